# Optimizing an MI355X kernel written in HIP

```python
import jax, jax.numpy as jnp
from jax import lax
import numpy as np

D_MODEL = 1024
BATCH = 4
SEQ = 4096
DEPTH = 4
DEC_BATCH = 32
DEC_SEQ = 16
PAST_LEN = 1024

CHUNK = 64
SGU_CHUNK = 128
SGU_WIDTH = D_MODEL // 2
SGU_GROUPS = 4
SGU_GROUP_DIM = SGU_WIDTH // SGU_GROUPS
SB_HEADS = 8
SB_HEAD_DIM = 64
SB_WIDTH = SB_HEADS * SB_HEAD_DIM
MIX_WIDTH = SGU_WIDTH + SB_WIDTH
IN_WIDTH = 2 * SGU_WIDTH + 3 * SB_WIDTH
SB_Q_BLOCK = 128
N_MEM = 256
MEM_HEADS = 4
MEM_HEAD_DIM = D_MODEL // MEM_HEADS
D_FF = -(-8 * D_MODEL // (3 * 256)) * 256
EPS = 1e-6

kernel_name = 'hybrid_sgu_stickbreak_stream_step'


def _rmsnorm(x, g):
    xf = x.astype(jnp.float32)
    y = xf * lax.rsqrt(jnp.mean(xf * xf, axis=-1, keepdims=True) + EPS)
    return (y * g.astype(jnp.float32)).astype(x.dtype)


def _mixer_inputs(h, w_in, g_v):
    B, T = h.shape[0], h.shape[1]
    proj = h @ w_in
    u, va, q, k, vb = jnp.split(
        proj, [SGU_WIDTH, 2 * SGU_WIDTH, 2 * SGU_WIDTH + SB_WIDTH, 2 * SGU_WIDTH + 2 * SB_WIDTH], axis=-1)
    u = jax.nn.gelu(u)
    va = _rmsnorm(jax.nn.gelu(va).reshape(B, T, SGU_GROUPS, SGU_GROUP_DIM), g_v)
    q = q.reshape(B, T, SB_HEADS, SB_HEAD_DIM)
    k = k.reshape(B, T, SB_HEADS, SB_HEAD_DIM)
    vb = vb.reshape(B, T, SB_HEADS, SB_HEAD_DIM)
    return u, va, q, k, vb


def _sgu_mix(v, w_s, b_s):
    L = v.shape[2]
    w = jnp.tril(w_s[:, :L, :L])
    bias = jnp.transpose(b_s[:, :L])[:, :, None]
    return jnp.einsum('gts,bcsge->bctge', w, v) + bias


def _stick_breaking(q, k, v, q_pos, k_pos):
    z = jnp.einsum('bqhd,bkhd->bhqk', q.astype(jnp.float32), k.astype(jnp.float32)) * (SB_HEAD_DIM ** -0.5)
    mask = k_pos[None, :] < q_pos[:, None]
    log_keep = jnp.where(mask, jax.nn.log_sigmoid(-z), 0.0)
    between = lax.cumsum(log_keep, axis=3, reverse=True) - log_keep
    a = jnp.where(mask, jnp.exp(jax.nn.log_sigmoid(z) + between), 0.0)
    o = jnp.einsum('bhqk,bkhd->bqhd', a, v.astype(jnp.float32))
    return o.astype(q.dtype)


def _sb_prompt(q, k, v):
    T = q.shape[1]
    pos = jnp.arange(T, dtype=jnp.int32)

    def blk(i):
        start = i * SB_Q_BLOCK
        qb = lax.dynamic_slice_in_dim(q, start, SB_Q_BLOCK, axis=1)
        pb = lax.dynamic_slice_in_dim(pos, start, SB_Q_BLOCK)
        return _stick_breaking(qb, k, v, pb, pos)

    out = lax.map(blk, jnp.arange(T // SB_Q_BLOCK, dtype=jnp.int32))
    return jnp.moveaxis(out, 0, 1).reshape(q.shape)


def _merge(a_out, sb_out, g_a, g_b, w_out):
    B, T = a_out.shape[0], a_out.shape[1]
    cat = jnp.concatenate([_rmsnorm(a_out, g_a), _rmsnorm(sb_out.reshape(B, T, SB_WIDTH), g_b)], axis=-1)
    return cat @ w_out


def _mem_kv(mem, w_mk, w_mv):
    B = mem.shape[0]
    mk = (mem @ w_mk).reshape(B, N_MEM, MEM_HEADS, MEM_HEAD_DIM)
    mv = (mem @ w_mv).reshape(B, N_MEM, MEM_HEADS, MEM_HEAD_DIM)
    return mk, mv


def _mem_attend(h, mk, mv, w_mq, w_mo):
    B, T = h.shape[0], h.shape[1]
    q = (h @ w_mq).reshape(B, T, MEM_HEADS, MEM_HEAD_DIM)
    s = jnp.einsum('bqhd,bkhd->bhqk', q.astype(jnp.float32), mk.astype(jnp.float32)) * (MEM_HEAD_DIM ** -0.5)
    p = jax.nn.softmax(s, axis=-1)
    o = jnp.einsum('bhqk,bkhd->bqhd', p, mv.astype(jnp.float32)).astype(h.dtype)
    return o.reshape(B, T, D_MODEL) @ w_mo


def _swiglu(h, w_gate, w_up, w_down):
    return (jax.nn.silu(h @ w_gate) * (h @ w_up)) @ w_down


def setup_inputs(seed: int = 0) -> dict:
    key = jax.random.key(seed)
    ks = jax.random.split(key, 32)
    f32 = jnp.float32

    def nrm(k, shape, scale=1.0):
        return jax.random.normal(k, shape, f32) * scale

    def gain(k, shape):
        return 1.0 + 0.05 * jax.random.normal(k, shape, f32)

    L = DEPTH
    return {
        'x_prompt': nrm(ks[0], (BATCH, SEQ, D_MODEL)),
        'x_sample': nrm(ks[1], (DEC_BATCH, DEC_SEQ, D_MODEL)),
        'cache_sb_k': nrm(ks[2], (L, DEC_BATCH, PAST_LEN, SB_HEADS, SB_HEAD_DIM)),
        'cache_sb_v': nrm(ks[3], (L, DEC_BATCH, PAST_LEN, SB_HEADS, SB_HEAD_DIM)),
        'cache_mem_k': nrm(ks[4], (L, DEC_BATCH, N_MEM, MEM_HEADS, MEM_HEAD_DIM)),
        'cache_mem_v': nrm(ks[5], (L, DEC_BATCH, N_MEM, MEM_HEADS, MEM_HEAD_DIM)),
        'mem_prompt': nrm(ks[6], (BATCH, N_MEM, D_MODEL)),
        'ln_mix': gain(ks[7], (L, D_MODEL)),
        'w_in': nrm(ks[8], (L, D_MODEL, IN_WIDTH), D_MODEL ** -0.5),
        'g_sgu_v': gain(ks[9], (L, SGU_GROUPS, SGU_GROUP_DIM)),
        'w_sgu': nrm(ks[10], (L, SGU_GROUPS, SGU_CHUNK, SGU_CHUNK), SGU_CHUNK ** -0.5),
        'b_sgu': 1.0 + 0.01 * jax.random.normal(ks[11], (L, SGU_GROUPS, SGU_CHUNK), f32),
        'g_out_sgu': gain(ks[12], (L, SGU_WIDTH)),
        'g_out_sb': gain(ks[13], (L, SB_WIDTH)),
        'w_out': nrm(ks[14], (L, MIX_WIDTH, D_MODEL), MIX_WIDTH ** -0.5),
        'ln_mem': gain(ks[15], (L, D_MODEL)),
        'w_mq': nrm(ks[16], (L, D_MODEL, D_MODEL), D_MODEL ** -0.5),
        'w_mk': nrm(ks[17], (L, D_MODEL, D_MODEL), D_MODEL ** -0.5),
        'w_mv': nrm(ks[18], (L, D_MODEL, D_MODEL), D_MODEL ** -0.5),
        'w_mo': nrm(ks[19], (L, D_MODEL, D_MODEL), D_MODEL ** -0.5),
        'ln_ffn': gain(ks[20], (L, D_MODEL)),
        'w_ffn_gate': nrm(ks[21], (L, D_MODEL, D_FF), D_MODEL ** -0.5),
        'w_ffn_up': nrm(ks[22], (L, D_MODEL, D_FF), D_MODEL ** -0.5),
        'w_ffn_down': nrm(ks[23], (L, D_FF, D_MODEL), D_FF ** -0.5),
        'ln_final': gain(ks[24], (D_MODEL,)),
    }


def reference(x_prompt, x_sample, cache_sb_k, cache_sb_v, cache_mem_k, cache_mem_v, mem_prompt,
              ln_mix, w_in, g_sgu_v, w_sgu, b_sgu, g_out_sgu, g_out_sb, w_out,
              ln_mem, w_mq, w_mk, w_mv, w_mo, ln_ffn, w_ffn_gate, w_ffn_up, w_ffn_down, ln_final):
    x = x_prompt
    B, T = x.shape[0], x.shape[1]
    sbk_p, sbv_p, mk_p, mv_p = [], [], [], []
    for l in range(DEPTH):
        h = _rmsnorm(x, ln_mix[l])
        u, va, q, k, vb = _mixer_inputs(h, w_in[l], g_sgu_v[l])
        va_c = va.reshape(B, T // SGU_CHUNK, SGU_CHUNK, SGU_GROUPS, SGU_GROUP_DIM)
        a_out = u * _sgu_mix(va_c, w_sgu[l], b_sgu[l]).reshape(B, T, SGU_WIDTH)
        sb_out = _sb_prompt(q, k, vb)
        x = x + _merge(a_out, sb_out, g_out_sgu[l], g_out_sb[l], w_out[l])
        mk, mv = _mem_kv(mem_prompt, w_mk[l], w_mv[l])
        x = x + _mem_attend(_rmsnorm(x, ln_mem[l]), mk, mv, w_mq[l], w_mo[l])
        x = x + _swiglu(_rmsnorm(x, ln_ffn[l]), w_ffn_gate[l], w_ffn_up[l], w_ffn_down[l])
        sbk_p.append(k)
        sbv_p.append(vb)
        mk_p.append(mk)
        mv_p.append(mv)
    y_prompt = _rmsnorm(x, ln_final)

    x = x_sample
    Bs, n = x.shape[0], x.shape[1]
    P = cache_sb_k.shape[2]
    k_pos = jnp.arange(P + n, dtype=jnp.int32)
    q_pos = P + jnp.arange(n, dtype=jnp.int32)
    sbk_s, sbv_s, sguv_s = [], [], []
    for l in range(DEPTH):
        h = _rmsnorm(x, ln_mix[l])
        u, va, q, k, vb = _mixer_inputs(h, w_in[l], g_sgu_v[l])
        a_out = u * _sgu_mix(va[:, None], w_sgu[l], b_sgu[l]).reshape(Bs, n, SGU_WIDTH)
        k_all = jnp.concatenate([cache_sb_k[l], k], axis=1)
        v_all = jnp.concatenate([cache_sb_v[l], vb], axis=1)
        sb_out = _stick_breaking(q, k_all, v_all, q_pos, k_pos)
        x = x + _merge(a_out, sb_out, g_out_sgu[l], g_out_sb[l], w_out[l])
        x = x + _mem_attend(_rmsnorm(x, ln_mem[l]), cache_mem_k[l], cache_mem_v[l], w_mq[l], w_mo[l])
        x = x + _swiglu(_rmsnorm(x, ln_ffn[l]), w_ffn_gate[l], w_ffn_up[l], w_ffn_down[l])
        sbk_s.append(k)
        sbv_s.append(vb)
        sguv_s.append(va)
    y_sample = _rmsnorm(x, ln_final)

    sb_k_prompt = jnp.stack(sbk_p)
    sb_v_prompt = jnp.stack(sbv_p)
    mem_k_prompt = jnp.stack(mk_p)
    mem_v_prompt = jnp.stack(mv_p)
    sb_k_sample = jnp.stack(sbk_s)
    sb_v_sample = jnp.stack(sbv_s)
    sgu_v_sample = jnp.stack(sguv_s)
    return (y_prompt, y_sample, sb_k_prompt, sb_v_prompt, mem_k_prompt, mem_v_prompt, sb_k_sample, sb_v_sample, sgu_v_sample)
```

```cpp
#include <hip/hip_runtime.h>
#include <cstdint>
#include <cstdio>
namespace refimpl {
constexpr int D = 1024, NB = 4, T = 4096, NL = 4, BS = 32, NS = 16, PAST = 1024, INW = 2560, NMEM = 256, DFF = 2816;
constexpr int MP = NB * T, MS = BS * NS, M = MP + MS;
constexpr float EPS = 1e-6f;
typedef float f32x16 __attribute__((ext_vector_type(16)));

__global__ void __launch_bounds__(256) rmsnorm_k(const float* x, size_t is, const float* g, float* out, size_t os, int rows, int width) {
    const int row = blockIdx.x * 4 + (threadIdx.x >> 6), lane = threadIdx.x & 63;
    if (row >= rows) return;
    const float* xr = x + (size_t)row * is; float* orow = out + (size_t)row * os;
    float s = 0.f;
    for (int c = lane; c < width; c += 64) { const float v = xr[c]; s += v * v; }
    for (int o = 32; o > 0; o >>= 1) s += __shfl_xor(s, o);
    const float r = rsqrtf(s / (float)width + EPS);
    for (int c = lane; c < width; c += 64) orow[c] = xr[c] * r * g[c];
}

__global__ void __launch_bounds__(256) gemm_f32_k(const float* A, int lda, const float* Bm, int ldb, float* C, int ldc, int K, int accum) {
    __shared__ float As[16][132];
    __shared__ float Bs[16][132];
    const int tid = threadIdx.x, wave = tid >> 6, lane = tid & 63, wr = wave >> 1, wc = wave & 1;
    const int m0 = blockIdx.y * 128, n0 = blockIdx.x * 128;
    f32x16 acc[2][2];
    for (int i = 0; i < 2; ++i) for (int j = 0; j < 2; ++j) for (int r = 0; r < 16; ++r) acc[i][j][r] = 0.f;
    for (int k0 = 0; k0 < K; k0 += 16) {
#pragma unroll
        for (int i = 0; i < 2; ++i) { const int idx = tid + i * 256, row = idx >> 2, kq = idx & 3;
            const float4 v = *(const float4*)(A + (size_t)(m0 + row) * lda + k0 + kq * 4);
            As[kq * 4 + 0][row] = v.x; As[kq * 4 + 1][row] = v.y; As[kq * 4 + 2][row] = v.z; As[kq * 4 + 3][row] = v.w; }
#pragma unroll
        for (int i = 0; i < 2; ++i) { const int idx = tid + i * 256, kk = idx >> 5, nq = idx & 31;
            const float4 v = *(const float4*)(Bm + (size_t)(k0 + kk) * ldb + n0 + nq * 4);
            Bs[kk][nq * 4 + 0] = v.x; Bs[kk][nq * 4 + 1] = v.y; Bs[kk][nq * 4 + 2] = v.z; Bs[kk][nq * 4 + 3] = v.w; }
        __syncthreads();
#pragma unroll
        for (int kk = 0; kk < 16; kk += 2) {
            const int kr = kk + (lane >> 5);
            float a[2], b[2];
            a[0] = As[kr][wr * 64 + (lane & 31)]; a[1] = As[kr][wr * 64 + 32 + (lane & 31)];
            b[0] = Bs[kr][wc * 64 + (lane & 31)]; b[1] = Bs[kr][wc * 64 + 32 + (lane & 31)];
#pragma unroll
            for (int i = 0; i < 2; ++i)
#pragma unroll
                for (int j = 0; j < 2; ++j) acc[i][j] = __builtin_amdgcn_mfma_f32_32x32x2f32(a[i], b[j], acc[i][j], 0, 0, 0);
        }
        __syncthreads();
    }
#pragma unroll
    for (int i = 0; i < 2; ++i)
#pragma unroll
        for (int j = 0; j < 2; ++j)
#pragma unroll
            for (int r = 0; r < 16; ++r) {
                const int row = m0 + wr * 64 + i * 32 + (r & 3) + 8 * (r >> 2) + 4 * (lane >> 5), col = n0 + wc * 64 + j * 32 + (lane & 31);
                float* p = C + (size_t)row * ldc + col; float v = acc[i][j][r]; if (accum) v += *p; *p = v; }
}

__device__ __forceinline__ float gelu_tanh(float x) { const float c = 0.7978845608028654f; return 0.5f * x * (1.f + tanhf(c * (x + 0.044715f * x * x * x))); }

__global__ void __launch_bounds__(256) mixer_post_k(float* proj, const float* g_v  , float* sbk_p, float* sbv_p, float* sbk_s, float* sbv_s, float* sguv_s) {
    const int row = blockIdx.x * 4 + (threadIdx.x >> 6), lane = threadIdx.x & 63;
    if (row >= M) return;
    float* pr = proj + (size_t)row * INW;
    for (int c = lane; c < 512; c += 64) pr[c] = gelu_tanh(pr[c]);
    for (int g = 0; g < 4; ++g) {
        float y0 = gelu_tanh(pr[512 + g * 128 + lane]), y1 = gelu_tanh(pr[512 + g * 128 + 64 + lane]);
        float s = y0 * y0 + y1 * y1;
        for (int o = 32; o > 0; o >>= 1) s += __shfl_xor(s, o);
        const float r = rsqrtf(s / 128.f + EPS);
        y0 = y0 * r * g_v[g * 128 + lane]; y1 = y1 * r * g_v[g * 128 + 64 + lane];
        pr[512 + g * 128 + lane] = y0; pr[512 + g * 128 + 64 + lane] = y1;
        if (row >= MP) { float* o = sguv_s + (size_t)(row - MP) * 512 + g * 128; o[lane] = y0; o[64 + lane] = y1; }
    }
    float* ko = row < MP ? sbk_p + (size_t)row * 512 : sbk_s + (size_t)(row - MP) * 512;
    float* vo = row < MP ? sbv_p + (size_t)row * 512 : sbv_s + (size_t)(row - MP) * 512;
    for (int c = lane; c < 512; c += 64) { ko[c] = pr[1536 + c]; vo[c] = pr[2048 + c]; }
}

__global__ void __launch_bounds__(128) sgu_mix_k(float* proj, const float* w_s  , const float* b_s  ) {
    const int ch = blockIdx.x, g = blockIdx.y, e = threadIdx.x;
    int base, Lr;
    if (ch < MP / 128) { base = ch * 128; Lr = 128; } else { base = MP + (ch - MP / 128) * NS; Lr = NS; }
    const float* W = w_s + (size_t)g * 128 * 128;
    for (int t = 0; t < Lr; ++t) {
        float acc = 0.f;
        for (int s = 0; s <= t; ++s) acc += W[t * 128 + s] * proj[(size_t)(base + s) * INW + 512 + g * 128 + e];
        acc += b_s[g * 128 + t];
        float* up = proj + (size_t)(base + t) * INW + g * 128 + e;
        *up = *up * acc;
    }
}

__device__ __forceinline__ float softplus_f(float z) { return fmaxf(z, 0.f) + log1pf(expf(-fabsf(z))); }

__global__ void __launch_bounds__(64) sb_prompt_k(const float* proj, float* cat) {
    const int tb = blockIdx.x, h = blockIdx.y, b = blockIdx.z, lane = threadIdx.x;
    const int t = tb * 64 + lane; const size_t rb = (size_t)b * T;
    float q[64], o[64];
    const float* qp = proj + (rb + t) * INW + 1024 + h * 64;
#pragma unroll
    for (int d = 0; d < 64; ++d) { q[d] = qp[d]; o[d] = 0.f; }
    float R = 0.f;
    for (int s = tb * 64 + 62; s >= 0; --s) {
        const float* kp = proj + (rb + s) * INW + 1536 + h * 64; const float* vp = kp + 512;
        float z = 0.f;
#pragma unroll
        for (int d = 0; d < 64; ++d) z += q[d] * kp[d];
        z *= 0.125f;
        if (s < t) { const float a = expf(-softplus_f(-z) + R);
#pragma unroll
            for (int d = 0; d < 64; ++d) o[d] += a * vp[d];
            R -= softplus_f(z); }
    }
    float* op = cat + (rb + t) * D + 512 + h * 64;
#pragma unroll
    for (int d = 0; d < 64; ++d) op[d] = o[d];
}
__global__ void __launch_bounds__(64) sb_sample_k(const float* proj, const float* ck  , const float* cv, float* cat) {
    const int h = blockIdx.x, bs = blockIdx.y, i = threadIdx.x;
    if (i >= NS) return;
    const size_t row = (size_t)MP + bs * NS + i;
    float q[64], o[64];
    const float* qp = proj + row * INW + 1024 + h * 64;
#pragma unroll
    for (int d = 0; d < 64; ++d) { q[d] = qp[d]; o[d] = 0.f; }
    float R = 0.f;
    for (int j = PAST + i - 1; j >= 0; --j) {
        const float* kp; const float* vp;
        if (j < PAST) { kp = ck + ((size_t)bs * PAST + j) * 512 + h * 64; vp = cv + ((size_t)bs * PAST + j) * 512 + h * 64; }
        else { kp = proj + ((size_t)MP + bs * NS + (j - PAST)) * INW + 1536 + h * 64; vp = kp + 512; }
        float z = 0.f;
#pragma unroll
        for (int d = 0; d < 64; ++d) z += q[d] * kp[d];
        z *= 0.125f;
        const float a = expf(-softplus_f(-z) + R);
#pragma unroll
        for (int d = 0; d < 64; ++d) o[d] += a * vp[d];
        R -= softplus_f(z);
    }
    float* op = cat + row * D + 512 + h * 64;
#pragma unroll
    for (int d = 0; d < 64; ++d) op[d] = o[d];
}

__global__ void __launch_bounds__(256) mem_attn_k(const float* QM, const float* mk_p, const float* mv_p  , const float* ck, const float* cv  , float* OM) {
    __shared__ float qs[256], ps[256], red[8];
    const int row = blockIdx.x, h = blockIdx.y, tid = threadIdx.x;
    const float* Kb; const float* Vb;
    if (row < MP) { const int b = row / T; Kb = mk_p + (size_t)b * NMEM * D; Vb = mv_p + (size_t)b * NMEM * D; }
    else { const int bs = (row - MP) / NS; Kb = ck + (size_t)bs * NMEM * D; Vb = cv + (size_t)bs * NMEM * D; }
    qs[tid] = QM[(size_t)row * D + h * 256 + tid];
    __syncthreads();
    const float* kr = Kb + (size_t)tid * D + h * 256;
    float s = 0.f;
    for (int d = 0; d < 256; d += 4) { const float4 kv = *(const float4*)(kr + d); s += qs[d] * kv.x + qs[d + 1] * kv.y + qs[d + 2] * kv.z + qs[d + 3] * kv.w; }
    s *= 0.0625f;
    float mx = s;
    for (int o = 32; o > 0; o >>= 1) mx = fmaxf(mx, __shfl_xor(mx, o));
    if ((tid & 63) == 0) red[tid >> 6] = mx;
    __syncthreads();
    mx = fmaxf(fmaxf(red[0], red[1]), fmaxf(red[2], red[3]));
    const float p = expf(s - mx);
    float sm = p;
    for (int o = 32; o > 0; o >>= 1) sm += __shfl_xor(sm, o);
    if ((tid & 63) == 0) red[4 + (tid >> 6)] = sm;
    ps[tid] = p;
    __syncthreads();
    sm = red[4] + red[5] + red[6] + red[7];
    float o = 0.f;
    for (int j = 0; j < 256; ++j) o += ps[j] * Vb[(size_t)j * D + h * 256 + tid];
    OM[(size_t)row * D + h * 256 + tid] = o / sm;
}

__global__ void __launch_bounds__(256) swiglu_act_k(float* G, const float* U, size_t n) {
    size_t i = (size_t)blockIdx.x * 256 + threadIdx.x; const size_t st = (size_t)gridDim.x * 256;
    for (; i < n; i += st) { const float g = G[i]; G[i] = g / (1.f + expf(-g)) * U[i]; }
}
__global__ void __launch_bounds__(256) copy_k(const float* src, float* dst, size_t n) {
    size_t i = (size_t)blockIdx.x * 256 + threadIdx.x; const size_t st = (size_t)gridDim.x * 256;
    for (; i < n; i += st) dst[i] = src[i];
}

struct Outs { float *y_p, *y_s, *sbk_p, *sbv_p, *mk_p, *mv_p, *sbk_s, *sbv_s, *sguv_s; };
static inline Outs split_out(float* o) {
    Outs r; size_t off = 0;
    r.y_p = o + off; off += (size_t)MP * D; r.y_s = o + off; off += (size_t)MS * D;
    r.sbk_p = o + off; off += (size_t)NL * MP * 512; r.sbv_p = o + off; off += (size_t)NL * MP * 512;
    r.mk_p = o + off; off += (size_t)NL * NB * NMEM * D; r.mv_p = o + off; off += (size_t)NL * NB * NMEM * D;
    r.sbk_s = o + off; off += (size_t)NL * MS * 512; r.sbv_s = o + off; off += (size_t)NL * MS * 512;
    r.sguv_s = o + off; off += (size_t)NL * MS * 512;
    return r;
}

static inline void gemm(hipStream_t st, const float* A, int lda, const float* Bm, int ldb, float* C, int ldc, int Mr, int N, int K, int accum) {
    hipLaunchKernelGGL(gemm_f32_k, dim3(N / 128, Mr / 128), dim3(256), 0, st, A, lda, Bm, ldb, C, ldc, K, accum);
}
static inline void rmsnorm(hipStream_t st, const float* x, size_t is, const float* g, float* out, size_t os, int rows, int width) {
    hipLaunchKernelGGL(rmsnorm_k, dim3((rows + 3) / 4), dim3(256), 0, st, x, is, g, out, os, rows, width);
}

static void forward(void* const* d_in, float* d_out, unsigned char* ws, hipStream_t st) {
    const float* x_prompt = (const float*)d_in[0]; const float* x_sample = (const float*)d_in[1];
    const float* c_sbk = (const float*)d_in[2]; const float* c_sbv = (const float*)d_in[3];
    const float* c_mk = (const float*)d_in[4]; const float* c_mv = (const float*)d_in[5];
    const float* mem_prompt = (const float*)d_in[6];
    const float* ln_mix = (const float*)d_in[7]; const float* w_in = (const float*)d_in[8]; const float* g_sgu_v = (const float*)d_in[9];
    const float* w_sgu = (const float*)d_in[10]; const float* b_sgu = (const float*)d_in[11]; const float* g_out_sgu = (const float*)d_in[12];
    const float* g_out_sb = (const float*)d_in[13]; const float* w_out = (const float*)d_in[14]; const float* ln_mem = (const float*)d_in[15];
    const float* w_mq = (const float*)d_in[16]; const float* w_mk = (const float*)d_in[17]; const float* w_mv = (const float*)d_in[18];
    const float* w_mo = (const float*)d_in[19]; const float* ln_ffn = (const float*)d_in[20]; const float* w_gate = (const float*)d_in[21];
    const float* w_up = (const float*)d_in[22]; const float* w_down = (const float*)d_in[23]; const float* ln_final = (const float*)d_in[24];
    const size_t MB = 1u << 20;
    float* x = (float*)(ws + 0 * MB); float* hn = (float*)(ws + 70 * MB); float* cat = (float*)(ws + 140 * MB);
    float* QM = (float*)(ws + 210 * MB); float* OM = (float*)(ws + 280 * MB); float* proj = (float*)(ws + 350 * MB);
    float* G = (float*)(ws + 350 * MB); float* U = (float*)(ws + 545 * MB);
    Outs O = split_out(d_out);
    hipLaunchKernelGGL(copy_k, dim3(2048), dim3(256), 0, st, x_prompt, x, (size_t)MP * D);
    hipLaunchKernelGGL(copy_k, dim3(256), dim3(256), 0, st, x_sample, x + (size_t)MP * D, (size_t)MS * D);
    for (int l = 0; l < NL; ++l) {
        rmsnorm(st, x, D, ln_mix + l * D, hn, D, M, D);
        gemm(st, hn, D, w_in + (size_t)l * D * INW, INW, proj, INW, M, INW, D, 0);
        hipLaunchKernelGGL(mixer_post_k, dim3(M / 4), dim3(256), 0, st, proj, g_sgu_v + l * 512, O.sbk_p + (size_t)l * MP * 512, O.sbv_p + (size_t)l * MP * 512,
                           O.sbk_s + (size_t)l * MS * 512, O.sbv_s + (size_t)l * MS * 512, O.sguv_s + (size_t)l * MS * 512);
        hipLaunchKernelGGL(sb_prompt_k, dim3(T / 64, 8, NB), dim3(64), 0, st, proj, cat);
        hipLaunchKernelGGL(sb_sample_k, dim3(8, BS), dim3(64), 0, st, proj, c_sbk + (size_t)l * BS * PAST * 512, c_sbv + (size_t)l * BS * PAST * 512, cat);
        hipLaunchKernelGGL(sgu_mix_k, dim3(MP / 128 + BS, 4), dim3(128), 0, st, proj, w_sgu + (size_t)l * 4 * 128 * 128, b_sgu + l * 512);
        rmsnorm(st, proj, INW, g_out_sgu + l * 512, cat, D, M, 512);
        rmsnorm(st, cat + 512, D, g_out_sb + l * 512, cat + 512, D, M, 512);
        gemm(st, cat, D, w_out + (size_t)l * D * D, D, x, D, M, D, D, 1);
        gemm(st, mem_prompt, D, w_mk + (size_t)l * D * D, D, O.mk_p + (size_t)l * NB * NMEM * D, D, NB * NMEM, D, D, 0);
        gemm(st, mem_prompt, D, w_mv + (size_t)l * D * D, D, O.mv_p + (size_t)l * NB * NMEM * D, D, NB * NMEM, D, D, 0);
        rmsnorm(st, x, D, ln_mem + l * D, hn, D, M, D);
        gemm(st, hn, D, w_mq + (size_t)l * D * D, D, QM, D, M, D, D, 0);
        hipLaunchKernelGGL(mem_attn_k, dim3(M, 4), dim3(256), 0, st, QM, O.mk_p + (size_t)l * NB * NMEM * D, O.mv_p + (size_t)l * NB * NMEM * D,
                           c_mk + (size_t)l * BS * NMEM * D, c_mv + (size_t)l * BS * NMEM * D, OM);
        gemm(st, OM, D, w_mo + (size_t)l * D * D, D, x, D, M, D, D, 1);
        rmsnorm(st, x, D, ln_ffn + l * D, hn, D, M, D);
        gemm(st, hn, D, w_gate + (size_t)l * D * DFF, DFF, G, DFF, M, DFF, D, 0);
        gemm(st, hn, D, w_up + (size_t)l * D * DFF, DFF, U, DFF, M, DFF, D, 0);
        hipLaunchKernelGGL(swiglu_act_k, dim3(4096), dim3(256), 0, st, G, U, (size_t)M * DFF);
        gemm(st, G, DFF, w_down + (size_t)l * DFF * D, D, x, D, M, D, DFF, 1);
    }
    rmsnorm(st, x, D, ln_final, O.y_p, D, MP, D);
    rmsnorm(st, x + (size_t)MP * D, D, ln_final, O.y_s, D, MS, D);
}
}
extern "C" void kernel_launch(void* const* d_in, const int* in_sizes, int n_in, void* d_out, int out_size, void* d_ws, size_t ws_size, hipStream_t stream) {
    refimpl::forward(d_in, (float*)d_out, (unsigned char*)d_ws, stream);
}
```

```cpp
#include <hip/hip_runtime.h>
#include <cstdint>
#include <cstdio>
#include <cmath>
namespace pg8 {
#define PG8_LAS __attribute__((address_space(3)))
typedef unsigned short bf16_t;
typedef short bf16x8 __attribute__((ext_vector_type(8)));
typedef float f32x4 __attribute__((ext_vector_type(4)));
typedef unsigned u32x4 __attribute__((ext_vector_type(4)));
constexpr int BM = 256, BK = 64, HALF = 128, HTB = HALF * BK * 2  , STAGE_BYTES = 8 * HTB, NXCD = 8, WGM = 8;

__host__ __device__ __forceinline__ int lds_byte(int r, int c) { const int st = (r >> 4) * 2 + (c >> 5), rr = r & 15, cc = c & 31, ob = rr * 64 + cc * 2; return st * 1024 + (ob ^ (((ob >> 9) & 1) << 5)); }
__host__ __device__ __forceinline__ void stage_rc(int b, int& R, int& C) { const int st = b / 1024, sb = b % 1024, swz = sb ^ (((sb >> 9) & 1) << 5); R = (st >> 1) * 16 + swz / 64; C = (st & 1) * 32 + (swz % 64) / 2; }
__host__ __device__ __forceinline__ int perm32(int rho) { const int n = rho >> 4, i = rho & 15; return 8 * (i >> 2) + 4 * n + (i & 3); }

struct Unit { int pm, pn; };
struct Gemm { const bf16_t* A; const bf16_t* Bt; int M, N, K; };

struct StaticOrder {
    int nM, nN, nwg, G, c;
    __host__ __device__ void init(int M, int N, int G_, int c_) { nM = M / BM; nN = N / BM; nwg = nM * nN; G = G_; c = c_; }
    __host__ __device__ bool next(int i, Unit& u) const {
        const long L = (long)i * G + c; if (L >= nwg) return false;
        int wgid = (int)L; { const int q = nwg / NXCD, r = nwg % NXCD, xcd = wgid % NXCD, off = wgid / NXCD; wgid = (xcd < r ? xcd * (q + 1) : r * (q + 1) + (xcd - r) * q) + off; }
        const int nig = WGM * nN, gid = wgid / nig, fm = gid * WGM, gsz = (nM - fm) < WGM ? (nM - fm) : WGM;
        u.pm = fm + ((wgid % nig) % gsz); u.pn = (wgid % nig) / gsz; return true;
    }
    __device__ __forceinline__ void a_ready(const Unit&) const {}
    __device__ __forceinline__ void done(const Unit&) const {}
};

__device__ __forceinline__ unsigned cvt_pk_bf16(float lo, float hi) { unsigned r; asm volatile("v_cvt_pk_bf16_f32 %0, %1, %2" : "=v"(r) : "v"(lo), "v"(hi)); return r; }
typedef float f32x2 __attribute__((ext_vector_type(2)));
constexpr int E_MP = 16384, E_MS = 512;
constexpr size_t EMiB = 1u << 20, EW_SSQ = 148 * EMiB, EW_SBSS = 150 * EMiB, EW_XF = 152 * EMiB, EW_XB = 218 * EMiB, EW_U = 251 * EMiB, EW_VA = 268 * EMiB, EW_Q = 285 * EMiB, EW_K = 302 * EMiB, EW_V = 319 * EMiB;
constexpr size_t EO_SBK_P = (size_t)16896 * 1024, EO_SBV_P = EO_SBK_P + (size_t)4 * 16384 * 512, EO_MK_P = EO_SBV_P + (size_t)4 * 16384 * 512, EO_MV_P = EO_MK_P + (size_t)4 * 4 * 256 * 1024, EO_SBK_S = EO_MV_P + (size_t)4 * 4 * 256 * 1024, EO_SBV_S = EO_SBK_S + (size_t)4 * 512 * 512;
constexpr float E_EPS = 1e-6f, E_LOG2E = 1.4426950408889634f;
typedef unsigned u32x2 __attribute__((ext_vector_type(2)));
__device__ __forceinline__ void load_rstd(const float* SSQ, int row0, int fq, float (&rs)[2][4]) {
#pragma unroll
    for (int ai = 0; ai < 2; ++ai)
#pragma unroll
        for (int m = 0; m < 4; ++m) { const f32x4 a = *(const f32x4*)(SSQ + (size_t)(row0 + ai * HALF + m * 16) * 16 + fq * 4);
            float s = (a[0] + a[1]) + (a[2] + a[3]); s += __shfl_xor(s, 16); s += __shfl_xor(s, 32);
            rs[ai][m] = __builtin_amdgcn_rsqf(s * (1.0f / 1024.0f) + E_EPS); }
}
__device__ __forceinline__ float gelu_tanh_f(float x) {
    const float y = x * (1.0f + 0.044715f * x * x);
    const float e = __builtin_amdgcn_exp2f(y * (-2.0f * 0.7978845608028654f * E_LOG2E));
    return x * __builtin_amdgcn_rcpf(1.0f + e);
}
__device__ __forceinline__ u32x4 pack8(const f32x4 a, const f32x4 b) { u32x4 w; w.x = cvt_pk_bf16(a[0], a[1]); w.y = cvt_pk_bf16(a[2], a[3]); w.z = cvt_pk_bf16(b[0], b[1]); w.w = cvt_pk_bf16(b[2], b[3]); return w; }

struct EpiIn {
    static constexpr bool PERM = true, AFTER_DRAIN = false, MIDSCALE = false; static constexpr int MID_T = 0;
    unsigned char* ws; float* out; int l; float qscale;
    __device__ __forceinline__ void midscale(f32x4 (&)[2][2][4][2], const Unit&, int, int) const {}
    __device__ __forceinline__ void operator()(const f32x4 (&acc)[2][2][4][2], const Unit& u, int wr, int wc, int fr, int fq) const {
        unsigned char* w = ws; float* o = out; asm volatile("" : "+s"(w), "+s"(o));
        const int row0 = u.pm * BM + wr * 64 + fr, typ = u.pn >> 1, col0 = (u.pn & 1) * 256 + wc * 32 + 8 * fq;
        float rs[2][4]; load_rstd((const float*)(w + EW_SSQ), row0, fq, rs);
        bf16_t* ob = (bf16_t*)(w + (typ == 0 ? EW_U : typ == 1 ? EW_VA : typ == 2 ? EW_Q : typ == 3 ? EW_K : EW_V));
        float* of = nullptr;
        if (typ >= 3) { const bool smp = u.pm * BM >= E_MP;
            of = o + (smp ? (typ == 3 ? EO_SBK_S : EO_SBV_S) + (size_t)l * E_MS * 512 - (size_t)E_MP * 512 : (typ == 3 ? EO_SBK_P : EO_SBV_P) + (size_t)l * E_MP * 512); }
#pragma unroll
        for (int ai = 0; ai < 2; ++ai)
#pragma unroll
            for (int m = 0; m < 4; ++m) { const int row = row0 + ai * HALF + m * 16; const float r = rs[ai][m];
#pragma unroll
                for (int bj = 0; bj < 2; ++bj) { f32x4 v0 = acc[ai][bj][m][0] * r, v1 = acc[ai][bj][m][1] * r; const size_t off = (size_t)row * 512 + col0 + bj * HALF;
                    if (typ <= 1) {
#pragma unroll
                        for (int i = 0; i < 4; ++i) { v0[i] = gelu_tanh_f(v0[i]); v1[i] = gelu_tanh_f(v1[i]); } }
                    else if (typ == 2) { v0 = v0 * qscale; v1 = v1 * qscale; }
                    else { *(f32x4*)(of + off) = v0; *(f32x4*)(of + off + 4) = v1; }
                    *(u32x4*)(ob + off) = pack8(v0, v1); }
                asm volatile("" ::: "memory"); }
    }
};
template <bool MID> struct EpiRes {
    static constexpr bool PERM = false, AFTER_DRAIN = false, MIDSCALE = MID; static constexpr int MID_T = 8;
    unsigned char* ws;
    __device__ __forceinline__ void midscale(f32x4 (&acc)[2][2][4][2], const Unit& u, int wr, int fr) const {
        unsigned char* w = ws; asm volatile("" : "+s"(w)); const float* SBSS = (const float*)(w + EW_SBSS);
        const int fq = (int)__builtin_amdgcn_mbcnt_hi(~0u, __builtin_amdgcn_mbcnt_lo(~0u, 0u)) >> 4;
#pragma unroll
        for (int ai = 0; ai < 2; ++ai)
#pragma unroll
            for (int m = 0; m < 4; ++m) { const f32x2 a = *(const f32x2*)(SBSS + (size_t)(u.pm * BM + wr * 64 + fr + ai * HALF + m * 16) * 8 + fq * 2);
                float s = a[0] + a[1]; s += __shfl_xor(s, 16); s += __shfl_xor(s, 32);
                const float r = __builtin_amdgcn_rsqf(s * (1.0f / 512.0f) + E_EPS);
#pragma unroll
                for (int bj = 0; bj < 2; ++bj)
#pragma unroll
                    for (int n = 0; n < 2; ++n) acc[ai][bj][m][n] = acc[ai][bj][m][n] * r; }
    }
    __device__ __forceinline__ void operator()(const f32x4 (&acc)[2][2][4][2], const Unit& u, int wr, int wc, int fr, int fq) const {
        unsigned char* w = ws; asm volatile("" : "+s"(w)); float* XF = (float*)(w + EW_XF); bf16_t* XB = (bf16_t*)(w + EW_XB); float* SSQ = (float*)(w + EW_SSQ);
        const int row0 = u.pm * BM + wr * 64 + fr, col0 = u.pn * BM + wc * 32 + 4 * fq;
#pragma unroll
        for (int ai = 0; ai < 2; ++ai)
#pragma unroll
            for (int m = 0; m < 4; ++m) { const int row = row0 + ai * HALF + m * 16; float ss = 0.f;
#pragma unroll
                for (int bj = 0; bj < 2; ++bj)
#pragma unroll
                    for (int n = 0; n < 2; ++n) { const size_t off = (size_t)row * 1024 + col0 + bj * HALF + n * 16;
                        const f32x4 x = *(const f32x4*)(XF + off) + acc[ai][bj][m][n];
                        *(f32x4*)(XF + off) = x; u32x2 wv; wv.x = cvt_pk_bf16(x[0], x[1]); wv.y = cvt_pk_bf16(x[2], x[3]); *(u32x2*)(XB + off) = wv;
                        ss += (x[0] * x[0] + x[1] * x[1]) + (x[2] * x[2] + x[3] * x[3]); }
                ss += __shfl_xor(ss, 16); ss += __shfl_xor(ss, 32);
                if (fq == 0) SSQ[(size_t)row * 16 + u.pn * 4 + wc] = ss;
                if (m & 1) asm volatile("" ::: "memory"); }
    }
};
struct EpiQ {
    static constexpr bool PERM = true, AFTER_DRAIN = false, MIDSCALE = false; static constexpr int MID_T = 0;
    const float* SSQ; bf16_t* QM; float qscale;
    __device__ __forceinline__ void midscale(f32x4 (&)[2][2][4][2], const Unit&, int, int) const {}
    __device__ __forceinline__ void operator()(const f32x4 (&acc)[2][2][4][2], const Unit& u, int wr, int wc, int fr, int fq) const {
        const int row0 = u.pm * BM + wr * 64 + fr, col0 = u.pn * BM + wc * 32 + 8 * fq;
        float rs[2][4]; load_rstd(SSQ, row0, fq, rs);
#pragma unroll
        for (int ai = 0; ai < 2; ++ai)
#pragma unroll
            for (int m = 0; m < 4; ++m) { const float r = rs[ai][m] * qscale; bf16_t* rowp = QM + (size_t)(row0 + ai * HALF + m * 16) * 1024 + col0;
#pragma unroll
                for (int bj = 0; bj < 2; ++bj) *(u32x4*)(rowp + bj * HALF) = pack8(acc[ai][bj][m][0] * r, acc[ai][bj][m][1] * r); }
    }
};
struct EpiGU {
    static constexpr bool PERM = true, AFTER_DRAIN = false, MIDSCALE = false; static constexpr int MID_T = 0;
    const float* SSQ; bf16_t* H;
    __device__ __forceinline__ void midscale(f32x4 (&)[2][2][4][2], const Unit&, int, int) const {}
    __device__ __forceinline__ void operator()(const f32x4 (&acc)[2][2][4][2], const Unit& u, int wr, int wc, int fr, int fq) const {
        const int row0 = u.pm * BM + wr * 64 + fr, col0 = u.pn * HALF + wc * 32 + 8 * fq;
        float rs[2][4]; load_rstd(SSQ, row0, fq, rs);
#pragma unroll
        for (int ai = 0; ai < 2; ++ai)
#pragma unroll
            for (int m = 0; m < 4; ++m) { const float r = rs[ai][m]; f32x4 h[2];
#pragma unroll
                for (int n = 0; n < 2; ++n) { const f32x4 g = acc[ai][0][m][n] * r, uu = acc[ai][1][m][n] * r;
#pragma unroll
                    for (int i = 0; i < 4; ++i) h[n][i] = g[i] * uu[i] * __builtin_amdgcn_rcpf(1.0f + __builtin_amdgcn_exp2f(-E_LOG2E * g[i])); }
                *(u32x4*)(H + (size_t)(row0 + ai * HALF + m * 16) * 2816 + col0) = pack8(h[0], h[1]); }
    }
};
struct EpiKV {
    static constexpr bool PERM = true, AFTER_DRAIN = false, MIDSCALE = false; static constexpr int MID_T = 0;
    float *mk_out, *mv_out; bf16_t *MK, *MVt;
    __device__ __forceinline__ void midscale(f32x4 (&)[2][2][4][2], const Unit&, int, int) const {}
    __device__ __forceinline__ void operator()(const f32x4 (&acc)[2][2][4][2], const Unit& u, int wr, int wc, int fr, int fq) const {
        const int l = u.pn >> 3, isv = (u.pn >> 2) & 1, hh = u.pn & 3, b = u.pm;
        const int key0 = wr * 64 + fr, col0 = hh * 256 + wc * 32 + 8 * fq;
        float* of = (isv ? mv_out : mk_out) + (size_t)(l * 4 + b) * 256 * 1024 + (size_t)key0 * 1024 + col0;
#pragma unroll
        for (int ai = 0; ai < 2; ++ai)
#pragma unroll
            for (int m = 0; m < 4; ++m) { float* p = of + (size_t)(ai * HALF + m * 16) * 1024;
#pragma unroll
                for (int bj = 0; bj < 2; ++bj) { *(f32x4*)(p + bj * HALF) = acc[ai][bj][m][0]; *(f32x4*)(p + bj * HALF + 4) = acc[ai][bj][m][1]; }
                asm volatile("" ::: "memory"); }
        if (!isv) { bf16_t* ob = MK + ((size_t)(l * 4 + b) * 256 + key0) * 1024 + col0;
#pragma unroll
            for (int ai = 0; ai < 2; ++ai)
#pragma unroll
                for (int m = 0; m < 4; ++m) {
#pragma unroll
                    for (int bj = 0; bj < 2; ++bj) *(u32x4*)(ob + (size_t)(ai * HALF + m * 16) * 1024 + bj * HALF) = pack8(acc[ai][bj][m][0], acc[ai][bj][m][1]);
                    asm volatile("" ::: "memory"); }
        } else { bf16_t* ob = MVt + ((size_t)(l * 4 + b) * 1024 + col0) * 256 + key0;
#pragma unroll
            for (int ai = 0; ai < 2; ++ai)
#pragma unroll
                for (int m = 0; m < 4; ++m)
#pragma unroll
                    for (int bj = 0; bj < 2; ++bj) { bf16_t* tp = ob + (size_t)(bj * HALF) * 256 + ai * HALF + m * 16; const u32x4 w = pack8(acc[ai][bj][m][0], acc[ai][bj][m][1]);
                        tp[0] = (bf16_t)(w.x & 0xffffu); tp[256] = (bf16_t)(w.x >> 16); tp[512] = (bf16_t)(w.y & 0xffffu); tp[768] = (bf16_t)(w.y >> 16);
                        tp[1024] = (bf16_t)(w.z & 0xffffu); tp[1280] = (bf16_t)(w.z >> 16); tp[1536] = (bf16_t)(w.w & 0xffffu); tp[1792] = (bf16_t)(w.w >> 16);
                        asm volatile("" ::: "memory"); }
        }
    }
};
template <class Epi, class Sched, bool ALIGN_EPI = false, bool SP2 = false>
__device__ __forceinline__ void gemm_phase(PG8_LAS unsigned char* lds, const Gemm g, const Sched& S, const Epi& E, int wave_id) {
    int tid_ = wave_id * 64 + (int)__builtin_amdgcn_mbcnt_hi(~0u, __builtin_amdgcn_mbcnt_lo(~0u, 0u)); asm volatile("" : "+v"(tid_));
    const int tid = tid_, wid = __builtin_amdgcn_readfirstlane(tid >> 6), lane = tid & 63, wr = wid >> 2, wc = wid & 3, fr = lane & 15, fq = lane >> 4;
    const int K = g.K, nt = K / BK;
    unsigned voffA[2], voffB[2];
#pragma unroll
    for (int i = 0; i < 2; ++i) { int R, C; stage_rc(tid * 16 + i * 8192, R, C); const int Rb = Epi::PERM ? ((R & ~31) + perm32(R & 31)) : R;
        voffA[i] = (unsigned)(R * K + C) * 2u; voffB[i] = (unsigned)(Rb * K + C) * 2u; }
    const size_t kstep = (size_t)(BK * 2);
    const size_t hstep = (size_t)HALF * K * 2;
    const size_t tstep = 2 * hstep;
    const unsigned ldsw = (unsigned)wid * 1024u;
    const int aoff = lds_byte(wr * 64 + fr, fq * 8), boff = lds_byte(wc * 32 + fr, fq * 8);
#define PG8_SA(b, h) (((b) * 2 + (h)) * HTB)
#define PG8_SB(b, h) ((4 + (b) * 2 + (h)) * HTB)
#define PG8_STAGE(bufoff, gbase, voff) do { _Pragma("unroll") for (int _i = 0; _i < 2; ++_i) \
        __builtin_amdgcn_global_load_lds((const unsigned*)((const char*)(gbase) + (voff)[_i]), (PG8_LAS unsigned*)(lds + (bufoff) + ldsw + _i * 8192), 16, 0, 0); } while (0)
#define PG8_LDA(dst, b, h) do { _Pragma("unroll") for (int m = 0; m < 4; ++m) _Pragma("unroll") for (int k = 0; k < 2; ++k) dst[m][k] = *(const PG8_LAS bf16x8*)(lds + PG8_SA(b, h) + aoff + m * 2048 + k * 1024); } while (0)
#define PG8_LDB(dst, b, h) do { _Pragma("unroll") for (int n = 0; n < 2; ++n) _Pragma("unroll") for (int k = 0; k < 2; ++k) dst[n][k] = *(const PG8_LAS bf16x8*)(lds + PG8_SB(b, h) + boff + n * 2048 + k * 1024); } while (0)
#define PG8_MMA(ai, bj, At, Bt) do { __builtin_amdgcn_s_setprio(1); _Pragma("unroll") for (int m = 0; m < 4; ++m) _Pragma("unroll") for (int n = 0; n < 2; ++n) _Pragma("unroll") for (int k = 0; k < 2; ++k) \
        acc[ai][bj][m][n] = __builtin_amdgcn_mfma_f32_16x16x32_bf16(Bt[n][k], At[m][k], acc[ai][bj][m][n], 0, 0, 0); __builtin_amdgcn_s_setprio(0); } while (0)
#define PG8_WAIT_V(n) asm volatile("s_waitcnt vmcnt(" #n ")" ::: "memory")
#define PG8_WAIT_L(n) asm volatile("s_waitcnt lgkmcnt(" #n ")" ::: "memory")
#define PG8_BAR __builtin_amdgcn_s_barrier()
#define PG8_SCHED __builtin_amdgcn_sched_barrier(0)
    Unit cur, nxt; int ui = 0;
    if (!S.next(0, cur)) return;
    f32x4 acc[2][2][4][2];
#pragma unroll
    for (int a = 0; a < 2; ++a)
#pragma unroll
        for (int b = 0; b < 2; ++b)
#pragma unroll
            for (int m = 0; m < 4; ++m)
#pragma unroll
                for (int n = 0; n < 2; ++n) acc[a][b][m][n] = (f32x4){0.f, 0.f, 0.f, 0.f};
    bf16x8 At[4][2], B0[2][2], B1[2][2];
    const char* cA = (const char*)g.A + (size_t)cur.pm * tstep; const char* cB = (const char*)g.Bt + (size_t)cur.pn * tstep;
    S.a_ready(cur);
    if constexpr (SP2) {
        PG8_STAGE(PG8_SB(0, 0), cB, voffB); PG8_STAGE(PG8_SB(0, 1), cB + hstep, voffB); PG8_STAGE(PG8_SA(0, 0), cA, voffA); PG8_STAGE(PG8_SA(0, 1), cA + hstep, voffA);
        if (wr == 1) PG8_BAR;
        PG8_WAIT_V(2); PG8_BAR;
        PG8_STAGE(PG8_SB(1, 0), cB + kstep, voffB); PG8_STAGE(PG8_SA(1, 0), cA + kstep, voffA); PG8_STAGE(PG8_SB(1, 1), cB + hstep + kstep, voffB);
        PG8_WAIT_V(6); PG8_BAR;
    } else {
        PG8_STAGE(PG8_SB(0, 0), cB, voffB); PG8_STAGE(PG8_SA(0, 0), cA, voffA); PG8_STAGE(PG8_SB(0, 1), cB + hstep, voffB); PG8_STAGE(PG8_SA(0, 1), cA + hstep, voffA);
        if (wr == 1) PG8_BAR;
        PG8_WAIT_V(4); PG8_BAR;
        PG8_STAGE(PG8_SB(1, 0), cB + kstep, voffB); PG8_STAGE(PG8_SA(1, 0), cA + kstep, voffA); PG8_STAGE(PG8_SB(1, 1), cB + hstep + kstep, voffB);
        PG8_WAIT_V(6); PG8_BAR;
    }
    for (;;) {
        const bool has_next = S.next(ui + 1, nxt);
        const char* nA = has_next ? (const char*)g.A + (size_t)nxt.pm * tstep : cA; const char* nB = has_next ? (const char*)g.Bt + (size_t)nxt.pn * tstep : cB;
        for (int t = 0; t < nt; t += 2) {
            if constexpr (Epi::MIDSCALE) { if (t == Epi::MID_T) E.midscale(acc, cur, wr, fr); }
            const bool last = (t == nt - 2);
            const char* a1 = cA + (size_t)(t + 1) * kstep;
            const char* a2 = last ? nA : cA + (size_t)(t + 2) * kstep; const char* b2 = last ? nB : cB + (size_t)(t + 2) * kstep;
            const char* a3 = a2 + kstep; const char* b3 = b2 + kstep;
            if (last && has_next) S.a_ready(nxt);
            if constexpr (SP2) {
            PG8_LDB(B0, 0, 0); PG8_LDB(B1, 0, 1); PG8_SCHED; PG8_LDA(At, 0, 0); PG8_STAGE(PG8_SA(1, 1), a1 + hstep, voffA);
            PG8_WAIT_V(8); PG8_WAIT_L(0); PG8_BAR; PG8_MMA(0, 0, At, B0); PG8_MMA(0, 1, At, B1); PG8_BAR; PG8_SCHED;
            PG8_LDA(At, 0, 1); PG8_STAGE(PG8_SB(0, 0), b2, voffB); PG8_STAGE(PG8_SB(0, 1), b2 + hstep, voffB); PG8_STAGE(PG8_SA(0, 0), a2, voffA);
            PG8_WAIT_V(8); PG8_WAIT_L(0); PG8_BAR; PG8_MMA(1, 0, At, B0); PG8_MMA(1, 1, At, B1); PG8_BAR; PG8_SCHED;
            PG8_LDB(B0, 1, 0); PG8_LDB(B1, 1, 1); PG8_SCHED; PG8_LDA(At, 1, 0); PG8_STAGE(PG8_SA(0, 1), a2 + hstep, voffA);
            PG8_WAIT_V(8); PG8_WAIT_L(0); PG8_BAR; PG8_MMA(0, 0, At, B0); PG8_MMA(0, 1, At, B1); PG8_BAR; PG8_SCHED;
            PG8_LDA(At, 1, 1); PG8_STAGE(PG8_SB(1, 0), b3, voffB); PG8_STAGE(PG8_SB(1, 1), b3 + hstep, voffB); PG8_STAGE(PG8_SA(1, 0), a3, voffA);
            PG8_WAIT_V(8); PG8_WAIT_L(0); PG8_BAR; PG8_MMA(1, 0, At, B0); PG8_MMA(1, 1, At, B1); PG8_BAR; PG8_SCHED;
            } else {
            PG8_LDB(B0, 0, 0); PG8_SCHED; PG8_LDA(At, 0, 0); PG8_STAGE(PG8_SA(1, 1), a1 + hstep, voffA);
            PG8_WAIT_L(8); PG8_BAR; PG8_WAIT_L(0); PG8_MMA(0, 0, At, B0); PG8_BAR; PG8_SCHED;
            PG8_LDB(B1, 0, 1); PG8_STAGE(PG8_SB(0, 0), b2, voffB);
            PG8_BAR; PG8_WAIT_L(0); PG8_MMA(0, 1, At, B1); PG8_BAR;
            PG8_LDA(At, 0, 1); PG8_STAGE(PG8_SA(0, 0), a2, voffA);
            PG8_BAR; PG8_WAIT_L(0); PG8_MMA(1, 0, At, B0); PG8_BAR; PG8_SCHED;
            PG8_STAGE(PG8_SB(0, 1), b2 + hstep, voffB);
            PG8_WAIT_V(6); PG8_BAR; PG8_MMA(1, 1, At, B1); PG8_BAR;
            PG8_LDB(B0, 1, 0); PG8_SCHED; PG8_LDA(At, 1, 0); PG8_STAGE(PG8_SA(0, 1), a2 + hstep, voffA);
            PG8_WAIT_L(8); PG8_BAR; PG8_WAIT_L(0); PG8_MMA(0, 0, At, B0); PG8_BAR; PG8_SCHED;
            PG8_LDB(B1, 1, 1); PG8_STAGE(PG8_SB(1, 0), b3, voffB);
            PG8_BAR; PG8_WAIT_L(0); PG8_MMA(0, 1, At, B1); PG8_BAR;
            PG8_LDA(At, 1, 1); PG8_STAGE(PG8_SA(1, 0), a3, voffA);
            PG8_BAR; PG8_WAIT_L(0); PG8_MMA(1, 0, At, B0); PG8_BAR; PG8_SCHED;
            PG8_STAGE(PG8_SB(1, 1), b3 + hstep, voffB);
            PG8_WAIT_V(6); PG8_BAR; PG8_MMA(1, 1, At, B1); PG8_BAR;
            }
        }
        if constexpr (ALIGN_EPI) { if (wr == 0) PG8_BAR; }
        if constexpr (!Epi::AFTER_DRAIN) { E(acc, cur, wr, wc, fr, fq); S.done(cur); }
        if (!has_next) break;
#pragma unroll
        for (int a = 0; a < 2; ++a)
#pragma unroll
            for (int b = 0; b < 2; ++b)
#pragma unroll
                for (int m = 0; m < 4; ++m)
#pragma unroll
                    for (int n = 0; n < 2; ++n) acc[a][b][m][n] = (f32x4){0.f, 0.f, 0.f, 0.f};
        cur = nxt; cA = nA; cB = nB; ++ui;
        if constexpr (ALIGN_EPI) { if (wr == 1) PG8_BAR; }
    }
    PG8_WAIT_V(0);
    if constexpr (!ALIGN_EPI) { if (wr == 0) PG8_BAR; }
    PG8_BAR;
    if constexpr (Epi::AFTER_DRAIN) { E.fused(acc, cur, wr, wc, fr, fq, lds, wid, lane); S.done(cur); }
#undef PG8_SA
#undef PG8_SB
#undef PG8_STAGE
#undef PG8_LDA
#undef PG8_LDB
#undef PG8_MMA
#undef PG8_WAIT_V
#undef PG8_WAIT_L
#undef PG8_BAR
#undef PG8_SCHED
}
}
constexpr int NWAVES = 8;
constexpr int D = 1024, NB = 4, T = 4096, NL = 4, BS = 32, NS = 16, PAST = 1024, INW = 2560, NMEM = 256, DFF = 2816;
constexpr int MP = NB * T, MS = BS * NS, M = MP + MS;
constexpr float EPS = 1e-6f, LOG2E = 1.4426950408889634f;
constexpr float C_SB = 0.125f * LOG2E, C_MEM = 0.0625f * LOG2E;
constexpr float SB_EXIT = 140.0f;
constexpr size_t MiB = 1u << 20;
constexpr size_t WS_CTL = 0, CTL_ZERO_BYTES = 1 * MiB;
constexpr size_t WS_WL = 2 * MiB, WL_STRIDE = 28 * MiB;
constexpr size_t WL_IN = 0, WL_OUT = 5 * MiB, WL_MQ = 7 * MiB, WL_MO = 9 * MiB, WL_GU = 11 * MiB, WL_DN = 22 * MiB;
constexpr size_t WS_WMKV = 114 * MiB, WS_MEMB = 130 * MiB, WS_MK = 132 * MiB, WS_MVT = 140 * MiB, WS_SSQ = 148 * MiB, WS_SBSS = 150 * MiB;
constexpr size_t WS_XF = 152 * MiB, WS_XB = 218 * MiB, WS_U = 251 * MiB, WS_VA = 268 * MiB, WS_Q = 285 * MiB, WS_K = 302 * MiB, WS_V = 319 * MiB;
constexpr size_t WS_CAT = 336 * MiB, WS_QM = 369 * MiB, WS_OM = 402 * MiB, WS_H = 435 * MiB, WS_END = 526 * MiB;
constexpr int CW_BAR = 4096;
constexpr int RING_OFF = 0, RING_BYTES = 131072, LDSCTL_OFF = RING_BYTES, MISC_OFF = LDSCTL_OFF + 320, AUX_OFF = LDSCTL_OFF + 1024, LDS_BYTES = 147456;

#define GAS __attribute__((address_space(1)))
#define LAS __attribute__((address_space(3)))
typedef unsigned short bf16;
typedef unsigned v4u __attribute__((ext_vector_type(4)));
typedef unsigned v2u __attribute__((ext_vector_type(2)));
typedef float f32x4 __attribute__((ext_vector_type(4)));
typedef float f32x16 __attribute__((ext_vector_type(16)));
typedef short bf16x8 __attribute__((ext_vector_type(8)));
typedef short s16x4 __attribute__((ext_vector_type(4)));
typedef GAS unsigned gu32;
#define RLX_AGENT __ATOMIC_RELAXED, __HIP_MEMORY_SCOPE_AGENT
#define LDS_WAIT() asm volatile("s_waitcnt lgkmcnt(0)" ::: "memory")
#define VM_WAIT() asm volatile("s_waitcnt vmcnt(0)" ::: "memory")
__device__ __forceinline__ unsigned cvtpk(float lo, float hi) { unsigned r; asm volatile("v_cvt_pk_bf16_f32 %0, %1, %2" : "=v"(r) : "v"(lo), "v"(hi)); return r; }
__device__ __forceinline__ float bf_lo(unsigned w) { return __uint_as_float(w << 16); }
__device__ __forceinline__ float bf_hi(unsigned w) { return __uint_as_float(w & 0xffff0000u); }
__device__ __forceinline__ int lane_id() { return (int)__builtin_amdgcn_mbcnt_hi(~0u, __builtin_amdgcn_mbcnt_lo(~0u, 0u)); }
__device__ __forceinline__ int crow(int r, int hi) { return (r & 3) + 8 * (r >> 2) + 4 * hi; }
__device__ __forceinline__ s16x4 tr_read(unsigned addr) { return __builtin_bit_cast(s16x4, __builtin_amdgcn_ds_read_tr16_b64_v4i16((LAS s16x4*)(uintptr_t)addr)); }
#define MFMA32(a, b, c) __builtin_amdgcn_mfma_f32_32x32x16_bf16((a), (b), (c), 0, 0, 0)

#define XB_TMO      128
#define XB_XCNT(j)  (256  + 64 * (j))
#define XB_XSUB(j)  (1280 + 64 * (j))
#define XB_XGEN(j)  (2304 + 64 * (j))
#define XB_TOP      3328
#define XB_TOPGEN   3392
#define XCD_BAR_WORDS 3456
#define XB_SPIN_CAP (1u << 18)

__device__ __forceinline__ unsigned xb_ld(unsigned* p)              { return __hip_atomic_load(p, __ATOMIC_RELAXED, __HIP_MEMORY_SCOPE_AGENT); }
__device__ __forceinline__ unsigned xb_add(unsigned* p, unsigned v) { return __hip_atomic_fetch_add(p, v, __ATOMIC_RELAXED, __HIP_MEMORY_SCOPE_AGENT); }
__device__ __forceinline__ unsigned xb_xcc_id() { return (unsigned)__builtin_amdgcn_s_getreg((3 << 11) | 20) & 0xFu; }
#define XB_SPIN(cond, bar) do { unsigned _sp = 0; while (cond) { __builtin_amdgcn_s_sleep(1); \
    if ((++_sp & 255u) == 0u) { if (xb_ld(&(bar)[XB_TMO])) break; if (_sp > XB_SPIN_CAP) { atomicAdd(&(bar)[XB_TMO], 1u); break; } } } } while (0)

struct XcdBarrier {
    unsigned* bar; unsigned x;
    volatile LAS unsigned* st;
};

__device__ __forceinline__ XcdBarrier xcd_barrier_post(unsigned* bar, volatile LAS unsigned* st, int tid) {
    XcdBarrier b; b.bar = bar; b.x = xb_xcc_id(); b.st = st;
    if (tid == 0) (void)xb_add(&bar[XB_XCNT(b.x)], 1u);
    return b;
}
__device__ __forceinline__ void xcd_barrier_complete(unsigned* bar, unsigned x, unsigned& nloc, unsigned& nx) {
    const unsigned G = gridDim.x * gridDim.y * gridDim.z;
    unsigned sum, cnt, mine, sp = 0u;
    for (;;) {
        sum = 0u; cnt = 0u; mine = 0u;
#pragma unroll
        for (unsigned j = 0; j < 16; ++j) { const unsigned c = xb_ld(&bar[XB_XCNT(j)]); sum += c; cnt += (c > 0u) ? 1u : 0u; mine = (j == x) ? c : mine; }
        if (sum == G) break;
        __builtin_amdgcn_s_sleep(1);
        if ((++sp & 255u) == 0u) { if (xb_ld(&bar[XB_TMO])) break; if (sp > XB_SPIN_CAP) { atomicAdd(&bar[XB_TMO], 1u); break; } }
    }
    nloc = mine > 0u ? mine : 1u; nx = cnt > 0u ? cnt : 1u;
}

__device__ __forceinline__ void xcd_barrier(const XcdBarrier& b, int tid) {
    asm volatile("s_waitcnt vmcnt(0)" ::: "memory");
    __syncthreads();
    if (tid == 0) {
        unsigned* bar = b.bar; unsigned bx = b.x; asm volatile("" : "+s"(bar), "+s"(bx));
        __builtin_amdgcn_s_waitcnt(0);
        unsigned nloc = b.st[0], nx = b.st[1];
        if (nloc == 0u) { xcd_barrier_complete(bar, bx, nloc, nx); b.st[0] = nloc; b.st[1] = nx; }
        const unsigned old = xb_add(&bar[XB_XSUB(bx)], 1u);
        const unsigned gen = old / nloc;
        if (old + 1u == (gen + 1u) * nloc) {
            __builtin_amdgcn_fence(__ATOMIC_RELEASE, "agent");
            asm volatile("s_waitcnt vmcnt(0)" ::: "memory");
            const unsigned og = xb_add(&bar[XB_TOP], 1u);
            const unsigned tg = og / nx;
            if (og + 1u == (tg + 1u) * nx) xb_add(&bar[XB_TOPGEN], 1u);
            else XB_SPIN(xb_ld(&bar[XB_TOPGEN]) == tg, bar);
            __builtin_amdgcn_fence(__ATOMIC_ACQUIRE, "agent");
            xb_add(&bar[XB_XGEN(bx)], 1u);
            asm volatile("s_waitcnt vmcnt(0)" ::: "memory");
        } else {
            XB_SPIN(xb_ld(&bar[XB_XGEN(bx)]) == gen, bar);
            __builtin_amdgcn_fence(__ATOMIC_ACQUIRE, "agent");
            asm volatile("s_waitcnt vmcnt(0)" ::: "memory");
        }
    }
    __syncthreads();
}


struct Frame {
    LAS unsigned char* lds; unsigned lds0;
    int wave, G, bid;
};
struct Args {
    const float* in[25]; float* out; unsigned char* ws; int ph_lo, ph_hi;
};
__device__ __forceinline__ float* out_y_p(float* o) { return o; }
__device__ __forceinline__ float* out_y_s(float* o) { return o + (size_t)MP * D; }
__device__ __forceinline__ float* out_sbk_p(float* o) { return o + (size_t)M * D; }
__device__ __forceinline__ float* out_sbv_p(float* o) { return out_sbk_p(o) + (size_t)NL * MP * 512; }
__device__ __forceinline__ float* out_mk_p(float* o) { return out_sbv_p(o) + (size_t)NL * MP * 512; }
__device__ __forceinline__ float* out_mv_p(float* o) { return out_mk_p(o) + (size_t)NL * NB * NMEM * D; }
__device__ __forceinline__ float* out_sbk_s(float* o) { return out_mv_p(o) + (size_t)NL * NB * NMEM * D; }
__device__ __forceinline__ float* out_sbv_s(float* o) { return out_sbk_s(o) + (size_t)NL * MS * 512; }
__device__ __forceinline__ float* out_sguv_s(float* o) { return out_sbv_s(o) + (size_t)NL * MS * 512; }

__device__ __forceinline__ void tr_item(const float* W, int ldw, int k_src0, int n_src0, const float* gain, bf16* dst, int ldd, int n_dst0, int k_dst0, LAS float* scr, int lane) {
#pragma unroll 8
    for (int i = 0; i < 32; ++i) { const int kk = 2 * i + (lane >> 5); float v = W[(size_t)(k_src0 + kk) * ldw + n_src0 + (lane & 31)]; if (gain) v *= gain[k_src0 + kk]; scr[kk * 33 + (lane & 31)] = v; }
    LDS_WAIT(); asm volatile("" ::: "memory");
    const int c = lane & 7;
#pragma unroll
    for (int j = 0; j < 4; ++j) { const int n = (lane >> 3) + 8 * j; const LAS float* s = scr + (8 * c) * 33 + n;
        v4u o; o.x = cvtpk(s[0 * 33], s[1 * 33]); o.y = cvtpk(s[2 * 33], s[3 * 33]); o.z = cvtpk(s[4 * 33], s[5 * 33]); o.w = cvtpk(s[6 * 33], s[7 * 33]);
        *(GAS v4u*)(dst + (size_t)(n_dst0 + n) * ldd + k_dst0 + 8 * c) = o; }
    LDS_WAIT(); asm volatile("" ::: "memory");
}
__device__ __forceinline__ void prologue(const Args& a, const Frame& F) {
    LAS float* scr = (LAS float*)(F.lds + RING_OFF + F.wave * 16384);
    const int gw = F.bid * NWAVES + F.wave, NGW = F.G * NWAVES;
    unsigned char* ws = a.ws;
    constexpr int I_IN = 1280, I_SQ = 512, I_G = 1408, I_L = I_IN + 3 * I_SQ + 3 * I_G + 2 * I_SQ;
    for (int it = gw; it < NL * I_L; it += NGW) {
        const int l = it / I_L; int r = it % I_L;
        unsigned char* wl = ws + WS_WL + (size_t)l * WL_STRIDE;
        if (r < I_IN) { const int kb = r / 80, nb = r % 80; tr_item(a.in[8] + (size_t)l * D * INW, INW, kb * 64, nb * 32, a.in[7] + l * D, (bf16*)(wl + WL_IN), D, nb * 32, kb * 64, scr, lane_id()); continue; } r -= I_IN;
        if (r < I_SQ) { const int kb = r / 32, nb = r % 32; const int ks = (kb * 64 + 512) & 1023;
            const float* gain = ks < 512 ? a.in[12] + l * 512 - 0 : a.in[13] + l * 512 - 512;
            tr_item(a.in[14] + (size_t)l * D * D, D, ks, nb * 32, gain, (bf16*)(wl + WL_OUT), D, nb * 32, kb * 64, scr, lane_id()); continue; } r -= I_SQ;
        if (r < I_SQ) { const int kb = r / 32, nb = r % 32; tr_item(a.in[16] + (size_t)l * D * D, D, kb * 64, nb * 32, a.in[15] + l * D, (bf16*)(wl + WL_MQ), D, nb * 32, kb * 64, scr, lane_id()); continue; } r -= I_SQ;
        if (r < I_SQ) { const int kb = r / 32, nb = r % 32; tr_item(a.in[19] + (size_t)l * D * D, D, kb * 64, nb * 32, nullptr, (bf16*)(wl + WL_MO), D, nb * 32, kb * 64, scr, lane_id()); continue; } r -= I_SQ;
        if (r < 2 * I_G) { const int up = r >= I_G; if (up) r -= I_G; const int kb = r / 88, nb = r % 88; const int j0 = nb * 32;
            tr_item(a.in[up ? 22 : 21] + (size_t)l * D * DFF, DFF, kb * 64, j0, a.in[20] + l * D, (bf16*)(wl + WL_GU), D, 256 * (j0 >> 7) + (up ? 128 : 0) + (j0 & 127), kb * 64, scr, lane_id()); continue; } r -= 2 * I_G;
        if (r < I_G) { const int kb = r / 32, nb = r % 32; tr_item(a.in[23] + (size_t)l * DFF * D, D, kb * 64, nb * 32, nullptr, (bf16*)(wl + WL_DN), DFF, nb * 32, kb * 64, scr, lane_id()); continue; } r -= I_G;
        { const int isv = r >= I_SQ; if (isv) r -= I_SQ; const int kb = r / 32, nb = r % 32;
          tr_item(a.in[isv ? 18 : 17] + (size_t)l * D * D, D, kb * 64, nb * 32, nullptr, (bf16*)(ws + WS_WMKV), D, (l * 2 + isv) * 1024 + nb * 32, kb * 64, scr, lane_id()); }
    }
    float* XF = (float*)(ws + WS_XF); bf16* XB = (bf16*)(ws + WS_XB); float* SSQ = (float*)(ws + WS_SSQ);
    for (int m = gw; m < M; m += NGW) {
        const float* src = m < MP ? a.in[0] + (size_t)m * D : a.in[1] + (size_t)(m - MP) * D;
        f32x4 v[4]; float s = 0.f;
#pragma unroll
        for (int j = 0; j < 4; ++j) { v[j] = ((const f32x4*)src)[lane_id() + 64 * j]; s += (v[j][0] * v[j][0] + v[j][1] * v[j][1]) + (v[j][2] * v[j][2] + v[j][3] * v[j][3]); }
#pragma unroll
        for (int o = 1; o < 64; o <<= 1) s += __shfl_xor(s, o);
#pragma unroll
        for (int j = 0; j < 4; ++j) { ((f32x4*)(XF + (size_t)m * D))[lane_id() + 64 * j] = v[j]; v2u w; w.x = cvtpk(v[j][0], v[j][1]); w.y = cvtpk(v[j][2], v[j][3]); ((v2u*)(XB + (size_t)m * D))[lane_id() + 64 * j] = w; }
        if (lane_id() < 16) SSQ[(size_t)m * 16 + lane_id()] = lane_id() == 0 ? s : 0.f;
    }
    { const f32x4* src = (const f32x4*)a.in[6]; v2u* dst = (v2u*)(ws + WS_MEMB); const int gt = F.bid * 512 + (F.wave * 64 + lane_id()), NT = F.G * 512;
      for (int i = gt; i < NB * NMEM * D / 4; i += NT) { const f32x4 v = src[i]; v2u w; w.x = cvtpk(v[0], v[1]); w.y = cvtpk(v[2], v[3]); dst[i] = w; } }
}

__device__ __forceinline__ void sgu_unit(const Args& a, const Frame& F, int l, int unit) {
    unsigned char* ws = a.ws;
    const bf16* VA = (const bf16*)(ws + WS_VA); const bf16* U = (const bf16*)(ws + WS_U); bf16* CAT = (bf16*)(ws + WS_CAT);
    const bool smp = unit >= 128; const int R0 = smp ? MP + 128 * (unit - 128) : 128 * unit;
    const float* gv = a.in[9] + l * 512; const float* Wl = a.in[10] + (size_t)l * 4 * 128 * 128; const float* bl = a.in[11] + l * 512;
    float* sguv = out_sguv_s(a.out) + (size_t)l * MS * 512;
    int tid_ = F.wave * 64 + lane_id(); asm volatile("" : "+v"(tid_));
    const int tid = tid_, lane = tid & 63, w = F.wave;
#pragma unroll 4
    for (int i = 0; i < 16; ++i) { const int c = tid + 512 * i, row = c >> 6, ch = c & 63, g = ch >> 4, c16 = ch & 15;
        const v4u raw = *(const GAS v4u*)(VA + (size_t)(R0 + row) * 512 + ch * 8);
        float x[8] = {bf_lo(raw.x), bf_hi(raw.x), bf_lo(raw.y), bf_hi(raw.y), bf_lo(raw.z), bf_hi(raw.z), bf_lo(raw.w), bf_hi(raw.w)};
        float ss = 0.f;
#pragma unroll
        for (int j = 0; j < 8; ++j) ss += x[j] * x[j];
        ss += __shfl_xor(ss, 1); ss += __shfl_xor(ss, 2); ss += __shfl_xor(ss, 4); ss += __shfl_xor(ss, 8);
        const float rstd = __builtin_amdgcn_rsqf(ss * (1.0f / 128.0f) + EPS);
        const f32x4 g0 = *(const f32x4*)(gv + ch * 8), g1 = *(const f32x4*)(gv + ch * 8 + 4);
        f32x4 y0, y1;
#pragma unroll
        for (int j = 0; j < 4; ++j) { y0[j] = x[j] * rstd * g0[j]; y1[j] = x[4 + j] * rstd * g1[j]; }
        if (smp) { float* o = sguv + (size_t)(R0 - MP + row) * 512 + ch * 8; *(f32x4*)o = y0; *(f32x4*)(o + 4) = y1; }
        v4u pk; pk.x = cvtpk(y0[0], y0[1]); pk.y = cvtpk(y0[2], y0[3]); pk.z = cvtpk(y1[0], y1[1]); pk.w = cvtpk(y1[2], y1[3]);
        *(LAS v4u*)(F.lds + g * 32768 + row * 256 + ((((c16 >> 2) ^ (row & 3)) << 2) | (c16 & 3)) * 16) = pk; }
    __syncthreads();
    const int g = w >> 1, eh = w & 1, r32 = lane & 31, hi = lane >> 5;
    const int g4 = lane >> 4, cb = g4 & 1, q4 = (lane & 15) >> 2, p4 = lane & 3;
    unsigned stash[4][2][8];
    const unsigned tile = F.lds0 + g * 32768;
#pragma unroll
    for (int i = 0; i < 4; ++i) {
        f32x16 acc[2];
#pragma unroll
        for (int r = 0; r < 16; ++r) { acc[0][r] = 0.f; acc[1][r] = 0.f; }
#pragma unroll
        for (int ks = 0; ks < 8; ++ks) { if (ks > 2 * i + 1) continue;
            const int t = 32 * i + r32, s0 = 16 * ks + 8 * hi;
            float wv[8];
            if (!smp) { const f32x4 w0 = *(const f32x4*)(Wl + (size_t)(g * 128 + t) * 128 + s0), w1 = *(const f32x4*)(Wl + (size_t)(g * 128 + t) * 128 + s0 + 4);
#pragma unroll
                for (int j = 0; j < 4; ++j) { wv[j] = (s0 + j <= t) ? w0[j] : 0.f; wv[4 + j] = (s0 + 4 + j <= t) ? w1[j] : 0.f; } }
            else { const int tt = t & 15, seg = t >> 4, ss0 = 8 * hi; const bool same = (ks == seg);
                const f32x4 w0 = *(const f32x4*)(Wl + (size_t)(g * 128 + tt) * 128 + ss0), w1 = *(const f32x4*)(Wl + (size_t)(g * 128 + tt) * 128 + ss0 + 4);
#pragma unroll
                for (int j = 0; j < 4; ++j) { wv[j] = (same && ss0 + j <= tt) ? w0[j] : 0.f; wv[4 + j] = (same && ss0 + 4 + j <= tt) ? w1[j] : 0.f; } }
            v4u apk; apk.x = cvtpk(wv[0], wv[1]); apk.y = cvtpk(wv[2], wv[3]); apk.z = cvtpk(wv[4], wv[5]); apk.w = cvtpk(wv[6], wv[7]);
            const bf16x8 af = __builtin_bit_cast(bf16x8, apk);
#pragma unroll
            for (int nb = 0; nb < 2; ++nb) { const int colb = (eh * 64 + nb * 32 + 16 * cb + 4 * p4) * 2;
                const int srow = 16 * ks + 8 * hi + q4;
                const unsigned ad0 = tile + srow * 256 + ((((colb >> 6) ^ q4) << 6) | (colb & 63)), ad1 = ad0 + 4 * 256;
                const s16x4 b0 = tr_read(ad0), b1 = tr_read(ad1);
                const bf16x8 bfr = (bf16x8){b0[0], b0[1], b0[2], b0[3], b1[0], b1[1], b1[2], b1[3]};
                acc[nb] = MFMA32(af, bfr, acc[nb]); }
            asm volatile("" ::: "memory"); }
#pragma unroll
        for (int nb = 0; nb < 2; ++nb) { const int e = g * 128 + eh * 64 + nb * 32 + r32;
#pragma unroll
            for (int k = 0; k < 8; ++k) { float v[2];
#pragma unroll
                for (int q = 0; q < 2; ++q) { const int t = 32 * i + crow(2 * k + q, hi); const float bias = bl[g * 128 + (smp ? (t & 15) : t)];
                    const float uu = __uint_as_float((unsigned)U[(size_t)(R0 + t) * 512 + e] << 16); v[q] = uu * (acc[nb][2 * k + q] + bias); }
                stash[i][nb][k] = cvtpk(v[0], v[1]); }
            asm volatile("" ::: "memory"); }
    }
    __syncthreads();
#pragma unroll
    for (int i = 0; i < 4; ++i)
#pragma unroll
        for (int nb = 0; nb < 2; ++nb) { const int e = g * 128 + eh * 64 + nb * 32 + r32;
#pragma unroll
            for (int k = 0; k < 8; ++k) { const int t0 = 32 * i + crow(2 * k, hi), t1 = 32 * i + crow(2 * k + 1, hi);
                *(LAS bf16*)(F.lds + t0 * 1024 + e * 2) = (bf16)(stash[i][nb][k] & 0xffffu); *(LAS bf16*)(F.lds + t1 * 1024 + e * 2) = (bf16)(stash[i][nb][k] >> 16); } }
    __syncthreads();
#pragma unroll 4
    for (int i = 0; i < 16; ++i) { const int c = tid + 512 * i, row = c >> 6, ch = c & 63;
        const v4u raw = *(const LAS v4u*)(F.lds + row * 1024 + ch * 16);
        float x[8] = {bf_lo(raw.x), bf_hi(raw.x), bf_lo(raw.y), bf_hi(raw.y), bf_lo(raw.z), bf_hi(raw.z), bf_lo(raw.w), bf_hi(raw.w)};
        float ss = 0.f;
#pragma unroll
        for (int j = 0; j < 8; ++j) ss += x[j] * x[j];
#pragma unroll
        for (int o = 1; o < 64; o <<= 1) ss += __shfl_xor(ss, o);
        const float rstd = __builtin_amdgcn_rsqf(ss * (1.0f / 512.0f) + EPS);
        v4u pk; pk.x = cvtpk(x[0] * rstd, x[1] * rstd); pk.y = cvtpk(x[2] * rstd, x[3] * rstd); pk.z = cvtpk(x[4] * rstd, x[5] * rstd); pk.w = cvtpk(x[6] * rstd, x[7] * rstd);
        *(GAS v4u*)(CAT + (size_t)(R0 + row) * 1024 + 512 + ch * 8) = pk; }
    __syncthreads();
}

template <bool SMP> __device__ __forceinline__ void sb_unit(const Args& a, const Frame& F, int l, int uidx) {
    unsigned char* ws = a.ws;
    const bf16* Qb = (const bf16*)(ws + WS_Q); const bf16* Kb = (const bf16*)(ws + WS_K); const bf16* Vb = (const bf16*)(ws + WS_V);
    bf16* CAT = (bf16*)(ws + WS_CAT); float* SBSS = (float*)(ws + WS_SBSS);
    int lane_ = lane_id(); asm volatile("" : "+v"(lane_));
    const int lane = lane_, r32 = lane & 31, hi = lane >> 5;
    int h, rowq0, nq, krow0 = 0, bs = 0, t0 = 0, jt;
    if (!SMP) { const int tb = uidx & 127, bh = uidx >> 7; h = bh & 7; const int b = bh >> 3; t0 = 32 * tb; rowq0 = b * T + t0; krow0 = b * T; nq = 32; jt = t0 >> 6; }
    else { h = uidx & 7; bs = uidx >> 3; rowq0 = MP + bs * NS; nq = NS; jt = PAST / 64; }
    const int tq = SMP ? PAST + (r32 < NS ? r32 : NS - 1) : t0 + r32;
    const float* ck = a.in[2] + ((size_t)(l * BS + bs) * PAST) * 512 + h * 64; const float* cv = a.in[3] + ((size_t)(l * BS + bs) * PAST) * 512 + h * 64;
    bf16x8 qf[4];
#pragma unroll
    for (int d0 = 0; d0 < 4; ++d0) qf[d0] = __builtin_bit_cast(bf16x8, *(const GAS v4u*)(Qb + (size_t)(rowq0 + (r32 < nq ? r32 : nq - 1)) * 512 + h * 64 + d0 * 16 + hi * 8));
    f32x16 o[2];
#pragma unroll
    for (int r = 0; r < 16; ++r) { o[0][r] = 0.f; o[1][r] = 0.f; }
    float R = 0.f;
    LAS unsigned char* vt = F.lds + F.wave * 16384;
    const unsigned vt0 = F.lds0 + F.wave * 16384;
    const int g4 = lane >> 4, cb = g4 & 1, q4 = (lane & 15) >> 2, p4 = lane & 3;
    for (; jt >= 0; --jt) {
        bf16x8 kf[2][4];
        if (!SMP || jt == PAST / 64) {
#pragma unroll
            for (int mb = 0; mb < 2; ++mb) { const int kv = 32 * mb + r32;
                const bf16* kp = Kb + (size_t)(SMP ? MP + bs * NS + (kv < NS ? kv : NS - 1) : krow0 + 64 * jt + kv) * 512 + h * 64 + hi * 8;
#pragma unroll
                for (int d0 = 0; d0 < 4; ++d0) kf[mb][d0] = __builtin_bit_cast(bf16x8, *(const GAS v4u*)(kp + d0 * 16)); }
#pragma unroll
            for (int i = 0; i < 8; ++i) { const int c = lane + 64 * i, row = c >> 3, ch = c & 7;
                const v4u v = *(const GAS v4u*)(Vb + (size_t)(SMP ? MP + bs * NS + (row < NS ? row : NS - 1) : krow0 + 64 * jt + row) * 512 + h * 64 + ch * 8);
                *(LAS v4u*)(vt + row * 144 + ch * 16) = v; }
        } else {
#pragma unroll
            for (int mb = 0; mb < 2; ++mb) { const float* kp = ck + (size_t)(64 * jt + 32 * mb + r32) * 512 + hi * 8;
#pragma unroll
                for (int d0 = 0; d0 < 4; ++d0) { const f32x4 x0 = *(const f32x4*)(kp + d0 * 16), x1 = *(const f32x4*)(kp + d0 * 16 + 4);
                    v4u v; v.x = cvtpk(x0[0], x0[1]); v.y = cvtpk(x0[2], x0[3]); v.z = cvtpk(x1[0], x1[1]); v.w = cvtpk(x1[2], x1[3]); kf[mb][d0] = __builtin_bit_cast(bf16x8, v); } }
#pragma unroll
            for (int i = 0; i < 8; ++i) { const int c = lane + 64 * i, row = c >> 3, ch = c & 7; const float* vp = cv + (size_t)(64 * jt + row) * 512 + ch * 8;
                const f32x4 x0 = *(const f32x4*)vp, x1 = *(const f32x4*)(vp + 4);
                v4u v; v.x = cvtpk(x0[0], x0[1]); v.y = cvtpk(x0[2], x0[3]); v.z = cvtpk(x1[0], x1[1]); v.w = cvtpk(x1[2], x1[3]);
                *(LAS v4u*)(vt + row * 144 + ch * 16) = v; }
        }
        f32x16 p0, p1;
#pragma unroll
        for (int r = 0; r < 16; ++r) { p0[r] = 0.f; p1[r] = 0.f; }
#pragma unroll
        for (int d0 = 0; d0 < 4; ++d0) { p0 = MFMA32(kf[0][d0], qf[d0], p0); p1 = MFMA32(kf[1][d0], qf[d0], p1); }
        const bool diag = SMP ? (jt == PAST / 64) : (64 * jt + 63 >= t0);
        if (diag) {
#pragma unroll
            for (int r = 0; r < 16; ++r) { const int kp = 64 * jt + crow(r, hi); if (kp >= tq) p0[r] = -1e30f; if (kp + 32 >= tq) p1[r] = -1e30f; } }
        float cw[32];
#pragma unroll
        for (int r = 0; r < 16; ++r) { cw[r] = __builtin_amdgcn_logf(1.0f + __builtin_amdgcn_exp2f(p0[r])); cw[16 + r] = __builtin_amdgcn_logf(1.0f + __builtin_amdgcn_exp2f(p1[r])); }
        float gs[8], oth[8];
#pragma unroll
        for (int gq = 0; gq < 8; ++gq) { cw[4 * gq + 2] += cw[4 * gq + 3]; cw[4 * gq + 1] += cw[4 * gq + 2]; cw[4 * gq] += cw[4 * gq + 1]; gs[gq] = cw[4 * gq]; }
#pragma unroll
        for (int gq = 0; gq < 8; ++gq) oth[gq] = __shfl_xor(gs[gq], 32);
        float off[8]; float tail = 0.f;
#pragma unroll
        for (int gq = 7; gq >= 0; --gq) { off[gq] = tail + (hi == 0 ? oth[gq] : 0.f) + R; tail += gs[gq] + oth[gq]; }
        R += tail;
#pragma unroll
        for (int r = 0; r < 16; ++r) { p0[r] = __builtin_amdgcn_exp2f(p0[r] - cw[r] - off[r >> 2]); p1[r] = __builtin_amdgcn_exp2f(p1[r] - cw[16 + r] - off[4 + (r >> 2)]); }
        unsigned pk[16];
#pragma unroll
        for (int i = 0; i < 8; ++i) { pk[i] = cvtpk(p0[2 * i], p0[2 * i + 1]); pk[8 + i] = cvtpk(p1[2 * i], p1[2 * i + 1]); }
#pragma unroll
        for (int ks = 0; ks < 4; ++ks) { const bf16x8 pf = __builtin_bit_cast(bf16x8, (v4u){pk[4 * ks], pk[4 * ks + 1], pk[4 * ks + 2], pk[4 * ks + 3]});
#pragma unroll
            for (int nb = 0; nb < 2; ++nb) { const unsigned ad0 = vt0 + (16 * ks + 4 * hi + q4) * 144 + (32 * nb + 16 * cb + 4 * p4) * 2, ad1 = ad0 + 8 * 144;
                const s16x4 b0 = tr_read(ad0), b1 = tr_read(ad1);
                const bf16x8 vf = (bf16x8){b0[0], b0[1], b0[2], b0[3], b1[0], b1[1], b1[2], b1[3]};
                o[nb] = MFMA32(pf, vf, o[nb]); } }
        const float Reff = (r32 < nq) ? R : 1e30f;
        if (__all(Reff >= SB_EXIT)) break;
    }
    float ssq[16];
#pragma unroll
    for (int r = 0; r < 16; ++r) { ssq[r] = o[0][r] * o[0][r] + o[1][r] * o[1][r];
#pragma unroll
        for (int ofs = 1; ofs < 32; ofs <<= 1) ssq[r] += __shfl_xor(ssq[r], ofs); }
#pragma unroll
    for (int r = 0; r < 16; ++r) { if (SMP && r >= 8) continue;
        const int q = crow(r, hi); bf16* op = CAT + (size_t)(rowq0 + q) * 1024 + h * 64 + r32;
        op[0] = (bf16)(cvtpk(o[0][r], 0.f) & 0xffffu); op[32] = (bf16)(cvtpk(o[1][r], 0.f) & 0xffffu);
        SBSS[(size_t)(rowq0 + q) * 8 + h] = ssq[r]; }
}

template <bool SMP> __device__ __forceinline__ void mem_unit(const Args& a, const Frame& F, int l, int uidx) {
    unsigned char* ws = a.ws;
    const bf16* QM = (const bf16*)(ws + WS_QM); bf16* OM = (bf16*)(ws + WS_OM);
    int lane_ = lane_id(); asm volatile("" : "+v"(lane_));
    const int lane = lane_, r32 = lane & 31, hi = lane >> 5;
    int h, rowq0, nq, b = 0;
    if (!SMP) { const int rb = uidx & 127, bh = uidx >> 7; h = bh & 3; b = bh >> 2; rowq0 = b * T + 32 * rb; nq = 32; }
    else { h = uidx & 3; b = uidx >> 2; rowq0 = MP + b * NS; nq = NS; }
    const bf16* MKp = (const bf16*)(ws + WS_MK) + (size_t)(l * 4 + b) * 256 * 1024 + h * 256;
    const bf16* MVp = (const bf16*)(ws + WS_MVT) + ((size_t)(l * 4 + b) * 1024 + h * 256) * 256;
    const float* ckp = a.in[4] + (size_t)(l * BS + b) * NMEM * D + h * 256; const float* cvp = a.in[5] + (size_t)(l * BS + b) * NMEM * D + h * 256;
    f32x16 s[8];
#pragma unroll
    for (int kb = 0; kb < 8; ++kb)
#pragma unroll
        for (int r = 0; r < 16; ++r) s[kb][r] = 0.f;
#pragma unroll 1
    for (int d0 = 0; d0 < 16; ++d0) {
        const bf16x8 qf = __builtin_bit_cast(bf16x8, *(const GAS v4u*)(QM + (size_t)(rowq0 + (r32 < nq ? r32 : nq - 1)) * 1024 + h * 256 + d0 * 16 + hi * 8));
#pragma unroll
        for (int kb = 0; kb < 8; ++kb) { bf16x8 kf;
            if (!SMP) kf = __builtin_bit_cast(bf16x8, *(const GAS v4u*)(MKp + (size_t)(32 * kb + r32) * 1024 + d0 * 16 + hi * 8));
            else { const float* kp = ckp + (size_t)(32 * kb + r32) * 1024 + d0 * 16 + hi * 8; const f32x4 x0 = *(const f32x4*)kp, x1 = *(const f32x4*)(kp + 4);
                v4u v; v.x = cvtpk(x0[0], x0[1]); v.y = cvtpk(x0[2], x0[3]); v.z = cvtpk(x1[0], x1[1]); v.w = cvtpk(x1[2], x1[3]); kf = __builtin_bit_cast(bf16x8, v); }
            s[kb] = MFMA32(kf, qf, s[kb]); }
    }
    float mx = s[0][0];
#pragma unroll
    for (int kb = 0; kb < 8; ++kb)
#pragma unroll
        for (int r = 0; r < 16; ++r) mx = fmaxf(mx, s[kb][r]);
    mx = fmaxf(mx, __shfl_xor(mx, 32));
    float lsum = 0.f; unsigned pk[8][8];
#pragma unroll
    for (int kb = 0; kb < 8; ++kb) {
#pragma unroll
        for (int r = 0; r < 16; ++r) { s[kb][r] = __builtin_amdgcn_exp2f(s[kb][r] - mx); lsum += s[kb][r]; }
#pragma unroll
        for (int i = 0; i < 8; ++i) pk[kb][i] = cvtpk(s[kb][2 * i], s[kb][2 * i + 1]);
#pragma unroll
        for (int hf = 0; hf < 2; ++hf) {
            auto r0 = __builtin_amdgcn_permlane32_swap(pk[kb][4 * hf + 0], pk[kb][4 * hf + 2], false, false); pk[kb][4 * hf + 0] = r0[0]; pk[kb][4 * hf + 2] = r0[1];
            auto r1 = __builtin_amdgcn_permlane32_swap(pk[kb][4 * hf + 1], pk[kb][4 * hf + 3], false, false); pk[kb][4 * hf + 1] = r1[0]; pk[kb][4 * hf + 3] = r1[1]; }
    }
    lsum += __shfl_xor(lsum, 32);
    LAS float* wsf = (LAS float*)(F.lds + AUX_OFF) + F.wave * 64;
    if (hi == 0) wsf[r32] = lsum;
    LDS_WAIT();
    float inv[16];
#pragma unroll
    for (int r = 0; r < 16; ++r) inv[r] = __builtin_amdgcn_rcpf(wsf[crow(r, hi)]);
#pragma unroll 1
    for (int nb = 0; nb < 8; ++nb) { f32x16 o;
#pragma unroll
        for (int r = 0; r < 16; ++r) o[r] = 0.f;
#pragma unroll
        for (int ks = 0; ks < 16; ++ks) { const bf16x8 pf = __builtin_bit_cast(bf16x8, (v4u){pk[ks >> 1][4 * (ks & 1)], pk[ks >> 1][4 * (ks & 1) + 1], pk[ks >> 1][4 * (ks & 1) + 2], pk[ks >> 1][4 * (ks & 1) + 3]});
            bf16x8 vf;
            if (!SMP) vf = __builtin_bit_cast(bf16x8, *(const GAS v4u*)(MVp + (size_t)(32 * nb + r32) * 256 + 16 * ks + 8 * hi));
            else { const float* vp = cvp + (size_t)(16 * ks + 8 * hi) * 1024 + 32 * nb + r32; float x[8];
#pragma unroll
                for (int j = 0; j < 8; ++j) x[j] = vp[(size_t)j * 1024];
                v4u v; v.x = cvtpk(x[0], x[1]); v.y = cvtpk(x[2], x[3]); v.z = cvtpk(x[4], x[5]); v.w = cvtpk(x[6], x[7]); vf = __builtin_bit_cast(bf16x8, v); }
            o = MFMA32(pf, vf, o); if ((ks & 3) == 3) asm volatile("" ::: "memory"); }
#pragma unroll
        for (int r = 0; r < 16; ++r) { if (SMP && r >= 8) continue; const int q = crow(r, hi); OM[(size_t)(rowq0 + q) * 1024 + h * 256 + 32 * nb + r32] = (bf16)(cvtpk(o[r] * inv[r], 0.f) & 0xffffu); }
    }
    LDS_WAIT();
}

__global__ void __launch_bounds__(NWAVES * 64, 2) mk_fwd(Args args) {
    extern __shared__ __attribute__((aligned(16))) unsigned char lds[];
    const int wave0 = __builtin_amdgcn_readfirstlane((int)threadIdx.x >> 6);
#define PH_FRAME() Frame F; { int w_ = wave0, g_ = (int)gridDim.x, b_ = (int)blockIdx.x; unsigned l0_ = (unsigned)(uintptr_t)lds; asm volatile("" : "+s"(w_), "+s"(g_), "+s"(b_), "+s"(l0_)); \
        F.lds = (LAS unsigned char*)lds; F.lds0 = l0_; F.wave = w_; F.G = g_; F.bid = b_; } \
        unsigned char* ws = args.ws; asm volatile("" : "+s"(ws));
    gu32* ctl; { unsigned char* ws0 = args.ws; ctl = (gu32*)(ws0 + WS_CTL); }
    for (int u = wave0 * 64 + lane_id(); u < (LDS_BYTES - LDSCTL_OFF) / 4; u += NWAVES * 64) ((LAS unsigned*)((LAS unsigned char*)lds + LDSCTL_OFF))[u] = 0u;
    __syncthreads();
    XcdBarrier bar = xcd_barrier_post((unsigned*)(ctl + CW_BAR), (volatile LAS unsigned*)((LAS unsigned char*)lds + MISC_OFF) + 8, wave0 * 64 + lane_id());
    const int lo = args.ph_lo, hi_ph = args.ph_hi; int ph = 0;
#define PH_ON() (lo <= ph && ph < hi_ph)
#define PH_END() do { if (lo <= ph && ph + 1 < hi_ph) xcd_barrier(bar, wave0 * 64 + lane_id()); ++ph; } while (0)

#ifndef NO_PRO
    if (PH_ON()) { PH_FRAME(); prologue(args, F); }
#endif
    PH_END();
    if (PH_ON()) { PH_FRAME(); pg8::Gemm g{(const bf16*)(ws + WS_MEMB), (const bf16*)(ws + WS_WMKV), NB * NMEM, 8 * D, D}; pg8::StaticOrder S; S.init(NB * NMEM, 8 * D, F.G, F.bid);
              pg8::EpiKV E{out_mk_p(args.out), out_mv_p(args.out), (bf16*)(ws + WS_MK), (bf16*)(ws + WS_MVT)};
#ifndef NO_GKV
              pg8::gemm_phase<pg8::EpiKV, pg8::StaticOrder, true, true>(F.lds + RING_OFF, g, S, E, F.wave);
#endif
    }
    PH_END();
    for (int l = 0; l < NL; ++l) {
        if (PH_ON()) { PH_FRAME(); const unsigned char* wl = ws + WS_WL + (size_t)l * WL_STRIDE;
            { pg8::Gemm g{(const bf16*)(ws + WS_XB), (const bf16*)(wl + WL_IN), M, INW, D}; pg8::StaticOrder S; S.init(M, INW, F.G, F.bid);
              pg8::EpiIn E{ws, args.out, l, C_SB};
#ifndef NO_GA
              pg8::gemm_phase<pg8::EpiIn, pg8::StaticOrder, true, true>(F.lds + RING_OFF, g, S, E, F.wave);
#endif
              }
        }
        PH_END();
        if (PH_ON()) { PH_FRAME();
#ifndef NO_SGU
            if (F.bid < 132) sgu_unit(args, F, l, F.bid);
#endif
            const int gw = F.bid * NWAVES + F.wave, NGW = F.G * NWAVES;
#ifndef NO_SB
            for (int u = gw; u < NB * 8 * (T / 32); u += NGW) sb_unit<false>(args, F, l, u);
#ifndef NO_SBS
            if (NGW - 1 - gw < BS * 8) sb_unit<true>(args, F, l, NGW - 1 - gw);
#endif
#endif
            __syncthreads();
        }
        PH_END();
        if (PH_ON()) { PH_FRAME(); const unsigned char* wl = ws + WS_WL + (size_t)l * WL_STRIDE; pg8::Gemm g{(const bf16*)(ws + WS_CAT), (const bf16*)(wl + WL_OUT), M, D, D}; pg8::StaticOrder S; S.init(M, D, F.G, F.bid);
            pg8::EpiRes<true> E{ws};
#ifndef NO_GD
            pg8::gemm_phase<pg8::EpiRes<true>, pg8::StaticOrder, true, true>(F.lds + RING_OFF, g, S, E, F.wave);
#endif
            }
        PH_END();
        if (PH_ON()) { PH_FRAME(); const unsigned char* wl = ws + WS_WL + (size_t)l * WL_STRIDE; pg8::Gemm g{(const bf16*)(ws + WS_XB), (const bf16*)(wl + WL_MQ), M, D, D}; pg8::StaticOrder S; S.init(M, D, F.G, F.bid);
            pg8::EpiQ E{(const float*)(ws + WS_SSQ), (bf16*)(ws + WS_QM), C_MEM};
#ifndef NO_GE
            pg8::gemm_phase<pg8::EpiQ, pg8::StaticOrder, true, true>(F.lds + RING_OFF, g, S, E, F.wave);
#endif
            }
        PH_END();
        if (PH_ON()) { PH_FRAME();
#ifndef NO_MEM
            if (F.bid * NWAVES + F.wave < NB * 4 * (T / 32)) mem_unit<false>(args, F, l, F.bid * NWAVES + F.wave);
#ifndef NO_MEMS
            if (F.wave * F.G + F.bid < BS * 4) mem_unit<true>(args, F, l, F.wave * F.G + F.bid);
#endif
#endif
            __syncthreads();
        }
        PH_END();
        if (PH_ON()) { PH_FRAME(); const unsigned char* wl = ws + WS_WL + (size_t)l * WL_STRIDE; pg8::Gemm g{(const bf16*)(ws + WS_OM), (const bf16*)(wl + WL_MO), M, D, D}; pg8::StaticOrder S; S.init(M, D, F.G, F.bid);
            pg8::EpiRes<false> E{ws};
#ifndef NO_GG
            pg8::gemm_phase<pg8::EpiRes<false>, pg8::StaticOrder, true, true>(F.lds + RING_OFF, g, S, E, F.wave);
#endif
            }
        PH_END();
        if (PH_ON()) { PH_FRAME(); const unsigned char* wl = ws + WS_WL + (size_t)l * WL_STRIDE; pg8::Gemm g{(const bf16*)(ws + WS_XB), (const bf16*)(wl + WL_GU), M, 2 * DFF, D}; pg8::StaticOrder S; S.init(M, 2 * DFF, F.G, F.bid);
            pg8::EpiGU E{(const float*)(ws + WS_SSQ), (bf16*)(ws + WS_H)};
#ifndef NO_GH
            pg8::gemm_phase<pg8::EpiGU, pg8::StaticOrder, true, true>(F.lds + RING_OFF, g, S, E, F.wave);
#endif
            }
        PH_END();
        if (PH_ON()) { PH_FRAME(); const unsigned char* wl = ws + WS_WL + (size_t)l * WL_STRIDE; pg8::Gemm g{(const bf16*)(ws + WS_H), (const bf16*)(wl + WL_DN), M, D, DFF}; pg8::StaticOrder S; S.init(M, D, F.G, F.bid);
            pg8::EpiRes<false> E{ws};
#ifndef NO_GI
            pg8::gemm_phase<pg8::EpiRes<false>, pg8::StaticOrder, true, true>(F.lds + RING_OFF, g, S, E, F.wave);
#endif
            }
        PH_END();
    }
    if (PH_ON()) { PH_FRAME();
        const float* gf = args.in[24]; const int gw = F.bid * NWAVES + F.wave, NGW = F.G * NWAVES;
        for (int m = gw; m < M; m += NGW) {
            float s = lane_id() < 16 ? ((const float*)(ws + WS_SSQ))[(size_t)m * 16 + lane_id()] : 0.f;
            s += __shfl_xor(s, 1); s += __shfl_xor(s, 2); s += __shfl_xor(s, 4); s += __shfl_xor(s, 8);
            s = __shfl(s, 0);
            const float rstd = __builtin_amdgcn_rsqf(s * (1.0f / 1024.0f) + EPS);
            float* dst = m < MP ? out_y_p(args.out) + (size_t)m * D : out_y_s(args.out) + (size_t)(m - MP) * D;
#pragma unroll
            for (int j = 0; j < 4; ++j) { const f32x4 v = ((const f32x4*)((const float*)(ws + WS_XF) + (size_t)m * D))[lane_id() + 64 * j]; const f32x4 gg = ((const f32x4*)gf)[lane_id() + 64 * j];
                ((f32x4*)dst)[lane_id() + 64 * j] = v * rstd * gg; }
        }
    }
#undef PH_ON
#undef PH_END
}

static int mk_grid = 0;
static void mk_launch(void* const* d_in, float* out, unsigned char* ws, hipStream_t stream, int ph_lo, int ph_hi) {
    if (mk_grid == 0) {
        int dev = 0, cus = 0;
        if (hipGetDevice(&dev) != hipSuccess || hipDeviceGetAttribute(&cus, hipDeviceAttributeMultiprocessorCount, dev) != hipSuccess) { mk_grid = -1; return; }
        if (hipFuncSetAttribute((const void*)mk_fwd, hipFuncAttributeMaxDynamicSharedMemorySize, LDS_BYTES) != hipSuccess) { mk_grid = -1; return; }
        (void)hipGetLastError();
        mk_grid = cus;
    }
    if (mk_grid < 0) return;
    (void)hipMemsetAsync(ws + WS_CTL, 0, CTL_ZERO_BYTES, stream);
    Args a{};
    for (int i = 0; i < 25; ++i) a.in[i] = (const float*)d_in[i];
    a.out = out; a.ws = ws; a.ph_lo = ph_lo; a.ph_hi = ph_hi;
    hipLaunchKernelGGL(mk_fwd, dim3(mk_grid), dim3(NWAVES * 64), LDS_BYTES, stream, a);
}
extern "C" void kernel_launch(void* const* d_in, const int* in_sizes, int n_in, void* d_out, int out_size, void* d_ws, size_t ws_size, hipStream_t stream) {
    mk_launch(d_in, (float*)d_out, (unsigned char*)d_ws, stream, 0, 35);
}
```

```cpp
#include <hip/hip_runtime.h>
#include <cstdint>
#include <cstdio>
#include <cmath>
namespace pg8 {
#define PG8_LAS __attribute__((address_space(3)))
typedef unsigned short bf16_t;
typedef short bf16x8 __attribute__((ext_vector_type(8)));
typedef float f32x4 __attribute__((ext_vector_type(4)));
typedef unsigned u32x4 __attribute__((ext_vector_type(4)));
constexpr int BM = 256, BK = 64, HALF = 128, HTB = HALF * BK * 2  , STAGE_BYTES = 8 * HTB, NXCD = 8, WGM = 8;

__host__ __device__ __forceinline__ int lds_byte(int r, int c) { const int st = (r >> 4) * 2 + (c >> 5), rr = r & 15, cc = c & 31, ob = rr * 64 + cc * 2; return st * 1024 + (ob ^ (((ob >> 9) & 1) << 5)); }
__host__ __device__ __forceinline__ void stage_rc(int b, int& R, int& C) { const int st = b / 1024, sb = b % 1024, swz = sb ^ (((sb >> 9) & 1) << 5); R = (st >> 1) * 16 + swz / 64; C = (st & 1) * 32 + (swz % 64) / 2; }
__host__ __device__ __forceinline__ int perm32(int rho) { const int n = rho >> 4, i = rho & 15; return 8 * (i >> 2) + 4 * n + (i & 3); }

struct Unit { int pm, pn; };
struct Gemm { const bf16_t* A; const bf16_t* Bt; int M, N, K; };

struct StaticOrder {
    int nM, nN, nwg, G, c;
    __host__ __device__ void init(int M, int N, int G_, int c_) { nM = M / BM; nN = N / BM; nwg = nM * nN; G = G_; c = c_; }
    __host__ __device__ bool next(int i, Unit& u) const {
        const long L = (long)i * G + c; if (L >= nwg) return false;
        int wgid = (int)L; { const int q = nwg / NXCD, r = nwg % NXCD, xcd = wgid % NXCD, off = wgid / NXCD; wgid = (xcd < r ? xcd * (q + 1) : r * (q + 1) + (xcd - r) * q) + off; }
        const int nig = WGM * nN, gid = wgid / nig, fm = gid * WGM, gsz = (nM - fm) < WGM ? (nM - fm) : WGM;
        u.pm = fm + ((wgid % nig) % gsz); u.pn = (wgid % nig) / gsz; return true;
    }
    __device__ __forceinline__ void a_ready(const Unit&) const {}
    __device__ __forceinline__ void done(const Unit&) const {}
};

__device__ __forceinline__ unsigned cvt_pk_bf16(float lo, float hi) { unsigned r; asm volatile("v_cvt_pk_bf16_f32 %0, %1, %2" : "=v"(r) : "v"(lo), "v"(hi)); return r; }
typedef float f32x2 __attribute__((ext_vector_type(2)));
constexpr int E_MP = 16384, E_MS = 512;
constexpr size_t EMiB = 1u << 20, EW_SSQ = 148 * EMiB, EW_SBSS = 150 * EMiB, EW_SASS = 527 * EMiB, EW_XF = 152 * EMiB, EW_XB = 218 * EMiB, EW_U = 251 * EMiB, EW_VA = 268 * EMiB, EW_Q = 285 * EMiB, EW_K = 302 * EMiB, EW_V = 319 * EMiB;
constexpr size_t EO_SBK_P = (size_t)16896 * 1024, EO_SBV_P = EO_SBK_P + (size_t)4 * 16384 * 512, EO_MK_P = EO_SBV_P + (size_t)4 * 16384 * 512, EO_MV_P = EO_MK_P + (size_t)4 * 4 * 256 * 1024, EO_SBK_S = EO_MV_P + (size_t)4 * 4 * 256 * 1024, EO_SBV_S = EO_SBK_S + (size_t)4 * 512 * 512;
constexpr float E_EPS = 1e-6f, E_LOG2E = 1.4426950408889634f;
typedef unsigned u32x2 __attribute__((ext_vector_type(2)));
__device__ __forceinline__ void load_rstd(const float* SSQ, int row0, int fq, float (&rs)[2][4]) {
#pragma unroll
    for (int ai = 0; ai < 2; ++ai)
#pragma unroll
        for (int m = 0; m < 4; ++m) { const f32x4 a = *(const f32x4*)(SSQ + (size_t)(row0 + ai * HALF + m * 16) * 16 + fq * 4);
            float s = (a[0] + a[1]) + (a[2] + a[3]); s += __shfl_xor(s, 16); s += __shfl_xor(s, 32);
            rs[ai][m] = __builtin_amdgcn_rsqf(s * (1.0f / 1024.0f) + E_EPS); }
}
__device__ __forceinline__ float gelu_tanh_f(float x) {
    const float y = x * (1.0f + 0.044715f * x * x);
    const float e = __builtin_amdgcn_exp2f(y * (-2.0f * 0.7978845608028654f * E_LOG2E));
    return x * __builtin_amdgcn_rcpf(1.0f + e);
}
__device__ __forceinline__ u32x4 pack8(const f32x4 a, const f32x4 b) { u32x4 w; w.x = cvt_pk_bf16(a[0], a[1]); w.y = cvt_pk_bf16(a[2], a[3]); w.z = cvt_pk_bf16(b[0], b[1]); w.w = cvt_pk_bf16(b[2], b[3]); return w; }

struct EpiIn {
    static constexpr bool PERM = true, AFTER_DRAIN = false, MIDSCALE = false; static constexpr int MID_T = 0;
    unsigned char* ws; float* out; int l; float qscale;
    __device__ __forceinline__ void midscale(f32x4 (&)[2][2][4][2], const Unit&, int, int, int) const {}
    __device__ __forceinline__ void prepare(const Unit&, int, int) const {}
    __device__ __forceinline__ void operator()(const f32x4 (&acc)[2][2][4][2], const Unit& u, int wr, int wc, int fr, int fq, int ui) const {
        unsigned char* w = ws; float* o = out; asm volatile("" : "+s"(w), "+s"(o));
        const int row0 = u.pm * BM + wr * 64 + fr, typ = u.pn >> 1, col0 = (u.pn & 1) * 256 + wc * 32 + 8 * fq;
        float rs[2][4]; load_rstd((const float*)(w + EW_SSQ), row0, fq, rs);
        bf16_t* ob = (bf16_t*)(w + (typ == 0 ? EW_U : typ == 1 ? EW_VA : typ == 2 ? EW_Q : typ == 3 ? EW_K : EW_V));
        float* of = nullptr;
        if (typ >= 3) { const bool smp = u.pm * BM >= E_MP;
            of = o + (smp ? (typ == 3 ? EO_SBK_S : EO_SBV_S) + (size_t)l * E_MS * 512 - (size_t)E_MP * 512 : (typ == 3 ? EO_SBK_P : EO_SBV_P) + (size_t)l * E_MP * 512); }
#pragma unroll
        for (int ai = 0; ai < 2; ++ai)
#pragma unroll
            for (int m = 0; m < 4; ++m) { const int row = row0 + ai * HALF + m * 16; const float r = rs[ai][m];
#pragma unroll
                for (int bj = 0; bj < 2; ++bj) { f32x4 v0 = acc[ai][bj][m][0] * r, v1 = acc[ai][bj][m][1] * r; const size_t off = (size_t)row * 512 + col0 + bj * HALF;
                    if (typ <= 1) {
#pragma unroll
                        for (int i = 0; i < 4; ++i) { v0[i] = gelu_tanh_f(v0[i]); v1[i] = gelu_tanh_f(v1[i]); } }
                    else if (typ == 2) { v0 = v0 * qscale; v1 = v1 * qscale; }
                    else { *(f32x4*)(of + off) = v0; *(f32x4*)(of + off + 4) = v1; }
                    *(u32x4*)(ob + off) = pack8(v0, v1); }
                asm volatile("" ::: "memory"); }
    }
};
template <bool MID> struct EpiRes {
    static constexpr bool PERM = false, AFTER_DRAIN = false, MIDSCALE = MID; static constexpr int MID_T = 8;
    unsigned char* ws; PG8_LAS float* aux;
    __device__ __forceinline__ void prepare(const Unit& u, int ui, int tid) const {
        if (MID && tid < 256) { unsigned char* w = ws; asm volatile("" : "+s"(w)); const float* SBSS = (const float*)(w + EW_SBSS); const float* SASS = (const float*)(w + EW_SASS);
            const size_t row = (size_t)(u.pm * BM + tid);
            const f32x4 b0 = *(const f32x4*)(SBSS + row * 8), b1 = *(const f32x4*)(SBSS + row * 8 + 4);
            const f32x4 a0 = *(const f32x4*)(SASS + row * 16), a1 = *(const f32x4*)(SASS + row * 16 + 4), a2 = *(const f32x4*)(SASS + row * 16 + 8), a3 = *(const f32x4*)(SASS + row * 16 + 12);
            const float sb = ((b0[0] + b0[1]) + (b0[2] + b0[3])) + ((b1[0] + b1[1]) + (b1[2] + b1[3]));
            const float sa = (((a0[0] + a0[1]) + (a0[2] + a0[3])) + ((a1[0] + a1[1]) + (a1[2] + a1[3]))) + (((a2[0] + a2[1]) + (a2[2] + a2[3])) + ((a3[0] + a3[1]) + (a3[2] + a3[3])));
            const float rb = __builtin_amdgcn_rsqf(sb * (1.0f / 512.0f) + E_EPS), qa = sa * (1.0f / 512.0f) + E_EPS;
            aux[(ui & 1) * 512 + tid] = rb * __builtin_amdgcn_sqrtf(qa); aux[(ui & 1) * 512 + 256 + tid] = __builtin_amdgcn_rsqf(qa); }
    }
    __device__ __forceinline__ void midscale(f32x4 (&acc)[2][2][4][2], const Unit& u, int wr, int fr, int ui) const {
#pragma unroll
        for (int ai = 0; ai < 2; ++ai)
#pragma unroll
            for (int m = 0; m < 4; ++m) { const float r = aux[(ui & 1) * 512 + ai * HALF + wr * 64 + m * 16 + fr];
#pragma unroll
                for (int bj = 0; bj < 2; ++bj)
#pragma unroll
                    for (int n = 0; n < 2; ++n) acc[ai][bj][m][n] = acc[ai][bj][m][n] * r; }
    }
    __device__ __forceinline__ void operator()(const f32x4 (&acc)[2][2][4][2], const Unit& u, int wr, int wc, int fr, int fq, int ui) const {
        unsigned char* w = ws; asm volatile("" : "+s"(w)); float* XF = (float*)(w + EW_XF); bf16_t* XB = (bf16_t*)(w + EW_XB); float* SSQ = (float*)(w + EW_SSQ);
        const int row0 = u.pm * BM + wr * 64 + fr, col0 = u.pn * BM + wc * 32 + 4 * fq;
#pragma unroll
        for (int ai = 0; ai < 2; ++ai)
#pragma unroll
            for (int m = 0; m < 4; ++m) { const int row = row0 + ai * HALF + m * 16; float ss = 0.f, ra = 1.0f;
                if (MID) ra = aux[(ui & 1) * 512 + 256 + ai * HALF + wr * 64 + m * 16 + fr];
#pragma unroll
                for (int bj = 0; bj < 2; ++bj)
#pragma unroll
                    for (int n = 0; n < 2; ++n) { const size_t off = (size_t)row * 1024 + col0 + bj * HALF + n * 16;
                        const f32x4 x = *(const f32x4*)(XF + off) + (MID ? acc[ai][bj][m][n] * ra : acc[ai][bj][m][n]);
                        *(f32x4*)(XF + off) = x; u32x2 wv; wv.x = cvt_pk_bf16(x[0], x[1]); wv.y = cvt_pk_bf16(x[2], x[3]); *(u32x2*)(XB + off) = wv;
                        ss += (x[0] * x[0] + x[1] * x[1]) + (x[2] * x[2] + x[3] * x[3]); }
                ss += __shfl_xor(ss, 16); ss += __shfl_xor(ss, 32);
                if (fq == 0) SSQ[(size_t)row * 16 + u.pn * 4 + wc] = ss;
                if (m & 1) asm volatile("" ::: "memory"); }
    }
};
struct EpiQ {
    static constexpr bool PERM = true, AFTER_DRAIN = false, MIDSCALE = false; static constexpr int MID_T = 0;
    const float* SSQ; bf16_t* QM; float qscale;
    __device__ __forceinline__ void midscale(f32x4 (&)[2][2][4][2], const Unit&, int, int, int) const {}
    __device__ __forceinline__ void prepare(const Unit&, int, int) const {}
    __device__ __forceinline__ void operator()(const f32x4 (&acc)[2][2][4][2], const Unit& u, int wr, int wc, int fr, int fq, int ui) const {
        const int row0 = u.pm * BM + wr * 64 + fr, col0 = u.pn * BM + wc * 32 + 8 * fq;
        float rs[2][4]; load_rstd(SSQ, row0, fq, rs);
#pragma unroll
        for (int ai = 0; ai < 2; ++ai)
#pragma unroll
            for (int m = 0; m < 4; ++m) { const float r = rs[ai][m] * qscale; bf16_t* rowp = QM + (size_t)(row0 + ai * HALF + m * 16) * 1024 + col0;
#pragma unroll
                for (int bj = 0; bj < 2; ++bj) *(u32x4*)(rowp + bj * HALF) = pack8(acc[ai][bj][m][0] * r, acc[ai][bj][m][1] * r); }
    }
};
struct EpiGU {
    static constexpr bool PERM = true, AFTER_DRAIN = false, MIDSCALE = false; static constexpr int MID_T = 0;
    const float* SSQ; bf16_t* H;
    __device__ __forceinline__ void midscale(f32x4 (&)[2][2][4][2], const Unit&, int, int, int) const {}
    __device__ __forceinline__ void prepare(const Unit&, int, int) const {}
    __device__ __forceinline__ void operator()(const f32x4 (&acc)[2][2][4][2], const Unit& u, int wr, int wc, int fr, int fq, int ui) const {
        const int row0 = u.pm * BM + wr * 64 + fr, col0 = u.pn * HALF + wc * 32 + 8 * fq;
        float rs[2][4]; load_rstd(SSQ, row0, fq, rs);
#pragma unroll
        for (int ai = 0; ai < 2; ++ai)
#pragma unroll
            for (int m = 0; m < 4; ++m) { const float r = rs[ai][m]; f32x4 h[2];
#pragma unroll
                for (int n = 0; n < 2; ++n) { const f32x4 g = acc[ai][0][m][n] * r, uu = acc[ai][1][m][n] * r;
#pragma unroll
                    for (int i = 0; i < 4; ++i) h[n][i] = g[i] * uu[i] * __builtin_amdgcn_rcpf(1.0f + __builtin_amdgcn_exp2f(-E_LOG2E * g[i])); }
                *(u32x4*)(H + (size_t)(row0 + ai * HALF + m * 16) * 2816 + col0) = pack8(h[0], h[1]); }
    }
};
struct EpiKV {
    static constexpr bool PERM = true, AFTER_DRAIN = false, MIDSCALE = false; static constexpr int MID_T = 0;
    float *mk_out, *mv_out; bf16_t *MK, *MVt;
    __device__ __forceinline__ void midscale(f32x4 (&)[2][2][4][2], const Unit&, int, int, int) const {}
    __device__ __forceinline__ void prepare(const Unit&, int, int) const {}
    __device__ __forceinline__ void operator()(const f32x4 (&acc)[2][2][4][2], const Unit& u, int wr, int wc, int fr, int fq, int ui) const {
        const int l = u.pn >> 3, isv = (u.pn >> 2) & 1, hh = u.pn & 3, b = u.pm;
        const int key0 = wr * 64 + fr, col0 = hh * 256 + wc * 32 + 8 * fq;
        float* of = (isv ? mv_out : mk_out) + (size_t)(l * 4 + b) * 256 * 1024 + (size_t)key0 * 1024 + col0;
#pragma unroll
        for (int ai = 0; ai < 2; ++ai)
#pragma unroll
            for (int m = 0; m < 4; ++m) { float* p = of + (size_t)(ai * HALF + m * 16) * 1024;
#pragma unroll
                for (int bj = 0; bj < 2; ++bj) { *(f32x4*)(p + bj * HALF) = acc[ai][bj][m][0]; *(f32x4*)(p + bj * HALF + 4) = acc[ai][bj][m][1]; }
                asm volatile("" ::: "memory"); }
        bf16_t* ob = (isv ? MVt : MK) + ((size_t)(l * 4 + b) * 256 + key0) * 1024 + col0;
#pragma unroll
        for (int ai = 0; ai < 2; ++ai)
#pragma unroll
            for (int m = 0; m < 4; ++m) {
#pragma unroll
                for (int bj = 0; bj < 2; ++bj) *(u32x4*)(ob + (size_t)(ai * HALF + m * 16) * 1024 + bj * HALF) = pack8(acc[ai][bj][m][0], acc[ai][bj][m][1]);
                asm volatile("" ::: "memory"); }
    }
};
template <class Epi, class Sched, bool ALIGN_EPI = false, bool SP2 = false>
__device__ __forceinline__ void gemm_phase(PG8_LAS unsigned char* lds, const Gemm g, const Sched& S, const Epi& E, int wave_id) {
    int tid_ = wave_id * 64 + (int)__builtin_amdgcn_mbcnt_hi(~0u, __builtin_amdgcn_mbcnt_lo(~0u, 0u)); asm volatile("" : "+v"(tid_));
    const int tid = tid_, wid = __builtin_amdgcn_readfirstlane(tid >> 6), lane = tid & 63, wr = wid >> 2, wc = wid & 3, fr = lane & 15, fq = lane >> 4;
    const int K = g.K, nt = K / BK;
    unsigned voffA[2], voffB[2];
#pragma unroll
    for (int i = 0; i < 2; ++i) { int R, C; stage_rc(tid * 16 + i * 8192, R, C); const int Rb = Epi::PERM ? ((R & ~31) + perm32(R & 31)) : R;
        voffA[i] = (unsigned)(R * K + C) * 2u; voffB[i] = (unsigned)(Rb * K + C) * 2u; }
    const size_t kstep = (size_t)(BK * 2);
    const size_t hstep = (size_t)HALF * K * 2;
    const size_t tstep = 2 * hstep;
    const unsigned ldsw = (unsigned)wid * 1024u;
    const int aoff = lds_byte(wr * 64 + fr, fq * 8), boff = lds_byte(wc * 32 + fr, fq * 8);
#define PG8_SA(b, h) (((b) * 2 + (h)) * HTB)
#define PG8_SB(b, h) ((4 + (b) * 2 + (h)) * HTB)
#define PG8_STAGE(bufoff, gbase, voff) do { _Pragma("unroll") for (int _i = 0; _i < 2; ++_i) \
        __builtin_amdgcn_global_load_lds((const unsigned*)((const char*)(gbase) + (voff)[_i]), (PG8_LAS unsigned*)(lds + (bufoff) + ldsw + _i * 8192), 16, 0, 0); } while (0)
#define PG8_LDA(dst, b, h) do { _Pragma("unroll") for (int m = 0; m < 4; ++m) _Pragma("unroll") for (int k = 0; k < 2; ++k) dst[m][k] = *(const PG8_LAS bf16x8*)(lds + PG8_SA(b, h) + aoff + m * 2048 + k * 1024); } while (0)
#define PG8_LDB(dst, b, h) do { _Pragma("unroll") for (int n = 0; n < 2; ++n) _Pragma("unroll") for (int k = 0; k < 2; ++k) dst[n][k] = *(const PG8_LAS bf16x8*)(lds + PG8_SB(b, h) + boff + n * 2048 + k * 1024); } while (0)
#define PG8_MMA(ai, bj, At, Bt) do { __builtin_amdgcn_s_setprio(1); _Pragma("unroll") for (int m = 0; m < 4; ++m) _Pragma("unroll") for (int n = 0; n < 2; ++n) _Pragma("unroll") for (int k = 0; k < 2; ++k) \
        acc[ai][bj][m][n] = __builtin_amdgcn_mfma_f32_16x16x32_bf16(Bt[n][k], At[m][k], acc[ai][bj][m][n], 0, 0, 0); __builtin_amdgcn_s_setprio(0); } while (0)
#define PG8_WAIT_V(n) asm volatile("s_waitcnt vmcnt(" #n ")" ::: "memory")
#define PG8_WAIT_L(n) asm volatile("s_waitcnt lgkmcnt(" #n ")" ::: "memory")
#define PG8_BAR __builtin_amdgcn_s_barrier()
#define PG8_SCHED __builtin_amdgcn_sched_barrier(0)
    Unit cur, nxt; int ui = 0;
    if (!S.next(0, cur)) return;
    f32x4 acc[2][2][4][2];
#pragma unroll
    for (int a = 0; a < 2; ++a)
#pragma unroll
        for (int b = 0; b < 2; ++b)
#pragma unroll
            for (int m = 0; m < 4; ++m)
#pragma unroll
                for (int n = 0; n < 2; ++n) acc[a][b][m][n] = (f32x4){0.f, 0.f, 0.f, 0.f};
    bf16x8 At[4][2], B0[2][2], B1[2][2];
    const char* cA = (const char*)g.A + (size_t)cur.pm * tstep; const char* cB = (const char*)g.Bt + (size_t)cur.pn * tstep;
    S.a_ready(cur);
    if constexpr (Epi::MIDSCALE) E.prepare(cur, 0, tid);
    if constexpr (SP2) {
        PG8_STAGE(PG8_SB(0, 0), cB, voffB); PG8_STAGE(PG8_SB(0, 1), cB + hstep, voffB); PG8_STAGE(PG8_SA(0, 0), cA, voffA); PG8_STAGE(PG8_SA(0, 1), cA + hstep, voffA);
        if (wr == 1) PG8_BAR;
        PG8_WAIT_V(2); PG8_BAR;
        PG8_STAGE(PG8_SB(1, 0), cB + kstep, voffB); PG8_STAGE(PG8_SA(1, 0), cA + kstep, voffA); PG8_STAGE(PG8_SB(1, 1), cB + hstep + kstep, voffB);
        PG8_WAIT_V(6); PG8_BAR;
    } else {
        PG8_STAGE(PG8_SB(0, 0), cB, voffB); PG8_STAGE(PG8_SA(0, 0), cA, voffA); PG8_STAGE(PG8_SB(0, 1), cB + hstep, voffB); PG8_STAGE(PG8_SA(0, 1), cA + hstep, voffA);
        if (wr == 1) PG8_BAR;
        PG8_WAIT_V(4); PG8_BAR;
        PG8_STAGE(PG8_SB(1, 0), cB + kstep, voffB); PG8_STAGE(PG8_SA(1, 0), cA + kstep, voffA); PG8_STAGE(PG8_SB(1, 1), cB + hstep + kstep, voffB);
        PG8_WAIT_V(6); PG8_BAR;
    }
    for (;;) {
        const bool has_next = S.next(ui + 1, nxt);
        const char* nA = has_next ? (const char*)g.A + (size_t)nxt.pm * tstep : cA; const char* nB = has_next ? (const char*)g.Bt + (size_t)nxt.pn * tstep : cB;
        for (int t = 0; t < nt; t += 2) {
            if constexpr (Epi::MIDSCALE) { if (t == Epi::MID_T) E.midscale(acc, cur, wr, fr, ui); }
            const bool last = (t == nt - 2);
            const char* a1 = cA + (size_t)(t + 1) * kstep;
            const char* a2 = last ? nA : cA + (size_t)(t + 2) * kstep; const char* b2 = last ? nB : cB + (size_t)(t + 2) * kstep;
            const char* a3 = a2 + kstep; const char* b3 = b2 + kstep;
            if (last && has_next) S.a_ready(nxt);
            if constexpr (SP2) {
            PG8_LDB(B0, 0, 0); PG8_LDB(B1, 0, 1); PG8_SCHED; PG8_LDA(At, 0, 0); PG8_STAGE(PG8_SA(1, 1), a1 + hstep, voffA);
            PG8_WAIT_V(8); PG8_WAIT_L(0); PG8_BAR; PG8_MMA(0, 0, At, B0); PG8_MMA(0, 1, At, B1); PG8_BAR; PG8_SCHED;
            PG8_LDA(At, 0, 1); PG8_STAGE(PG8_SB(0, 0), b2, voffB); PG8_STAGE(PG8_SB(0, 1), b2 + hstep, voffB); PG8_STAGE(PG8_SA(0, 0), a2, voffA);
            PG8_WAIT_V(8); PG8_WAIT_L(0); PG8_BAR; PG8_MMA(1, 0, At, B0); PG8_MMA(1, 1, At, B1); PG8_BAR; PG8_SCHED;
            PG8_LDB(B0, 1, 0); PG8_LDB(B1, 1, 1); PG8_SCHED; PG8_LDA(At, 1, 0); PG8_STAGE(PG8_SA(0, 1), a2 + hstep, voffA);
            PG8_WAIT_V(8); PG8_WAIT_L(0); PG8_BAR; PG8_MMA(0, 0, At, B0); PG8_MMA(0, 1, At, B1); PG8_BAR; PG8_SCHED;
            PG8_LDA(At, 1, 1); PG8_STAGE(PG8_SB(1, 0), b3, voffB); PG8_STAGE(PG8_SB(1, 1), b3 + hstep, voffB); PG8_STAGE(PG8_SA(1, 0), a3, voffA);
            PG8_WAIT_V(8); PG8_WAIT_L(0); PG8_BAR; PG8_MMA(1, 0, At, B0); PG8_MMA(1, 1, At, B1); PG8_BAR; PG8_SCHED;
            } else {
            PG8_LDB(B0, 0, 0); PG8_SCHED; PG8_LDA(At, 0, 0); PG8_STAGE(PG8_SA(1, 1), a1 + hstep, voffA);
            PG8_WAIT_L(8); PG8_BAR; PG8_WAIT_L(0); PG8_MMA(0, 0, At, B0); PG8_BAR; PG8_SCHED;
            PG8_LDB(B1, 0, 1); PG8_STAGE(PG8_SB(0, 0), b2, voffB);
            PG8_BAR; PG8_WAIT_L(0); PG8_MMA(0, 1, At, B1); PG8_BAR;
            PG8_LDA(At, 0, 1); PG8_STAGE(PG8_SA(0, 0), a2, voffA);
            PG8_BAR; PG8_WAIT_L(0); PG8_MMA(1, 0, At, B0); PG8_BAR; PG8_SCHED;
            PG8_STAGE(PG8_SB(0, 1), b2 + hstep, voffB);
            PG8_WAIT_V(6); PG8_BAR; PG8_MMA(1, 1, At, B1); PG8_BAR;
            PG8_LDB(B0, 1, 0); PG8_SCHED; PG8_LDA(At, 1, 0); PG8_STAGE(PG8_SA(0, 1), a2 + hstep, voffA);
            PG8_WAIT_L(8); PG8_BAR; PG8_WAIT_L(0); PG8_MMA(0, 0, At, B0); PG8_BAR; PG8_SCHED;
            PG8_LDB(B1, 1, 1); PG8_STAGE(PG8_SB(1, 0), b3, voffB);
            PG8_BAR; PG8_WAIT_L(0); PG8_MMA(0, 1, At, B1); PG8_BAR;
            PG8_LDA(At, 1, 1); PG8_STAGE(PG8_SA(1, 0), a3, voffA);
            PG8_BAR; PG8_WAIT_L(0); PG8_MMA(1, 0, At, B0); PG8_BAR; PG8_SCHED;
            PG8_STAGE(PG8_SB(1, 1), b3 + hstep, voffB);
            PG8_WAIT_V(6); PG8_BAR; PG8_MMA(1, 1, At, B1); PG8_BAR;
            }
        }
        if constexpr (ALIGN_EPI) { if (wr == 0) PG8_BAR; }
        if constexpr (!Epi::AFTER_DRAIN) { E(acc, cur, wr, wc, fr, fq, ui); S.done(cur); }
        if (!has_next) break;
#pragma unroll
        for (int a = 0; a < 2; ++a)
#pragma unroll
            for (int b = 0; b < 2; ++b)
#pragma unroll
                for (int m = 0; m < 4; ++m)
#pragma unroll
                    for (int n = 0; n < 2; ++n) acc[a][b][m][n] = (f32x4){0.f, 0.f, 0.f, 0.f};
        cur = nxt; cA = nA; cB = nB; ++ui;
        if constexpr (Epi::MIDSCALE) E.prepare(cur, ui, tid);
        if constexpr (ALIGN_EPI) { if (wr == 1) PG8_BAR; }
    }
    PG8_WAIT_V(0);
    if constexpr (!ALIGN_EPI) { if (wr == 0) PG8_BAR; }
    PG8_BAR;
    if constexpr (Epi::AFTER_DRAIN) { E.fused(acc, cur, wr, wc, fr, fq, lds, wid, lane); S.done(cur); }
#undef PG8_SA
#undef PG8_SB
#undef PG8_STAGE
#undef PG8_LDA
#undef PG8_LDB
#undef PG8_MMA
#undef PG8_WAIT_V
#undef PG8_WAIT_L
#undef PG8_BAR
#undef PG8_SCHED
}
}
constexpr int NWAVES = 8;
constexpr int D = 1024, NB = 4, T = 4096, NL = 4, BS = 32, NS = 16, PAST = 1024, INW = 2560, NMEM = 256, DFF = 2816;
constexpr int MP = NB * T, MS = BS * NS, M = MP + MS;
constexpr float EPS = 1e-6f, LOG2E = 1.4426950408889634f;
constexpr float C_SB = 0.125f * LOG2E, C_MEM = 0.0625f * LOG2E;
constexpr float SB_EXIT = 140.0f;
constexpr size_t MiB = 1u << 20;
constexpr size_t WS_CTL = 0, CTL_ZERO_BYTES = 1 * MiB;
constexpr size_t WS_WL = 2 * MiB, WL_STRIDE = 28 * MiB;
constexpr size_t WL_IN = 0, WL_OUT = 5 * MiB, WL_MQ = 7 * MiB, WL_MO = 9 * MiB, WL_GU = 11 * MiB, WL_DN = 22 * MiB;
constexpr size_t WS_WMKV = 114 * MiB, WS_MEMB = 130 * MiB, WS_MK = 132 * MiB, WS_MV = 140 * MiB, WS_SSQ = 148 * MiB, WS_SBSS = 150 * MiB;
constexpr size_t WS_XF = 152 * MiB, WS_XB = 218 * MiB, WS_U = 251 * MiB, WS_VA = 268 * MiB, WS_Q = 285 * MiB, WS_K = 302 * MiB, WS_V = 319 * MiB;
constexpr size_t WS_CAT = 336 * MiB, WS_QM = 369 * MiB, WS_OM = 402 * MiB, WS_H = 435 * MiB, WS_WT = 526 * MiB, WS_SASS = 527 * MiB, WS_END = 529 * MiB;
constexpr int CW_BAR = 4096;
constexpr int RING_OFF = 0, RING_BYTES = 131072, LDSCTL_OFF = RING_BYTES, MISC_OFF = LDSCTL_OFF + 320, AUX_OFF = LDSCTL_OFF + 1024, LDS_BYTES = 147456;

#define GAS __attribute__((address_space(1)))
#define LAS __attribute__((address_space(3)))
typedef unsigned short bf16;
typedef unsigned v4u __attribute__((ext_vector_type(4)));
typedef unsigned v2u __attribute__((ext_vector_type(2)));
typedef float f32x4 __attribute__((ext_vector_type(4)));
typedef float f32x16 __attribute__((ext_vector_type(16)));
typedef short bf16x8 __attribute__((ext_vector_type(8)));
typedef short s16x4 __attribute__((ext_vector_type(4)));
typedef GAS unsigned gu32;
#define RLX_AGENT __ATOMIC_RELAXED, __HIP_MEMORY_SCOPE_AGENT
#define LDS_WAIT() asm volatile("s_waitcnt lgkmcnt(0)" ::: "memory")
#define VM_WAIT() asm volatile("s_waitcnt vmcnt(0)" ::: "memory")
__device__ __forceinline__ unsigned cvtpk(float lo, float hi) { unsigned r; asm volatile("v_cvt_pk_bf16_f32 %0, %1, %2" : "=v"(r) : "v"(lo), "v"(hi)); return r; }
__device__ __forceinline__ float bf_lo(unsigned w) { return __uint_as_float(w << 16); }
__device__ __forceinline__ float bf_hi(unsigned w) { return __uint_as_float(w & 0xffff0000u); }
__device__ __forceinline__ int lane_id() { return (int)__builtin_amdgcn_mbcnt_hi(~0u, __builtin_amdgcn_mbcnt_lo(~0u, 0u)); }
__device__ __forceinline__ int crow(int r, int hi) { return (r & 3) + 8 * (r >> 2) + 4 * hi; }
__device__ __forceinline__ s16x4 tr_read(unsigned addr) { return __builtin_bit_cast(s16x4, __builtin_amdgcn_ds_read_tr16_b64_v4i16((LAS s16x4*)(uintptr_t)addr)); }
#define MFMA32(a, b, c) __builtin_amdgcn_mfma_f32_32x32x16_bf16((a), (b), (c), 0, 0, 0)

#ifndef REP_A
#define REP_A 1
#endif
#ifndef REP_B
#define REP_B 1
#endif
#ifndef REP_E
#define REP_E 1
#endif
#ifndef REP_F
#define REP_F 1
#endif
#ifndef REP_H
#define REP_H 1
#endif
#ifndef REP_P
#define REP_P 1
#endif
#ifndef REP_SGU
#define REP_SGU 1
#endif
#ifndef REP_SB
#define REP_SB 1
#endif
#define XB_TMO      128
#define XB_XCNT(j)  (256  + 64 * (j))
#define XB_XSUB(j)  (1280 + 64 * (j))
#define XB_XGEN(j)  (2304 + 64 * (j))
#define XB_TOP      3328
#define XB_TOPGEN   3392
#define XCD_BAR_WORDS 3456
#define XB_SPIN_CAP (1u << 18)

__device__ __forceinline__ unsigned xb_ld(unsigned* p)              { return __hip_atomic_load(p, __ATOMIC_RELAXED, __HIP_MEMORY_SCOPE_AGENT); }
__device__ __forceinline__ unsigned xb_add(unsigned* p, unsigned v) { return __hip_atomic_fetch_add(p, v, __ATOMIC_RELAXED, __HIP_MEMORY_SCOPE_AGENT); }
__device__ __forceinline__ unsigned xb_xcc_id() { return (unsigned)__builtin_amdgcn_s_getreg((3 << 11) | 20) & 0xFu; }
#define XB_SPIN(cond, bar) do { unsigned _sp = 0; while (cond) { __builtin_amdgcn_s_sleep(1); \
    if ((++_sp & 255u) == 0u) { if (xb_ld(&(bar)[XB_TMO])) break; if (_sp > XB_SPIN_CAP) { atomicAdd(&(bar)[XB_TMO], 1u); break; } } } } while (0)

struct XcdBarrier {
    unsigned* bar; unsigned x;
    volatile LAS unsigned* st;
};

__device__ __forceinline__ XcdBarrier xcd_barrier_post(unsigned* bar, volatile LAS unsigned* st, int tid) {
    XcdBarrier b; b.bar = bar; b.x = xb_xcc_id(); b.st = st;
    if (tid == 0) (void)xb_add(&bar[XB_XCNT(b.x)], 1u);
    return b;
}
__device__ __forceinline__ void xcd_barrier_complete(unsigned* bar, unsigned x, unsigned& nloc, unsigned& nx) {
    const unsigned G = gridDim.x * gridDim.y * gridDim.z;
    unsigned sum, cnt, mine, sp = 0u;
    for (;;) {
        sum = 0u; cnt = 0u; mine = 0u;
#pragma unroll
        for (unsigned j = 0; j < 16; ++j) { const unsigned c = xb_ld(&bar[XB_XCNT(j)]); sum += c; cnt += (c > 0u) ? 1u : 0u; mine = (j == x) ? c : mine; }
        if (sum == G) break;
        __builtin_amdgcn_s_sleep(1);
        if ((++sp & 255u) == 0u) { if (xb_ld(&bar[XB_TMO])) break; if (sp > XB_SPIN_CAP) { atomicAdd(&bar[XB_TMO], 1u); break; } }
    }
    nloc = mine > 0u ? mine : 1u; nx = cnt > 0u ? cnt : 1u;
}

__device__ __forceinline__ void xcd_barrier(const XcdBarrier& b, int tid) {
    asm volatile("s_waitcnt vmcnt(0)" ::: "memory");
    __syncthreads();
    if (tid == 0) {
        unsigned* bar = b.bar; unsigned bx = b.x; asm volatile("" : "+s"(bar), "+s"(bx));
        __builtin_amdgcn_s_waitcnt(0);
        unsigned nloc = b.st[0], nx = b.st[1];
        if (nloc == 0u) { xcd_barrier_complete(bar, bx, nloc, nx); b.st[0] = nloc; b.st[1] = nx; }
        const unsigned old = xb_add(&bar[XB_XSUB(bx)], 1u);
        const unsigned gen = old / nloc;
        if (old + 1u == (gen + 1u) * nloc) {
            __builtin_amdgcn_fence(__ATOMIC_RELEASE, "agent");
            asm volatile("s_waitcnt vmcnt(0)" ::: "memory");
            const unsigned og = xb_add(&bar[XB_TOP], 1u);
            const unsigned tg = og / nx;
            if (og + 1u == (tg + 1u) * nx) xb_add(&bar[XB_TOPGEN], 1u);
            else XB_SPIN(xb_ld(&bar[XB_TOPGEN]) == tg, bar);
            __builtin_amdgcn_fence(__ATOMIC_ACQUIRE, "agent");
            xb_add(&bar[XB_XGEN(bx)], 1u);
            asm volatile("s_waitcnt vmcnt(0)" ::: "memory");
        } else {
            XB_SPIN(xb_ld(&bar[XB_XGEN(bx)]) == gen, bar);
            __builtin_amdgcn_fence(__ATOMIC_ACQUIRE, "agent");
            asm volatile("s_waitcnt vmcnt(0)" ::: "memory");
        }
    }
    __syncthreads();
}


struct Frame {
    LAS unsigned char* lds; unsigned lds0;
    int wave, G, bid;
};
struct Args {
    const float* in[25]; float* out; unsigned char* ws; int ph_lo, ph_hi;
};
__device__ __forceinline__ float* out_y_p(float* o) { return o; }
__device__ __forceinline__ float* out_y_s(float* o) { return o + (size_t)MP * D; }
__device__ __forceinline__ float* out_sbk_p(float* o) { return o + (size_t)M * D; }
__device__ __forceinline__ float* out_sbv_p(float* o) { return out_sbk_p(o) + (size_t)NL * MP * 512; }
__device__ __forceinline__ float* out_mk_p(float* o) { return out_sbv_p(o) + (size_t)NL * MP * 512; }
__device__ __forceinline__ float* out_mv_p(float* o) { return out_mk_p(o) + (size_t)NL * NB * NMEM * D; }
__device__ __forceinline__ float* out_sbk_s(float* o) { return out_mv_p(o) + (size_t)NL * NB * NMEM * D; }
__device__ __forceinline__ float* out_sbv_s(float* o) { return out_sbk_s(o) + (size_t)NL * MS * 512; }
__device__ __forceinline__ float* out_sguv_s(float* o) { return out_sbv_s(o) + (size_t)NL * MS * 512; }

__device__ __forceinline__ void tr_item(const float* W, int ldw, int k_src0, int n_src0, const float* gain, bf16* dst, int ldd, int n_dst0, int k_dst0, LAS float* scr, int lane) {
    const int kr0 = lane >> 4, nc = (lane & 15) * 4;
    f32x4 v[16];
#pragma unroll
    for (int i = 0; i < 16; ++i) v[i] = *(const f32x4*)(W + (size_t)(k_src0 + kr0 + 4 * i) * ldw + n_src0 + nc);
    if (gain) {
#pragma unroll
        for (int i = 0; i < 16; ++i) v[i] = v[i] * gain[k_src0 + kr0 + 4 * i]; }
#pragma unroll
    for (int i = 0; i < 16; ++i) { const int kr = kr0 + 4 * i; LAS float* p = scr + kr * 64;
        p[(nc + 0) ^ (kr & 31)] = v[i][0]; p[(nc + 1) ^ (kr & 31)] = v[i][1]; p[(nc + 2) ^ (kr & 31)] = v[i][2]; p[(nc + 3) ^ (kr & 31)] = v[i][3]; }
    LDS_WAIT(); asm volatile("" ::: "memory");
    const int c = lane & 7;
#pragma unroll
    for (int j = 0; j < 8; ++j) { const int n = (lane >> 3) + 8 * j; float s[8];
#pragma unroll
        for (int i = 0; i < 8; ++i) s[i] = scr[(8 * c + i) * 64 + (n ^ ((8 * c + i) & 31))];
        v4u o; o.x = cvtpk(s[0], s[1]); o.y = cvtpk(s[2], s[3]); o.z = cvtpk(s[4], s[5]); o.w = cvtpk(s[6], s[7]);
        *(GAS v4u*)(dst + (size_t)(n_dst0 + n) * ldd + k_dst0 + 8 * c) = o; }
    LDS_WAIT(); asm volatile("" ::: "memory");
}
__device__ __forceinline__ void prologue(const Args& a, const Frame& F) {
    LAS float* scr = (LAS float*)(F.lds + RING_OFF + F.wave * 16384);
    const int gw = F.bid * NWAVES + F.wave, NGW = F.G * NWAVES;
    unsigned char* ws = a.ws;
    constexpr int I_IN = 640, I_SQ = 256, I_G = 704, I_L = I_IN + 3 * I_SQ + 3 * I_G + 2 * I_SQ;
    for (int it = gw; it < NL * I_L; it += NGW) {
        const int l = it / I_L; int r = it % I_L;
        unsigned char* wl = ws + WS_WL + (size_t)l * WL_STRIDE;
        if (r < I_IN) { const int kb = r / 40, nb = r % 40; tr_item(a.in[8] + (size_t)l * D * INW, INW, kb * 64, nb * 64, a.in[7] + l * D, (bf16*)(wl + WL_IN), D, nb * 64, kb * 64, scr, lane_id()); continue; } r -= I_IN;
        if (r < I_SQ) { const int kb = r / 16, nb = r % 16; const int ks = (kb * 64 + 512) & 1023;
            const float* gain = ks < 512 ? a.in[12] + l * 512 - 0 : a.in[13] + l * 512 - 512;
            tr_item(a.in[14] + (size_t)l * D * D, D, ks, nb * 64, gain, (bf16*)(wl + WL_OUT), D, nb * 64, kb * 64, scr, lane_id()); continue; } r -= I_SQ;
        if (r < I_SQ) { const int kb = r / 16, nb = r % 16; tr_item(a.in[16] + (size_t)l * D * D, D, kb * 64, nb * 64, a.in[15] + l * D, (bf16*)(wl + WL_MQ), D, nb * 64, kb * 64, scr, lane_id()); continue; } r -= I_SQ;
        if (r < I_SQ) { const int kb = r / 16, nb = r % 16; tr_item(a.in[19] + (size_t)l * D * D, D, kb * 64, nb * 64, nullptr, (bf16*)(wl + WL_MO), D, nb * 64, kb * 64, scr, lane_id()); continue; } r -= I_SQ;
        if (r < 2 * I_G) { const int up = r >= I_G; if (up) r -= I_G; const int kb = r / 44, nb = r % 44; const int j0 = nb * 64;
            tr_item(a.in[up ? 22 : 21] + (size_t)l * D * DFF, DFF, kb * 64, j0, a.in[20] + l * D, (bf16*)(wl + WL_GU), D, 256 * (j0 >> 7) + (up ? 128 : 0) + (j0 & 127), kb * 64, scr, lane_id()); continue; } r -= 2 * I_G;
        if (r < I_G) { const int kb = r / 16, nb = r % 16; tr_item(a.in[23] + (size_t)l * DFF * D, D, kb * 64, nb * 64, nullptr, (bf16*)(wl + WL_DN), DFF, nb * 64, kb * 64, scr, lane_id()); continue; } r -= I_G;
        { const int isv = r >= I_SQ; if (isv) r -= I_SQ; const int kb = r / 16, nb = r % 16;
          tr_item(a.in[isv ? 18 : 17] + (size_t)l * D * D, D, kb * 64, nb * 64, nullptr, (bf16*)(ws + WS_WMKV), D, (l * 2 + isv) * 1024 + nb * 64, kb * 64, scr, lane_id()); }
    }
    float* XF = (float*)(ws + WS_XF); bf16* XB = (bf16*)(ws + WS_XB); float* SSQ = (float*)(ws + WS_SSQ);
    for (int m = gw; m < M; m += NGW) {
        const float* src = m < MP ? a.in[0] + (size_t)m * D : a.in[1] + (size_t)(m - MP) * D;
        f32x4 v[4]; float s = 0.f;
#pragma unroll
        for (int j = 0; j < 4; ++j) { v[j] = ((const f32x4*)src)[lane_id() + 64 * j]; s += (v[j][0] * v[j][0] + v[j][1] * v[j][1]) + (v[j][2] * v[j][2] + v[j][3] * v[j][3]); }
#pragma unroll
        for (int o = 1; o < 64; o <<= 1) s += __shfl_xor(s, o);
#pragma unroll
        for (int j = 0; j < 4; ++j) { ((f32x4*)(XF + (size_t)m * D))[lane_id() + 64 * j] = v[j]; v2u w; w.x = cvtpk(v[j][0], v[j][1]); w.y = cvtpk(v[j][2], v[j][3]); ((v2u*)(XB + (size_t)m * D))[lane_id() + 64 * j] = w; }
        if (lane_id() < 16) SSQ[(size_t)m * 16 + lane_id()] = lane_id() == 0 ? s : 0.f;
    }
    { bf16* WT = (bf16*)(ws + WS_WT); const int gt = F.bid * 512 + (F.wave * 64 + lane_id()), NT = F.G * 512;
      for (int i = gt; i < NL * 2 * 4 * 128 * 128; i += NT) { const int s = i & 127, t = (i >> 7) & 127, g = (i >> 14) & 3, var = (i >> 16) & 1, l = i >> 17;
          const float* W = a.in[10] + (size_t)(l * 4 + g) * 128 * 128; float v;
          if (var == 0) v = s <= t ? W[t * 128 + s] : 0.f; else v = ((t >> 4) == (s >> 4) && (s & 15) <= (t & 15)) ? W[(t & 15) * 128 + (s & 15)] : 0.f;
          WT[i] = (bf16)(cvtpk(v, 0.f) & 0xffffu); } }
    { const f32x4* src = (const f32x4*)a.in[6]; v2u* dst = (v2u*)(ws + WS_MEMB); const int gt = F.bid * 512 + (F.wave * 64 + lane_id()), NT = F.G * 512;
      for (int i = gt; i < NB * NMEM * D / 4; i += NT) { const f32x4 v = src[i]; v2u w; w.x = cvtpk(v[0], v[1]); w.y = cvtpk(v[2], v[3]); dst[i] = w; } }
}

__device__ __forceinline__ void sgu_unit(const Args& a, const Frame& F, int l, int unit) {
    unsigned char* ws = a.ws;
    const bf16* VA = (const bf16*)(ws + WS_VA); const bf16* U = (const bf16*)(ws + WS_U); bf16* CAT = (bf16*)(ws + WS_CAT); float* SASS = (float*)(ws + WS_SASS);
    const int c = unit >> 1, gp = unit & 1; const bool smp = c >= 128; const int R0 = smp ? MP + 128 * (c - 128) : 128 * c;
    const float* gv = a.in[9] + l * 512; const float* bl = a.in[11] + l * 512;
    float* sguv = out_sguv_s(a.out) + (size_t)l * MS * 512;
    int tid_ = F.wave * 64 + lane_id(); asm volatile("" : "+v"(tid_));
    const int tid = tid_, lane = tid & 63, w = F.wave;
#pragma unroll 4
    for (int i = 0; i < 8; ++i) { const int cc = tid + 512 * i, row = cc >> 5, ch = cc & 31, gl = ch >> 4, c16 = ch & 15, col = (2 * gp + gl) * 128 + c16 * 8;
        const v4u raw = *(const GAS v4u*)(VA + (size_t)(R0 + row) * 512 + col);
        float x[8] = {bf_lo(raw.x), bf_hi(raw.x), bf_lo(raw.y), bf_hi(raw.y), bf_lo(raw.z), bf_hi(raw.z), bf_lo(raw.w), bf_hi(raw.w)};
        float ss = 0.f;
#pragma unroll
        for (int j = 0; j < 8; ++j) ss += x[j] * x[j];
        ss += __shfl_xor(ss, 1); ss += __shfl_xor(ss, 2); ss += __shfl_xor(ss, 4); ss += __shfl_xor(ss, 8);
        const float rstd = __builtin_amdgcn_rsqf(ss * (1.0f / 128.0f) + EPS);
        const f32x4 g0 = *(const f32x4*)(gv + col), g1 = *(const f32x4*)(gv + col + 4);
        f32x4 y0, y1;
#pragma unroll
        for (int j = 0; j < 4; ++j) { y0[j] = x[j] * rstd * g0[j]; y1[j] = x[4 + j] * rstd * g1[j]; }
        if (smp) { float* o = sguv + (size_t)(R0 - MP + row) * 512 + col; *(f32x4*)o = y0; *(f32x4*)(o + 4) = y1; }
        v4u pk; pk.x = cvtpk(y0[0], y0[1]); pk.y = cvtpk(y0[2], y0[3]); pk.z = cvtpk(y1[0], y1[1]); pk.w = cvtpk(y1[2], y1[3]);
        *(LAS v4u*)(F.lds + gl * 32768 + row * 256 + ((((c16 >> 2) ^ (row & 3)) << 2) | (c16 & 3)) * 16) = pk; }
    __syncthreads();
    const int gl = w >> 2, nb = w & 3, g = 2 * gp + gl, r32 = lane & 31, hi = lane >> 5;
    const int g4 = lane >> 4, cb = g4 & 1, q4 = (lane & 15) >> 2, p4 = lane & 3;
    const bf16* WT = (const bf16*)(ws + WS_WT) + ((size_t)((l * 2 + (smp ? 1 : 0)) * 4 + g) * 128 + r32) * 128 + hi * 8;
    const int colb = (nb * 32 + 16 * cb + 4 * p4) * 2;
    const unsigned tb = F.lds0 + gl * 32768 + (8 * hi + q4) * 256 + ((((colb >> 6) ^ q4) << 6) | (colb & 63));
    f32x16 acc[4];
#pragma unroll
    for (int i = 0; i < 4; ++i)
#pragma unroll
        for (int r = 0; r < 16; ++r) acc[i][r] = 0.f;
#pragma unroll
    for (int ks = 0; ks < 8; ++ks) {
        const s16x4 a0 = tr_read(tb + ks * 16 * 256), a1 = tr_read(tb + ks * 16 * 256 + 4 * 256);
        const bf16x8 af = (bf16x8){a0[0], a0[1], a0[2], a0[3], a1[0], a1[1], a1[2], a1[3]};
#pragma unroll
        for (int i = 0; i < 4; ++i) { if (ks > 2 * i + 1) continue;
            const bf16x8 wf = __builtin_bit_cast(bf16x8, *(const GAS v4u*)(WT + (size_t)(32 * i) * 128 + ks * 16));
            acc[i] = MFMA32(af, wf, acc[i]); }
    }
#pragma unroll
    for (int i = 0; i < 4; ++i) { const int t = 32 * i + r32; const float bias = bl[g * 128 + (smp ? (t & 15) : t)];
        const size_t rowoff = (size_t)(R0 + t); float ss = 0.f;
#pragma unroll
        for (int k = 0; k < 4; ++k) { const int e = g * 128 + nb * 32 + 8 * k + 4 * hi;
            const v2u uu = *(const GAS v2u*)(U + rowoff * 512 + e);
            const float v0 = bf_lo(uu.x) * (acc[i][4 * k] + bias), v1 = bf_hi(uu.x) * (acc[i][4 * k + 1] + bias), v2 = bf_lo(uu.y) * (acc[i][4 * k + 2] + bias), v3 = bf_hi(uu.y) * (acc[i][4 * k + 3] + bias);
            ss += (v0 * v0 + v1 * v1) + (v2 * v2 + v3 * v3);
            v2u o; o.x = cvtpk(v0, v1); o.y = cvtpk(v2, v3); *(GAS v2u*)(CAT + rowoff * 1024 + 512 + e) = o; }
        ss += __shfl_xor(ss, 32);
        SASS[rowoff * 16 + g * 4 + nb] = ss; }
    __syncthreads();
}

template <bool SMP> __device__ __forceinline__ void sb_unit(const Args& a, const Frame& F, int l, int uidx) {
    unsigned char* ws = a.ws;
    const bf16* Qb = (const bf16*)(ws + WS_Q); const bf16* Kb = (const bf16*)(ws + WS_K); const bf16* Vb = (const bf16*)(ws + WS_V);
    bf16* CAT = (bf16*)(ws + WS_CAT); float* SBSS = (float*)(ws + WS_SBSS);
    int lane_ = lane_id(); asm volatile("" : "+v"(lane_));
    const int lane = lane_, r32 = lane & 31, hi = lane >> 5;
    int h, rowq0, nq, krow0 = 0, bs = 0, t0 = 0, jt;
    if (!SMP) { const int tb = uidx & 127, bh = uidx >> 7; h = bh & 7; const int b = bh >> 3; t0 = 32 * tb; rowq0 = b * T + t0; krow0 = b * T; nq = 32; jt = t0 >> 6; }
    else { h = uidx & 7; bs = uidx >> 3; rowq0 = MP + bs * NS; nq = NS; jt = PAST / 64; }
    const int tq = SMP ? PAST + (r32 < NS ? r32 : NS - 1) : t0 + r32;
    const float* ck = a.in[2] + ((size_t)(l * BS + bs) * PAST) * 512 + h * 64; const float* cv = a.in[3] + ((size_t)(l * BS + bs) * PAST) * 512 + h * 64;
    bf16x8 qf[4];
#pragma unroll
    for (int d0 = 0; d0 < 4; ++d0) qf[d0] = __builtin_bit_cast(bf16x8, *(const GAS v4u*)(Qb + (size_t)(rowq0 + (r32 < nq ? r32 : nq - 1)) * 512 + h * 64 + d0 * 16 + hi * 8));
    f32x16 o[2];
#pragma unroll
    for (int r = 0; r < 16; ++r) { o[0][r] = 0.f; o[1][r] = 0.f; }
    float R = 0.f;
    LAS unsigned char* vt = F.lds + F.wave * 16384;
    const unsigned vt0 = F.lds0 + F.wave * 16384;
    const int g4 = lane >> 4, cb = g4 & 1, q4 = (lane & 15) >> 2, p4 = lane & 3;
    bf16x8 kn[2][4]; v4u vn[8];
    if (!SMP) {
#pragma unroll
        for (int mb = 0; mb < 2; ++mb) { const bf16* kp = Kb + (size_t)(krow0 + 64 * jt + 32 * mb + r32) * 512 + h * 64 + hi * 8;
#pragma unroll
            for (int d0 = 0; d0 < 4; ++d0) kn[mb][d0] = __builtin_bit_cast(bf16x8, *(const GAS v4u*)(kp + d0 * 16)); }
#pragma unroll
        for (int i = 0; i < 8; ++i) { const int c = lane + 64 * i, row = c >> 3, ch = c & 7; vn[i] = *(const GAS v4u*)(Vb + (size_t)(krow0 + 64 * jt + row) * 512 + h * 64 + ch * 8); }
    }
    for (; jt >= 0; --jt) {
        bf16x8 kf[2][4];
        if (!SMP) {
#pragma unroll
            for (int mb = 0; mb < 2; ++mb)
#pragma unroll
                for (int d0 = 0; d0 < 4; ++d0) kf[mb][d0] = kn[mb][d0];
#pragma unroll
            for (int i = 0; i < 8; ++i) { const int c = lane + 64 * i, row = c >> 3, ch = c & 7; *(LAS v4u*)(vt + row * 144 + ch * 16) = vn[i]; }
            const int jn = jt > 0 ? jt - 1 : 0;
#pragma unroll
            for (int mb = 0; mb < 2; ++mb) { const bf16* kp = Kb + (size_t)(krow0 + 64 * jn + 32 * mb + r32) * 512 + h * 64 + hi * 8;
#pragma unroll
                for (int d0 = 0; d0 < 4; ++d0) kn[mb][d0] = __builtin_bit_cast(bf16x8, *(const GAS v4u*)(kp + d0 * 16)); }
#pragma unroll
            for (int i = 0; i < 8; ++i) { const int c = lane + 64 * i, row = c >> 3, ch = c & 7; vn[i] = *(const GAS v4u*)(Vb + (size_t)(krow0 + 64 * jn + row) * 512 + h * 64 + ch * 8); }
        } else if (jt == PAST / 64) {
#pragma unroll
            for (int mb = 0; mb < 2; ++mb) { const int kv = 32 * mb + r32;
                const bf16* kp = Kb + (size_t)(MP + bs * NS + (kv < NS ? kv : NS - 1)) * 512 + h * 64 + hi * 8;
#pragma unroll
                for (int d0 = 0; d0 < 4; ++d0) kf[mb][d0] = __builtin_bit_cast(bf16x8, *(const GAS v4u*)(kp + d0 * 16)); }
#pragma unroll
            for (int i = 0; i < 8; ++i) { const int c = lane + 64 * i, row = c >> 3, ch = c & 7;
                const v4u v = *(const GAS v4u*)(Vb + (size_t)(MP + bs * NS + (row < NS ? row : NS - 1)) * 512 + h * 64 + ch * 8);
                *(LAS v4u*)(vt + row * 144 + ch * 16) = v; }
        } else {
#pragma unroll
            for (int mb = 0; mb < 2; ++mb) { const float* kp = ck + (size_t)(64 * jt + 32 * mb + r32) * 512 + hi * 8;
#pragma unroll
                for (int d0 = 0; d0 < 4; ++d0) { const f32x4 x0 = *(const f32x4*)(kp + d0 * 16), x1 = *(const f32x4*)(kp + d0 * 16 + 4);
                    v4u v; v.x = cvtpk(x0[0], x0[1]); v.y = cvtpk(x0[2], x0[3]); v.z = cvtpk(x1[0], x1[1]); v.w = cvtpk(x1[2], x1[3]); kf[mb][d0] = __builtin_bit_cast(bf16x8, v); } }
#pragma unroll
            for (int i = 0; i < 8; ++i) { const int c = lane + 64 * i, row = c >> 3, ch = c & 7; const float* vp = cv + (size_t)(64 * jt + row) * 512 + ch * 8;
                const f32x4 x0 = *(const f32x4*)vp, x1 = *(const f32x4*)(vp + 4);
                v4u v; v.x = cvtpk(x0[0], x0[1]); v.y = cvtpk(x0[2], x0[3]); v.z = cvtpk(x1[0], x1[1]); v.w = cvtpk(x1[2], x1[3]);
                *(LAS v4u*)(vt + row * 144 + ch * 16) = v; }
        }
        f32x16 p0, p1;
#pragma unroll
        for (int r = 0; r < 16; ++r) { p0[r] = 0.f; p1[r] = 0.f; }
#pragma unroll
        for (int d0 = 0; d0 < 4; ++d0) { p0 = MFMA32(kf[0][d0], qf[d0], p0); p1 = MFMA32(kf[1][d0], qf[d0], p1); }
        const bool diag = SMP ? (jt == PAST / 64) : (64 * jt + 63 >= t0);
        if (diag) {
#pragma unroll
            for (int r = 0; r < 16; ++r) { const int kp = 64 * jt + crow(r, hi); if (kp >= tq) p0[r] = -1e30f; if (kp + 32 >= tq) p1[r] = -1e30f; } }
        float cw[32];
#pragma unroll
        for (int r = 0; r < 16; ++r) { cw[r] = __builtin_amdgcn_logf(1.0f + __builtin_amdgcn_exp2f(p0[r])); cw[16 + r] = __builtin_amdgcn_logf(1.0f + __builtin_amdgcn_exp2f(p1[r])); }
        float gs[8], oth[8];
#pragma unroll
        for (int gq = 0; gq < 8; ++gq) { cw[4 * gq + 2] += cw[4 * gq + 3]; cw[4 * gq + 1] += cw[4 * gq + 2]; cw[4 * gq] += cw[4 * gq + 1]; gs[gq] = cw[4 * gq]; }
#pragma unroll
        for (int gq = 0; gq < 8; ++gq) oth[gq] = __shfl_xor(gs[gq], 32);
        float off[8]; float tail = 0.f;
#pragma unroll
        for (int gq = 7; gq >= 0; --gq) { off[gq] = tail + (hi == 0 ? oth[gq] : 0.f) + R; tail += gs[gq] + oth[gq]; }
        R += tail;
#pragma unroll
        for (int r = 0; r < 16; ++r) { p0[r] = __builtin_amdgcn_exp2f(p0[r] - cw[r] - off[r >> 2]); p1[r] = __builtin_amdgcn_exp2f(p1[r] - cw[16 + r] - off[4 + (r >> 2)]); }
        unsigned pk[16];
#pragma unroll
        for (int i = 0; i < 8; ++i) { pk[i] = cvtpk(p0[2 * i], p0[2 * i + 1]); pk[8 + i] = cvtpk(p1[2 * i], p1[2 * i + 1]); }
#pragma unroll
        for (int ks = 0; ks < 4; ++ks) { const bf16x8 pf = __builtin_bit_cast(bf16x8, (v4u){pk[4 * ks], pk[4 * ks + 1], pk[4 * ks + 2], pk[4 * ks + 3]});
#pragma unroll
            for (int nb = 0; nb < 2; ++nb) { const unsigned ad0 = vt0 + (16 * ks + 4 * hi + q4) * 144 + (32 * nb + 16 * cb + 4 * p4) * 2, ad1 = ad0 + 8 * 144;
                const s16x4 b0 = tr_read(ad0), b1 = tr_read(ad1);
                const bf16x8 vf = (bf16x8){b0[0], b0[1], b0[2], b0[3], b1[0], b1[1], b1[2], b1[3]};
                o[nb] = MFMA32(pf, vf, o[nb]); } }
        const float Reff = (r32 < nq) ? R : 1e30f;
        if (__all(Reff >= SB_EXIT)) break;
    }
    float ssq[16];
#pragma unroll
    for (int r = 0; r < 16; ++r) { ssq[r] = o[0][r] * o[0][r] + o[1][r] * o[1][r];
#pragma unroll
        for (int ofs = 1; ofs < 32; ofs <<= 1) ssq[r] += __shfl_xor(ssq[r], ofs); }
#pragma unroll
    for (int r = 0; r < 16; ++r) { if (SMP && r >= 8) continue;
        const int q = crow(r, hi); bf16* op = CAT + (size_t)(rowq0 + q) * 1024 + h * 64 + r32;
        op[0] = (bf16)(cvtpk(o[0][r], 0.f) & 0xffffu); op[32] = (bf16)(cvtpk(o[1][r], 0.f) & 0xffffu);
        SBSS[(size_t)(rowq0 + q) * 8 + h] = ssq[r]; }
}

template <bool SMP> __device__ __forceinline__ void mem_unit(const Args& a, const Frame& F, int l, int uidx) {
    unsigned char* ws = a.ws;
    const bf16* QM = (const bf16*)(ws + WS_QM); bf16* OM = (bf16*)(ws + WS_OM);
    int tid_ = F.wave * 64 + lane_id(); asm volatile("" : "+v"(tid_));
    const int tid = tid_, lane = tid & 63, r32 = lane & 31, hi = lane >> 5;
    int h, rowq0, nq, b;
    if (!SMP) { const int qb = uidx & 15, bh = uidx >> 4; h = bh & 3; b = bh >> 2; rowq0 = b * T + 256 * qb + 32 * F.wave; nq = 32; }
    else { h = uidx & 3; b = uidx >> 2; rowq0 = MP + b * NS; nq = NS; }
    const bool active = !SMP || F.wave == 0;
    if (!SMP) { const bf16* src = (const bf16*)(ws + WS_MK) + (size_t)(l * 4 + b) * 256 * 1024 + h * 256;
#pragma unroll 4
        for (int i = 0; i < 16; ++i) { const int c = tid + 512 * i, key = c >> 5, ch = c & 31;
            const v4u v = *(const GAS v4u*)(src + (size_t)key * 1024 + ch * 8);
            *(LAS v4u*)(F.lds + key * 512 + ((ch ^ (key & 31)) << 4)) = v; } }
    else { const float* src = a.in[4] + (size_t)(l * BS + b) * NMEM * D + h * 256;
#pragma unroll 4
        for (int i = 0; i < 16; ++i) { const int c = tid + 512 * i, key = c >> 5, ch = c & 31;
            const f32x4 x0 = *(const f32x4*)(src + (size_t)key * 1024 + ch * 8), x1 = *(const f32x4*)(src + (size_t)key * 1024 + ch * 8 + 4);
            v4u v; v.x = cvtpk(x0[0], x0[1]); v.y = cvtpk(x0[2], x0[3]); v.z = cvtpk(x1[0], x1[1]); v.w = cvtpk(x1[2], x1[3]);
            *(LAS v4u*)(F.lds + key * 512 + ((ch ^ (key & 31)) << 4)) = v; } }
    __syncthreads();
    f32x16 s[8]; unsigned pk[8][8]; float inv[16];
    if (active) {
#pragma unroll
        for (int kb = 0; kb < 8; ++kb)
#pragma unroll
            for (int r = 0; r < 16; ++r) s[kb][r] = 0.f;
        const bf16* qp = QM + (size_t)(rowq0 + (r32 < nq ? r32 : nq - 1)) * 1024 + h * 256 + hi * 8;
        const int xb = r32 ^ hi;
#pragma unroll 2
        for (int d0 = 0; d0 < 16; ++d0) {
            const bf16x8 qf = __builtin_bit_cast(bf16x8, *(const GAS v4u*)(qp + d0 * 16));
            LAS unsigned char* kp = F.lds + r32 * 512 + ((xb ^ (2 * d0)) << 4);
#pragma unroll
            for (int kb = 0; kb < 8; ++kb) { const bf16x8 kf = *(const LAS bf16x8*)(kp + kb * 16384); s[kb] = MFMA32(kf, qf, s[kb]); }
        }
        float mx = s[0][0];
#pragma unroll
        for (int kb = 0; kb < 8; ++kb)
#pragma unroll
            for (int r = 0; r < 16; ++r) mx = fmaxf(mx, s[kb][r]);
        mx = fmaxf(mx, __shfl_xor(mx, 32));
        float lsum = 0.f;
#pragma unroll
        for (int kb = 0; kb < 8; ++kb) {
#pragma unroll
            for (int r = 0; r < 16; ++r) { s[kb][r] = __builtin_amdgcn_exp2f(s[kb][r] - mx); lsum += s[kb][r]; }
#pragma unroll
            for (int i = 0; i < 8; ++i) pk[kb][i] = cvtpk(s[kb][2 * i], s[kb][2 * i + 1]); }
        lsum += __shfl_xor(lsum, 32);
        LAS float* wsf = (LAS float*)(F.lds + AUX_OFF) + F.wave * 64;
        if (hi == 0) wsf[r32] = lsum;
        LDS_WAIT();
#pragma unroll
        for (int r = 0; r < 16; ++r) inv[r] = __builtin_amdgcn_rcpf(wsf[crow(r, hi)]);
    }
    __syncthreads();
    if (!SMP) { const bf16* src = (const bf16*)(ws + WS_MV) + (size_t)(l * 4 + b) * 256 * 1024 + h * 256;
#pragma unroll 4
        for (int i = 0; i < 16; ++i) { const int c = tid + 512 * i, key = c >> 5, ch = c & 31;
            const v4u v = *(const GAS v4u*)(src + (size_t)key * 1024 + ch * 8);
            *(LAS v4u*)(F.lds + key * 512 + ((((ch >> 2) ^ (key & 3)) << 2 | (ch & 3)) << 4)) = v; } }
    else { const float* src = a.in[5] + (size_t)(l * BS + b) * NMEM * D + h * 256;
#pragma unroll 4
        for (int i = 0; i < 16; ++i) { const int c = tid + 512 * i, key = c >> 5, ch = c & 31;
            const f32x4 x0 = *(const f32x4*)(src + (size_t)key * 1024 + ch * 8), x1 = *(const f32x4*)(src + (size_t)key * 1024 + ch * 8 + 4);
            v4u v; v.x = cvtpk(x0[0], x0[1]); v.y = cvtpk(x0[2], x0[3]); v.z = cvtpk(x1[0], x1[1]); v.w = cvtpk(x1[2], x1[3]);
            *(LAS v4u*)(F.lds + key * 512 + ((((ch >> 2) ^ (key & 3)) << 2 | (ch & 3)) << 4)) = v; } }
    __syncthreads();
    if (active) {
        const int g4 = lane >> 4, cb = g4 & 1, q4 = (lane & 15) >> 2, p4 = lane & 3;
        const unsigned vb = F.lds0 + (4 * hi + q4) * 512 + (16 * cb + 4 * p4) * 2;
#pragma unroll 1
        for (int nb = 0; nb < 8; ++nb) { f32x16 o;
#pragma unroll
            for (int r = 0; r < 16; ++r) o[r] = 0.f;
            const unsigned vn = vb + ((nb ^ q4) << 6);
#pragma unroll
            for (int ks = 0; ks < 16; ++ks) { const bf16x8 pf = __builtin_bit_cast(bf16x8, (v4u){pk[ks >> 1][4 * (ks & 1)], pk[ks >> 1][4 * (ks & 1) + 1], pk[ks >> 1][4 * (ks & 1) + 2], pk[ks >> 1][4 * (ks & 1) + 3]});
                const s16x4 b0 = tr_read(vn + ks * 16 * 512), b1 = tr_read(vn + ks * 16 * 512 + 8 * 512);
                const bf16x8 vf = (bf16x8){b0[0], b0[1], b0[2], b0[3], b1[0], b1[1], b1[2], b1[3]};
                o = MFMA32(pf, vf, o); }
#pragma unroll
            for (int r = 0; r < 16; ++r) { if (SMP && r >= 8) continue; const int q = crow(r, hi); OM[(size_t)(rowq0 + q) * 1024 + h * 256 + 32 * nb + r32] = (bf16)(cvtpk(o[r] * inv[r], 0.f) & 0xffffu); }
        }
    }
    __syncthreads();
}

template <int MODE> __device__ __forceinline__ void mini_gemm(const Frame& F, unsigned char* ws, const bf16* A, const bf16* Bt, int K) {
    int tid_ = F.wave * 64 + lane_id(); asm volatile("" : "+v"(tid_));
    const int tid = tid_, lane = tid & 63, r32 = lane & 31, hi = lane >> 5, w = F.wave;
    const int rb = F.bid >> 4, cb = F.bid & 15, row0 = MP + 32 * rb, col0 = 64 * cb, KS = K >> 3;
    const bf16* ap = A + (size_t)(row0 + r32) * K + w * KS + hi * 8;
    const bf16* bp0 = Bt + (size_t)(col0 + r32) * K + w * KS + hi * 8; const bf16* bp1 = bp0 + (size_t)32 * K;
    f32x16 acc0, acc1;
#pragma unroll
    for (int r = 0; r < 16; ++r) { acc0[r] = 0.f; acc1[r] = 0.f; }
#pragma unroll 4
    for (int k = 0; k < KS; k += 16) {
        const bf16x8 af = __builtin_bit_cast(bf16x8, *(const GAS v4u*)(ap + k)), b0 = __builtin_bit_cast(bf16x8, *(const GAS v4u*)(bp0 + k)), b1 = __builtin_bit_cast(bf16x8, *(const GAS v4u*)(bp1 + k));
        acc0 = MFMA32(af, b0, acc0); acc1 = MFMA32(af, b1, acc1); }
    LAS float* P = (LAS float*)F.lds + w * 2048;
#pragma unroll
    for (int r = 0; r < 16; ++r) { P[crow(r, hi) * 64 + r32] = acc0[r]; P[crow(r, hi) * 64 + 32 + r32] = acc1[r]; }
    __syncthreads();
    const int row = tid >> 4, c4 = (tid & 15) * 4, grow = row0 + row, gcol = col0 + c4;
    f32x4 sb = (f32x4){0.f, 0.f, 0.f, 0.f}, sa = (f32x4){0.f, 0.f, 0.f, 0.f};
#pragma unroll
    for (int ww = 0; ww < 4; ++ww) { sb = sb + *(const LAS f32x4*)((LAS float*)F.lds + ww * 2048 + row * 64 + c4); sa = sa + *(const LAS f32x4*)((LAS float*)F.lds + (ww + 4) * 2048 + row * 64 + c4); }
    if (MODE == 2) { const float* SSQ = (const float*)(ws + WS_SSQ) + (size_t)grow * 16;
        const f32x4 q0 = *(const f32x4*)SSQ, q1 = *(const f32x4*)(SSQ + 4), q2 = *(const f32x4*)(SSQ + 8), q3 = *(const f32x4*)(SSQ + 12);
        const float s = (((q0[0] + q0[1]) + (q0[2] + q0[3])) + ((q1[0] + q1[1]) + (q1[2] + q1[3]))) + (((q2[0] + q2[1]) + (q2[2] + q2[3])) + ((q3[0] + q3[1]) + (q3[2] + q3[3])));
        const float r = __builtin_amdgcn_rsqf(s * (1.0f / 1024.0f) + EPS) * C_MEM; const f32x4 v = (sb + sa) * r;
        v2u o; o.x = cvtpk(v[0], v[1]); o.y = cvtpk(v[2], v[3]); *(GAS v2u*)((bf16*)(ws + WS_QM) + (size_t)grow * 1024 + gcol) = o;
    } else {
        f32x4 val = sb + sa;
        if (MODE == 1) { const float* SBSS = (const float*)(ws + WS_SBSS) + (size_t)grow * 8; const float* SASS = (const float*)(ws + WS_SASS) + (size_t)grow * 16;
            const f32x4 b0 = *(const f32x4*)SBSS, b1 = *(const f32x4*)(SBSS + 4), a0 = *(const f32x4*)SASS, a1 = *(const f32x4*)(SASS + 4), a2 = *(const f32x4*)(SASS + 8), a3 = *(const f32x4*)(SASS + 12);
            const float tb = ((b0[0] + b0[1]) + (b0[2] + b0[3])) + ((b1[0] + b1[1]) + (b1[2] + b1[3]));
            const float ta = (((a0[0] + a0[1]) + (a0[2] + a0[3])) + ((a1[0] + a1[1]) + (a1[2] + a1[3]))) + (((a2[0] + a2[1]) + (a2[2] + a2[3])) + ((a3[0] + a3[1]) + (a3[2] + a3[3])));
            val = sb * __builtin_amdgcn_rsqf(tb * (1.0f / 512.0f) + EPS) + sa * __builtin_amdgcn_rsqf(ta * (1.0f / 512.0f) + EPS); }
        float* xf = (float*)(ws + WS_XF) + (size_t)grow * 1024 + gcol;
        const f32x4 x = *(const f32x4*)xf + val; *(f32x4*)xf = x;
        v2u o; o.x = cvtpk(x[0], x[1]); o.y = cvtpk(x[2], x[3]); *(GAS v2u*)((bf16*)(ws + WS_XB) + (size_t)grow * 1024 + gcol) = o;
        float ss = (x[0] * x[0] + x[1] * x[1]) + (x[2] * x[2] + x[3] * x[3]);
        ss += __shfl_xor(ss, 1); ss += __shfl_xor(ss, 2); ss += __shfl_xor(ss, 4); ss += __shfl_xor(ss, 8);
        if ((tid & 15) == 0) ((float*)(ws + WS_SSQ))[(size_t)grow * 16 + cb] = ss;
    }
    __syncthreads();
}

__global__ void __launch_bounds__(NWAVES * 64, 2) mk_fwd(Args args) {
    extern __shared__ __attribute__((aligned(16))) unsigned char lds[];
    const int wave0 = __builtin_amdgcn_readfirstlane((int)threadIdx.x >> 6);
#define PH_FRAME() Frame F; { int w_ = wave0, g_ = (int)gridDim.x, b_ = (int)blockIdx.x; unsigned l0_ = (unsigned)(uintptr_t)lds; asm volatile("" : "+s"(w_), "+s"(g_), "+s"(b_), "+s"(l0_)); \
        F.lds = (LAS unsigned char*)lds; F.lds0 = l0_; F.wave = w_; F.G = g_; F.bid = b_; } \
        unsigned char* ws = args.ws; asm volatile("" : "+s"(ws));
    gu32* ctl; { unsigned char* ws0 = args.ws; ctl = (gu32*)(ws0 + WS_CTL); }
    for (int u = wave0 * 64 + lane_id(); u < (LDS_BYTES - LDSCTL_OFF) / 4; u += NWAVES * 64) ((LAS unsigned*)((LAS unsigned char*)lds + LDSCTL_OFF))[u] = 0u;
    __syncthreads();
    XcdBarrier bar = xcd_barrier_post((unsigned*)(ctl + CW_BAR), (volatile LAS unsigned*)((LAS unsigned char*)lds + MISC_OFF) + 8, wave0 * 64 + lane_id());
    const int lo = args.ph_lo, hi_ph = args.ph_hi; int ph = 0;
#define PH_ON() (lo <= ph && ph < hi_ph)
#define PH_END() do { if (lo <= ph && ph + 1 < hi_ph) xcd_barrier(bar, wave0 * 64 + lane_id()); ++ph; } while (0)

#ifndef NO_PRO
    if (PH_ON()) {
#pragma unroll 1
        for (int rp = 0; rp < REP_P; ++rp) { PH_FRAME(); prologue(args, F); } }
#endif
    PH_END();
    if (PH_ON()) { PH_FRAME(); pg8::Gemm g{(const bf16*)(ws + WS_MEMB), (const bf16*)(ws + WS_WMKV), NB * NMEM, 8 * D, D}; pg8::StaticOrder S; S.init(NB * NMEM, 8 * D, F.G, F.bid);
              pg8::EpiKV E{out_mk_p(args.out), out_mv_p(args.out), (bf16*)(ws + WS_MK), (bf16*)(ws + WS_MV)};
#ifndef NO_GKV
              pg8::gemm_phase<pg8::EpiKV, pg8::StaticOrder, true, true>(F.lds + RING_OFF, g, S, E, F.wave);
#endif
    }
    PH_END();
    for (int l = 0; l < NL; ++l) {
        if (PH_ON())
#pragma unroll 1
        for (int rp = 0; rp < REP_A; ++rp) { PH_FRAME(); const unsigned char* wl = ws + WS_WL + (size_t)l * WL_STRIDE;
            { pg8::Gemm g{(const bf16*)(ws + WS_XB), (const bf16*)(wl + WL_IN), M, INW, D}; pg8::StaticOrder S; S.init(M, INW, F.G, F.bid);
              pg8::EpiIn E{ws, args.out, l, C_SB};
#ifndef NO_GA
              pg8::gemm_phase<pg8::EpiIn, pg8::StaticOrder, true, true>(F.lds + RING_OFF, g, S, E, F.wave);
#endif
              }
        }
        PH_END();
        if (PH_ON())
#pragma unroll 1
        for (int rp = 0; rp < REP_B; ++rp) { PH_FRAME();
#ifndef NO_SGU
#pragma unroll 1
            for (int r2 = 0; r2 < REP_SGU; ++r2) {
            if (F.bid < 264) sgu_unit(args, F, l, F.bid);
            if (F.bid + 256 < 264) sgu_unit(args, F, l, F.bid + 256);
            }
#endif
            const int gw = F.bid * NWAVES + F.wave, NGW = F.G * NWAVES;
#ifndef NO_SB
#pragma unroll 1
            for (int r2 = 0; r2 < REP_SB; ++r2)
            for (int u = gw; u < NB * 8 * (T / 32); u += NGW) sb_unit<false>(args, F, l, u);
#ifndef NO_SBS
            if (NGW - 1 - gw < BS * 8) sb_unit<true>(args, F, l, NGW - 1 - gw);
#endif
#endif
            __syncthreads();
        }
        PH_END();
        if (PH_ON()) { PH_FRAME(); const unsigned char* wl = ws + WS_WL + (size_t)l * WL_STRIDE; pg8::Gemm g{(const bf16*)(ws + WS_CAT), (const bf16*)(wl + WL_OUT), MP, D, D}; pg8::StaticOrder S; S.init(MP, D, F.G, F.bid);
            pg8::EpiRes<true> E{ws, (LAS float*)(F.lds + AUX_OFF + 2048)};
#ifndef NO_GD
            pg8::gemm_phase<pg8::EpiRes<true>, pg8::StaticOrder, true, true>(F.lds + RING_OFF, g, S, E, F.wave);
#endif
            mini_gemm<1>(F, ws, (const bf16*)(ws + WS_CAT), (const bf16*)(wl + WL_OUT), D);
            }
        PH_END();
        if (PH_ON())
#pragma unroll 1
        for (int rp = 0; rp < REP_E; ++rp) { PH_FRAME(); const unsigned char* wl = ws + WS_WL + (size_t)l * WL_STRIDE; pg8::Gemm g{(const bf16*)(ws + WS_XB), (const bf16*)(wl + WL_MQ), MP, D, D}; pg8::StaticOrder S; S.init(MP, D, F.G, F.bid);
            pg8::EpiQ E{(const float*)(ws + WS_SSQ), (bf16*)(ws + WS_QM), C_MEM};
#ifndef NO_GE
            pg8::gemm_phase<pg8::EpiQ, pg8::StaticOrder, true, true>(F.lds + RING_OFF, g, S, E, F.wave);
#endif
            mini_gemm<2>(F, ws, (const bf16*)(ws + WS_XB), (const bf16*)(wl + WL_MQ), D);
            }
        PH_END();
        if (PH_ON())
#pragma unroll 1
        for (int rp = 0; rp < REP_F; ++rp) { PH_FRAME();
#ifndef NO_MEM
            if (F.bid < NB * 4 * (T / 256)) mem_unit<false>(args, F, l, F.bid);
#ifndef NO_MEMS
            if (F.bid < BS * 4) mem_unit<true>(args, F, l, F.bid);
#endif
#endif
            __syncthreads();
        }
        PH_END();
        if (PH_ON()) { PH_FRAME(); const unsigned char* wl = ws + WS_WL + (size_t)l * WL_STRIDE; pg8::Gemm g{(const bf16*)(ws + WS_OM), (const bf16*)(wl + WL_MO), MP, D, D}; pg8::StaticOrder S; S.init(MP, D, F.G, F.bid);
            pg8::EpiRes<false> E{ws, nullptr};
#ifndef NO_GG
            pg8::gemm_phase<pg8::EpiRes<false>, pg8::StaticOrder, true, true>(F.lds + RING_OFF, g, S, E, F.wave);
#endif
            mini_gemm<0>(F, ws, (const bf16*)(ws + WS_OM), (const bf16*)(wl + WL_MO), D);
            }
        PH_END();
        if (PH_ON())
#pragma unroll 1
        for (int rp = 0; rp < REP_H; ++rp) { PH_FRAME(); const unsigned char* wl = ws + WS_WL + (size_t)l * WL_STRIDE; pg8::Gemm g{(const bf16*)(ws + WS_XB), (const bf16*)(wl + WL_GU), M, 2 * DFF, D}; pg8::StaticOrder S; S.init(M, 2 * DFF, F.G, F.bid);
            pg8::EpiGU E{(const float*)(ws + WS_SSQ), (bf16*)(ws + WS_H)};
#ifndef NO_GH
            pg8::gemm_phase<pg8::EpiGU, pg8::StaticOrder, true, true>(F.lds + RING_OFF, g, S, E, F.wave);
#endif
            }
        PH_END();
        if (PH_ON()) { PH_FRAME(); const unsigned char* wl = ws + WS_WL + (size_t)l * WL_STRIDE; pg8::Gemm g{(const bf16*)(ws + WS_H), (const bf16*)(wl + WL_DN), MP, D, DFF}; pg8::StaticOrder S; S.init(MP, D, F.G, F.bid);
            pg8::EpiRes<false> E{ws, nullptr};
#ifndef NO_GI
            pg8::gemm_phase<pg8::EpiRes<false>, pg8::StaticOrder, true, true>(F.lds + RING_OFF, g, S, E, F.wave);
#endif
            mini_gemm<0>(F, ws, (const bf16*)(ws + WS_H), (const bf16*)(wl + WL_DN), DFF);
            }
        PH_END();
    }
    if (PH_ON()) { PH_FRAME();
        const float* gf = args.in[24]; const int gw = F.bid * NWAVES + F.wave, NGW = F.G * NWAVES;
        for (int m = gw; m < M; m += NGW) {
            float s = lane_id() < 16 ? ((const float*)(ws + WS_SSQ))[(size_t)m * 16 + lane_id()] : 0.f;
            s += __shfl_xor(s, 1); s += __shfl_xor(s, 2); s += __shfl_xor(s, 4); s += __shfl_xor(s, 8);
            s = __shfl(s, 0);
            const float rstd = __builtin_amdgcn_rsqf(s * (1.0f / 1024.0f) + EPS);
            float* dst = m < MP ? out_y_p(args.out) + (size_t)m * D : out_y_s(args.out) + (size_t)(m - MP) * D;
#pragma unroll
            for (int j = 0; j < 4; ++j) { const f32x4 v = ((const f32x4*)((const float*)(ws + WS_XF) + (size_t)m * D))[lane_id() + 64 * j]; const f32x4 gg = ((const f32x4*)gf)[lane_id() + 64 * j];
                ((f32x4*)dst)[lane_id() + 64 * j] = v * rstd * gg; }
        }
    }
#undef PH_ON
#undef PH_END
}

static int mk_grid = 0;
static void mk_launch(void* const* d_in, float* out, unsigned char* ws, hipStream_t stream, int ph_lo, int ph_hi) {
    if (mk_grid == 0) {
        int dev = 0, cus = 0;
        if (hipGetDevice(&dev) != hipSuccess || hipDeviceGetAttribute(&cus, hipDeviceAttributeMultiprocessorCount, dev) != hipSuccess) { mk_grid = -1; return; }
        if (hipFuncSetAttribute((const void*)mk_fwd, hipFuncAttributeMaxDynamicSharedMemorySize, LDS_BYTES) != hipSuccess) { mk_grid = -1; return; }
        (void)hipGetLastError();
        mk_grid = cus;
    }
    if (mk_grid < 0) return;
    (void)hipMemsetAsync(ws + WS_CTL, 0, CTL_ZERO_BYTES, stream);
    Args a{};
    for (int i = 0; i < 25; ++i) a.in[i] = (const float*)d_in[i];
    a.out = out; a.ws = ws; a.ph_lo = ph_lo; a.ph_hi = ph_hi;
    hipLaunchKernelGGL(mk_fwd, dim3(mk_grid), dim3(NWAVES * 64), LDS_BYTES, stream, a);
}
extern "C" void kernel_launch(void* const* d_in, const int* in_sizes, int n_in, void* d_out, int out_size, void* d_ws, size_t ws_size, hipStream_t stream) {
    mk_launch(d_in, (float*)d_out, (unsigned char*)d_ws, stream, 0, 35);
}
```

```cpp
#include <hip/hip_runtime.h>
#include <cstdint>
#include <cstdio>
#include <cmath>
namespace pg8 {
#define PG8_LAS __attribute__((address_space(3)))
typedef unsigned short bf16_t;
typedef short bf16x8 __attribute__((ext_vector_type(8)));
typedef float f32x4 __attribute__((ext_vector_type(4)));
typedef unsigned u32x4 __attribute__((ext_vector_type(4)));
constexpr int BM = 256, BK = 64, HALF = 128, HTB = HALF * BK * 2  , STAGE_BYTES = 8 * HTB, NXCD = 8, WGM = 8;

__host__ __device__ __forceinline__ int lds_byte(int r, int c) { const int st = (r >> 4) * 2 + (c >> 5), rr = r & 15, cc = c & 31, ob = rr * 64 + cc * 2; return st * 1024 + (ob ^ (((ob >> 9) & 1) << 5)); }
__host__ __device__ __forceinline__ void stage_rc(int b, int& R, int& C) { const int st = b / 1024, sb = b % 1024, swz = sb ^ (((sb >> 9) & 1) << 5); R = (st >> 1) * 16 + swz / 64; C = (st & 1) * 32 + (swz % 64) / 2; }
__host__ __device__ __forceinline__ int perm32(int rho) { const int n = rho >> 4, i = rho & 15; return 8 * (i >> 2) + 4 * n + (i & 3); }

template <int CTRL> __device__ __forceinline__ float xl_dpp(float v) { return __builtin_bit_cast(float, __builtin_amdgcn_mov_dpp(__builtin_bit_cast(int, v), CTRL, 0xF, 0xF, true)); }
__device__ __forceinline__ float xl_sum16(float v) {
    v += xl_dpp<0xB1>(v); v += xl_dpp<0x4E>(v); v += xl_dpp<0x141>(v); v += xl_dpp<0x140>(v); return v; }
__device__ __forceinline__ void xl_swap16(float v, float& a, float& b) { a = v; b = v; asm volatile("s_nop 1\n\tv_permlane16_swap_b32 %0, %1" : "+v"(a), "+v"(b)); }
__device__ __forceinline__ void xl_swap32(float v, float& a, float& b) { a = v; b = v; asm volatile("s_nop 1\n\tv_permlane32_swap_b32 %0, %1" : "+v"(a), "+v"(b)); }
__device__ __forceinline__ float xl_sum_x16(float v) { float a, b; xl_swap16(v, a, b); return a + b; }
__device__ __forceinline__ float xl_sum_x32(float v) { float a, b; xl_swap32(v, a, b); return a + b; }
__device__ __forceinline__ float xl_max_x32(float v) { float a, b; xl_swap32(v, a, b); return fmaxf(a, b); }
__device__ __forceinline__ float xl_other_x32(float v, int hi) { float a, b; xl_swap32(v, a, b); return hi ? a : b; }
__device__ __forceinline__ int pg8_lane_id() { int l_; asm volatile("v_mbcnt_lo_u32_b32 %0, -1, 0\n\tv_mbcnt_hi_u32_b32 %0, -1, %0" : "=v"(l_)); return l_; }
struct Unit { int pm, pn; };
struct Gemm { const bf16_t* A; const bf16_t* Bt; int M, N, K; };

struct StaticOrder {
    int nM, nN, nwg, G, c;
    __host__ __device__ void init(int M, int N, int G_, int c_) { nM = M / BM; nN = N / BM; nwg = nM * nN; G = G_; c = c_; }
    __host__ __device__ bool next(int i, Unit& u) const {
        const long L = (long)i * G + c; if (L >= nwg) return false;
        int wgid = (int)L; { const int q = nwg / NXCD, r = nwg % NXCD, xcd = wgid % NXCD, off = wgid / NXCD; wgid = (xcd < r ? xcd * (q + 1) : r * (q + 1) + (xcd - r) * q) + off; }
        const int nig = WGM * nN, gid = wgid / nig, fm = gid * WGM, gsz = (nM - fm) < WGM ? (nM - fm) : WGM;
        u.pm = fm + ((wgid % nig) % gsz); u.pn = nN - 1 - (wgid % nig) / gsz; return true;
    }
    __device__ __forceinline__ void a_ready(const Unit&) const {}
    __device__ __forceinline__ void done(const Unit&) const {}
};

__device__ __forceinline__ unsigned cvt_pk_bf16(float lo, float hi) { unsigned r; asm volatile("v_cvt_pk_bf16_f32 %0, %1, %2" : "=v"(r) : "v"(lo), "v"(hi)); return r; }
typedef float f32x2 __attribute__((ext_vector_type(2)));
constexpr int E_MP = 16384, E_MS = 512;
constexpr size_t EMiB = 1u << 20, EW_SSQ = 148 * EMiB, EW_SBSS = 150 * EMiB, EW_SASS = 527 * EMiB, EW_XF = 152 * EMiB, EW_XB = 218 * EMiB, EW_U = 251 * EMiB, EW_VA = 268 * EMiB, EW_Q = 285 * EMiB, EW_K = 302 * EMiB, EW_V = 319 * EMiB;
constexpr size_t EO_SBK_P = (size_t)16896 * 1024, EO_SBV_P = EO_SBK_P + (size_t)4 * 16384 * 512, EO_MK_P = EO_SBV_P + (size_t)4 * 16384 * 512, EO_MV_P = EO_MK_P + (size_t)4 * 4 * 256 * 1024, EO_SBK_S = EO_MV_P + (size_t)4 * 4 * 256 * 1024, EO_SBV_S = EO_SBK_S + (size_t)4 * 512 * 512;
constexpr float E_EPS = 1e-6f, E_LOG2E = 1.4426950408889634f;
typedef unsigned u32x2 __attribute__((ext_vector_type(2)));
__device__ __forceinline__ void load_rstd(const float* SSQ, int row0, int fq, float (&rs)[2][4]) {
#pragma unroll
    for (int ai = 0; ai < 2; ++ai)
#pragma unroll
        for (int m = 0; m < 4; ++m) { const f32x4 a = *(const f32x4*)(SSQ + (size_t)(row0 + ai * HALF + m * 16) * 16 + fq * 4);
            float s = (a[0] + a[1]) + (a[2] + a[3]); s = xl_sum_x16(s); s = xl_sum_x32(s);
            rs[ai][m] = __builtin_amdgcn_rsqf(s * (1.0f / 1024.0f) + E_EPS); }
}
__device__ __forceinline__ void prep_rstd(const float* SSQ, PG8_LAS float* aux, const Unit& u, int ui, int tid) {
    if (tid < 256) { const f32x4* p = (const f32x4*)(SSQ + (size_t)(u.pm * BM + tid) * 16); const f32x4 a = p[0], b = p[1], c = p[2], d = p[3];
        const float s = (((a[0] + a[1]) + (a[2] + a[3])) + ((b[0] + b[1]) + (b[2] + b[3]))) + (((c[0] + c[1]) + (c[2] + c[3])) + ((d[0] + d[1]) + (d[2] + d[3])));
        aux[(ui & 1) * 256 + tid] = __builtin_amdgcn_rsqf(s * (1.0f / 1024.0f) + E_EPS); }
}
__device__ __forceinline__ void aux_rstd(const PG8_LAS float* aux, int ui, int wr, int fr, float (&rs)[2][4]) {
#pragma unroll
    for (int ai = 0; ai < 2; ++ai)
#pragma unroll
        for (int m = 0; m < 4; ++m) rs[ai][m] = aux[(ui & 1) * 256 + ai * HALF + wr * 64 + m * 16 + fr];
}
__device__ __forceinline__ float gelu_tanh_f(float x) {
    const float y = x * (1.0f + 0.044715f * x * x);
    const float e = __builtin_amdgcn_exp2f(y * (-2.0f * 0.7978845608028654f * E_LOG2E));
    return x * __builtin_amdgcn_rcpf(1.0f + e);
}
__device__ __forceinline__ u32x4 pack8(const f32x4 a, const f32x4 b) { u32x4 w; w.x = cvt_pk_bf16(a[0], a[1]); w.y = cvt_pk_bf16(a[2], a[3]); w.z = cvt_pk_bf16(b[0], b[1]); w.w = cvt_pk_bf16(b[2], b[3]); return w; }

struct EpiIn {
    static constexpr bool PERM = true, AFTER_DRAIN = false, MIDSCALE = false, PREP = true; static constexpr int MID_T = 0;
    unsigned char* ws; float* out; int l; float qscale; PG8_LAS float* aux;
    __device__ __forceinline__ void midscale(f32x4 (&)[2][2][4][2], const Unit&, int, int, int) const {}
    __device__ __forceinline__ void prepare(const Unit& u, int ui, int tid) const { size_t z_ = 0; asm volatile("" : "+s"(z_)); prep_rstd((const float*)(ws + z_ + EW_SSQ), aux, u, ui, tid); }
    __device__ __forceinline__ void operator()(const f32x4 (&acc)[2][2][4][2], const Unit& u, int wr, int wc, int fr, int fq, int ui) const {
        size_t z_ = 0; asm volatile("" : "+s"(z_)); unsigned char* w = ws + z_; float* o = out + z_;
        const int row0 = u.pm * BM + wr * 64 + fr, typ = u.pn >> 1, col0 = (u.pn & 1) * 256 + wc * 32 + 8 * fq;
        float rs[2][4]; aux_rstd(aux, ui, wr, fr, rs);
        bf16_t* ob = (bf16_t*)(w + (typ == 0 ? EW_U : typ == 1 ? EW_VA : typ == 2 ? EW_Q : typ == 3 ? EW_K : EW_V));
        float* of = nullptr;
        if (typ >= 3) { const bool smp = u.pm * BM >= E_MP;
            of = o + (smp ? (typ == 3 ? EO_SBK_S : EO_SBV_S) + (size_t)l * E_MS * 512 - (size_t)E_MP * 512 : (typ == 3 ? EO_SBK_P : EO_SBV_P) + (size_t)l * E_MP * 512); }
#pragma unroll
        for (int ai = 0; ai < 2; ++ai)
#pragma unroll
            for (int m = 0; m < 4; ++m) { const int row = row0 + ai * HALF + m * 16; const float r = rs[ai][m];
#pragma unroll
                for (int bj = 0; bj < 2; ++bj) { f32x4 v0 = acc[ai][bj][m][0] * r, v1 = acc[ai][bj][m][1] * r; const size_t off = (size_t)row * 512 + col0 + bj * HALF;
                    if (typ <= 1) {
#pragma unroll
                        for (int i = 0; i < 4; ++i) { v0[i] = gelu_tanh_f(v0[i]); v1[i] = gelu_tanh_f(v1[i]); } }
                    else if (typ == 2) { v0 = v0 * qscale; v1 = v1 * qscale; }
                    else { *(f32x4*)(of + off) = v0; *(f32x4*)(of + off + 4) = v1; }
                    *(u32x4*)(ob + off) = pack8(v0, v1); }
                asm volatile("" ::: "memory"); }
    }
};
template <bool MID> struct EpiRes {
    static constexpr bool PERM = true, AFTER_DRAIN = false, MIDSCALE = MID, PREP = MID; static constexpr int MID_T = 8;
    unsigned char* ws; PG8_LAS float* aux;
    __device__ __forceinline__ void prepare(const Unit& u, int ui, int tid) const {
        if (MID && tid < 256) { size_t z_ = 0; asm volatile("" : "+s"(z_)); unsigned char* w = ws + z_; const float* SBSS = (const float*)(w + EW_SBSS); const float* SASS = (const float*)(w + EW_SASS);
            const size_t row = (size_t)(u.pm * BM + tid);
            const f32x4 b0 = *(const f32x4*)(SBSS + row * 8), b1 = *(const f32x4*)(SBSS + row * 8 + 4);
            const f32x4 a0 = *(const f32x4*)(SASS + row * 16), a1 = *(const f32x4*)(SASS + row * 16 + 4), a2 = *(const f32x4*)(SASS + row * 16 + 8), a3 = *(const f32x4*)(SASS + row * 16 + 12);
            const float sb = ((b0[0] + b0[1]) + (b0[2] + b0[3])) + ((b1[0] + b1[1]) + (b1[2] + b1[3]));
            const float sa = (((a0[0] + a0[1]) + (a0[2] + a0[3])) + ((a1[0] + a1[1]) + (a1[2] + a1[3]))) + (((a2[0] + a2[1]) + (a2[2] + a2[3])) + ((a3[0] + a3[1]) + (a3[2] + a3[3])));
            const float rb = __builtin_amdgcn_rsqf(sb * (1.0f / 512.0f) + E_EPS), qa = sa * (1.0f / 512.0f) + E_EPS;
            aux[(ui & 1) * 512 + tid] = rb * __builtin_amdgcn_sqrtf(qa); aux[(ui & 1) * 512 + 256 + tid] = __builtin_amdgcn_rsqf(qa); }
    }
    __device__ __forceinline__ void midscale(f32x4 (&acc)[2][2][4][2], const Unit& u, int wr, int fr, int ui) const {
#pragma unroll
        for (int ai = 0; ai < 2; ++ai)
#pragma unroll
            for (int m = 0; m < 4; ++m) { const float r = aux[(ui & 1) * 512 + ai * HALF + wr * 64 + m * 16 + fr];
#pragma unroll
                for (int bj = 0; bj < 2; ++bj)
#pragma unroll
                    for (int n = 0; n < 2; ++n) acc[ai][bj][m][n] = acc[ai][bj][m][n] * r; }
    }
    __device__ __forceinline__ void operator()(const f32x4 (&acc)[2][2][4][2], const Unit& u, int wr, int wc, int fr, int fq, int ui) const {
        size_t z_ = 0; asm volatile("" : "+s"(z_)); unsigned char* w = ws + z_; bf16_t* XB = (bf16_t*)(w + EW_XB); float* SSQ = (float*)(w + EW_SSQ);
        const int row0 = u.pm * BM + wr * 64 + fr, col0 = u.pn * BM + wc * 32 + 8 * fq;
#pragma unroll
        for (int ai = 0; ai < 2; ++ai) {
            u32x4 xo[4][2];
#pragma unroll
            for (int m = 0; m < 4; ++m)
#pragma unroll
                for (int bj = 0; bj < 2; ++bj) xo[m][bj] = *(const u32x4*)(XB + (size_t)(row0 + ai * HALF + m * 16) * 1024 + col0 + bj * HALF);
            asm volatile("" : "+v"(xo[0][0]), "+v"(xo[0][1]), "+v"(xo[1][0]), "+v"(xo[1][1]), "+v"(xo[2][0]), "+v"(xo[2][1]), "+v"(xo[3][0]), "+v"(xo[3][1]));
#pragma unroll
            for (int m = 0; m < 4; ++m) { const int row = row0 + ai * HALF + m * 16; float ss = 0.f, ra = 1.0f;
                if (MID) ra = aux[(ui & 1) * 512 + 256 + ai * HALF + wr * 64 + m * 16 + fr];
#pragma unroll
                for (int bj = 0; bj < 2; ++bj) { const size_t off = (size_t)row * 1024 + col0 + bj * HALF;
                    const u32x4 xv = xo[m][bj];
                    f32x4 x0, x1;
                    x0[0] = __uint_as_float(xv.x << 16); x0[1] = __uint_as_float(xv.x & 0xffff0000u); x0[2] = __uint_as_float(xv.y << 16); x0[3] = __uint_as_float(xv.y & 0xffff0000u);
                    x1[0] = __uint_as_float(xv.z << 16); x1[1] = __uint_as_float(xv.z & 0xffff0000u); x1[2] = __uint_as_float(xv.w << 16); x1[3] = __uint_as_float(xv.w & 0xffff0000u);
                    x0 = x0 + (MID ? acc[ai][bj][m][0] * ra : acc[ai][bj][m][0]); x1 = x1 + (MID ? acc[ai][bj][m][1] * ra : acc[ai][bj][m][1]);
                    *(u32x4*)(XB + off) = pack8(x0, x1);
                    ss += ((x0[0] * x0[0] + x0[1] * x0[1]) + (x0[2] * x0[2] + x0[3] * x0[3])) + ((x1[0] * x1[0] + x1[1] * x1[1]) + (x1[2] * x1[2] + x1[3] * x1[3])); }
                ss = xl_sum_x16(ss); ss = xl_sum_x32(ss);
                if (fq == 0) SSQ[(size_t)row * 16 + u.pn * 4 + wc] = ss; }
        }
    }
};
struct EpiQ {
    static constexpr bool PERM = true, AFTER_DRAIN = false, MIDSCALE = false, PREP = true; static constexpr int MID_T = 0;
    const float* SSQ; bf16_t* QM; float qscale; PG8_LAS float* aux;
    __device__ __forceinline__ void midscale(f32x4 (&)[2][2][4][2], const Unit&, int, int, int) const {}
    __device__ __forceinline__ void prepare(const Unit& u, int ui, int tid) const { prep_rstd(SSQ, aux, u, ui, tid); }
    __device__ __forceinline__ void operator()(const f32x4 (&acc)[2][2][4][2], const Unit& u, int wr, int wc, int fr, int fq, int ui) const {
        const int row0 = u.pm * BM + wr * 64 + fr, col0 = u.pn * BM + wc * 32 + 8 * fq;
        float rs[2][4]; aux_rstd(aux, ui, wr, fr, rs);
#pragma unroll
        for (int ai = 0; ai < 2; ++ai)
#pragma unroll
            for (int m = 0; m < 4; ++m) { const float r = rs[ai][m] * qscale; bf16_t* rowp = QM + (size_t)(row0 + ai * HALF + m * 16) * 1024 + col0;
#pragma unroll
                for (int bj = 0; bj < 2; ++bj) *(u32x4*)(rowp + bj * HALF) = pack8(acc[ai][bj][m][0] * r, acc[ai][bj][m][1] * r); }
    }
};
struct EpiGU {
    static constexpr bool PERM = true, AFTER_DRAIN = false, MIDSCALE = false, PREP = true; static constexpr int MID_T = 0;
    const float* SSQ; bf16_t* H; PG8_LAS float* aux;
    __device__ __forceinline__ void midscale(f32x4 (&)[2][2][4][2], const Unit&, int, int, int) const {}
    __device__ __forceinline__ void prepare(const Unit& u, int ui, int tid) const { prep_rstd(SSQ, aux, u, ui, tid); }
    __device__ __forceinline__ void operator()(const f32x4 (&acc)[2][2][4][2], const Unit& u, int wr, int wc, int fr, int fq, int ui) const {
        const int row0 = u.pm * BM + wr * 64 + fr, col0 = u.pn * HALF + wc * 32 + 8 * fq;
        float rs[2][4]; aux_rstd(aux, ui, wr, fr, rs);
#pragma unroll
        for (int ai = 0; ai < 2; ++ai)
#pragma unroll
            for (int m = 0; m < 4; ++m) { const float r = rs[ai][m]; f32x4 h[2];
#pragma unroll
                for (int n = 0; n < 2; ++n) { const f32x4 g = acc[ai][0][m][n] * r, uu = acc[ai][1][m][n] * r;
#pragma unroll
                    for (int i = 0; i < 4; ++i) h[n][i] = g[i] * uu[i] * __builtin_amdgcn_rcpf(1.0f + __builtin_amdgcn_exp2f(-E_LOG2E * g[i])); }
                *(u32x4*)(H + (size_t)(row0 + ai * HALF + m * 16) * 2816 + col0) = pack8(h[0], h[1]); }
    }
};
struct EpiKV {
    static constexpr bool PERM = true, AFTER_DRAIN = false, MIDSCALE = false, PREP = false; static constexpr int MID_T = 0;
    float *mk_out, *mv_out; bf16_t *MK, *MVt; int pn0;
    __device__ __forceinline__ void midscale(f32x4 (&)[2][2][4][2], const Unit&, int, int, int) const {}
    __device__ __forceinline__ void prepare(const Unit&, int, int) const {}
    __device__ __forceinline__ void operator()(const f32x4 (&acc)[2][2][4][2], const Unit& u, int wr, int wc, int fr, int fq, int ui) const {
        const int pn = u.pn + pn0, l = pn >> 3, isv = (pn >> 2) & 1, hh = pn & 3, b = u.pm;
        const int key0 = wr * 64 + fr, col0 = hh * 256 + wc * 32 + 8 * fq;
        float* of = (isv ? mv_out : mk_out) + (size_t)(l * 4 + b) * 256 * 1024 + (size_t)key0 * 1024 + col0;
#pragma unroll
        for (int ai = 0; ai < 2; ++ai)
#pragma unroll
            for (int m = 0; m < 4; ++m) { float* p = of + (size_t)(ai * HALF + m * 16) * 1024;
#pragma unroll
                for (int bj = 0; bj < 2; ++bj) { *(f32x4*)(p + bj * HALF) = acc[ai][bj][m][0]; *(f32x4*)(p + bj * HALF + 4) = acc[ai][bj][m][1]; }
                asm volatile("" ::: "memory"); }
        bf16_t* ob = (isv ? MVt : MK) + ((size_t)(l * 4 + b) * 256 + key0) * 1024 + col0;
#pragma unroll
        for (int ai = 0; ai < 2; ++ai)
#pragma unroll
            for (int m = 0; m < 4; ++m) {
#pragma unroll
                for (int bj = 0; bj < 2; ++bj) *(u32x4*)(ob + (size_t)(ai * HALF + m * 16) * 1024 + bj * HALF) = pack8(acc[ai][bj][m][0], acc[ai][bj][m][1]);
                asm volatile("" ::: "memory"); }
    }
};
template <class Epi, class Sched, bool ALIGN_EPI = false, bool SP2 = false, bool KREV = false>
__device__ __forceinline__ void gemm_phase(PG8_LAS unsigned char* lds, const Gemm g, const Sched& S, const Epi& E, int wave_id) {
    int tid_ = wave_id * 64 + pg8_lane_id(); asm volatile("" : "+v"(tid_));
    const int tid = tid_, wid = __builtin_amdgcn_readfirstlane(tid >> 6), lane = tid & 63, wr = wid >> 2, wc = wid & 3, fr = lane & 15, fq = lane >> 4;
    const int K = g.K, nt = K / BK;
    unsigned voffA[2], voffB[2];
#pragma unroll
    for (int i = 0; i < 2; ++i) { int R, C; stage_rc(tid * 16 + i * 8192, R, C); const int Rb = Epi::PERM ? ((R & ~31) + perm32(R & 31)) : R;
        voffA[i] = (unsigned)(R * K + C) * 2u; voffB[i] = (unsigned)(Rb * K + C) * 2u; }
    const ptrdiff_t kstep = KREV ? -(ptrdiff_t)(BK * 2) : (ptrdiff_t)(BK * 2);
    const size_t k0off = KREV ? (size_t)(nt - 1) * (BK * 2) : 0;
    const size_t hstep = (size_t)HALF * K * 2;
    const size_t tstep = 2 * hstep;
    const unsigned ldsw = (unsigned)wid * 1024u;
    const int aoff = lds_byte(wr * 64 + fr, fq * 8), boff = lds_byte(wc * 32 + fr, fq * 8);
#define PG8_SA(b, h) (((b) * 2 + (h)) * HTB)
#define PG8_SB(b, h) ((4 + (b) * 2 + (h)) * HTB)
#define PG8_STAGE(bufoff, gbase, voff) do { _Pragma("unroll") for (int _i = 0; _i < 2; ++_i) \
        __builtin_amdgcn_global_load_lds((const unsigned*)((const char*)(gbase) + (voff)[_i]), (PG8_LAS unsigned*)(lds + (bufoff) + ldsw + _i * 8192), 16, 0, 0); } while (0)
#define PG8_LDA(dst, b, h) do { _Pragma("unroll") for (int m = 0; m < 4; ++m) _Pragma("unroll") for (int k = 0; k < 2; ++k) dst[m][k] = *(const PG8_LAS bf16x8*)(lds + PG8_SA(b, h) + aoff + m * 2048 + k * 1024); } while (0)
#define PG8_LDB(dst, b, h) do { _Pragma("unroll") for (int n = 0; n < 2; ++n) _Pragma("unroll") for (int k = 0; k < 2; ++k) dst[n][k] = *(const PG8_LAS bf16x8*)(lds + PG8_SB(b, h) + boff + n * 2048 + k * 1024); } while (0)
#define PG8_MMA(ai, bj, At, Bt) do { __builtin_amdgcn_s_setprio(1); _Pragma("unroll") for (int m = 0; m < 4; ++m) _Pragma("unroll") for (int n = 0; n < 2; ++n) _Pragma("unroll") for (int k = 0; k < 2; ++k) \
        acc[ai][bj][m][n] = __builtin_amdgcn_mfma_f32_16x16x32_bf16(Bt[n][k], At[m][k], acc[ai][bj][m][n], 0, 0, 0); __builtin_amdgcn_s_setprio(0); } while (0)
#define PG8_WAIT_V(n) asm volatile("s_waitcnt vmcnt(" #n ")" ::: "memory")
#define PG8_WAIT_L(n) asm volatile("s_waitcnt lgkmcnt(" #n ")" ::: "memory")
#define PG8_BAR __builtin_amdgcn_s_barrier()
#define PG8_SCHED __builtin_amdgcn_sched_barrier(0)
    Unit cur, nxt; int ui = 0;
    if (!S.next(0, cur)) return;
    f32x4 acc[2][2][4][2];
#pragma unroll
    for (int a = 0; a < 2; ++a)
#pragma unroll
        for (int b = 0; b < 2; ++b)
#pragma unroll
            for (int m = 0; m < 4; ++m)
#pragma unroll
                for (int n = 0; n < 2; ++n) acc[a][b][m][n] = (f32x4){0.f, 0.f, 0.f, 0.f};
    bf16x8 At[4][2], B0[2][2], B1[2][2];
    const char* cA = (const char*)g.A + (size_t)cur.pm * tstep + k0off; const char* cB = (const char*)g.Bt + (size_t)cur.pn * tstep + k0off;
    S.a_ready(cur);
    if constexpr (Epi::PREP) E.prepare(cur, 0, tid);
    if constexpr (SP2) {
        PG8_STAGE(PG8_SB(0, 0), cB, voffB); PG8_STAGE(PG8_SB(0, 1), cB + hstep, voffB); PG8_STAGE(PG8_SA(0, 0), cA, voffA); PG8_STAGE(PG8_SA(0, 1), cA + hstep, voffA);
        if (wr == 1) PG8_BAR;
        PG8_WAIT_V(2); PG8_BAR;
        PG8_STAGE(PG8_SB(1, 0), cB + kstep, voffB); PG8_STAGE(PG8_SA(1, 0), cA + kstep, voffA); PG8_STAGE(PG8_SB(1, 1), cB + hstep + kstep, voffB);
        PG8_WAIT_V(6); PG8_BAR;
    } else {
        PG8_STAGE(PG8_SB(0, 0), cB, voffB); PG8_STAGE(PG8_SA(0, 0), cA, voffA); PG8_STAGE(PG8_SB(0, 1), cB + hstep, voffB); PG8_STAGE(PG8_SA(0, 1), cA + hstep, voffA);
        if (wr == 1) PG8_BAR;
        PG8_WAIT_V(4); PG8_BAR;
        PG8_STAGE(PG8_SB(1, 0), cB + kstep, voffB); PG8_STAGE(PG8_SA(1, 0), cA + kstep, voffA); PG8_STAGE(PG8_SB(1, 1), cB + hstep + kstep, voffB);
        PG8_WAIT_V(6); PG8_BAR;
    }
    for (;;) {
        const bool has_next = S.next(ui + 1, nxt);
        const char* nA = has_next ? (const char*)g.A + (size_t)nxt.pm * tstep + k0off : cA; const char* nB = has_next ? (const char*)g.Bt + (size_t)nxt.pn * tstep + k0off : cB;
        for (int t = 0; t < nt; t += 2) {
            if constexpr (Epi::MIDSCALE) { if (t == Epi::MID_T) E.midscale(acc, cur, wr, fr, ui); }
            const bool last = (t == nt - 2);
            const char* a1 = cA + (ptrdiff_t)(t + 1) * kstep;
            const char* a2 = last ? nA : cA + (ptrdiff_t)(t + 2) * kstep; const char* b2 = last ? nB : cB + (ptrdiff_t)(t + 2) * kstep;
            const char* a3 = a2 + kstep; const char* b3 = b2 + kstep;
            if (last && has_next) S.a_ready(nxt);
            if constexpr (SP2) {
            PG8_LDB(B0, 0, 0); PG8_LDB(B1, 0, 1); PG8_SCHED; PG8_LDA(At, 0, 0); PG8_STAGE(PG8_SA(1, 1), a1 + hstep, voffA);
            PG8_WAIT_V(8); PG8_WAIT_L(0); PG8_BAR; PG8_MMA(0, 0, At, B0); PG8_MMA(0, 1, At, B1); PG8_BAR; PG8_SCHED;
            PG8_LDA(At, 0, 1); PG8_STAGE(PG8_SB(0, 0), b2, voffB); PG8_STAGE(PG8_SB(0, 1), b2 + hstep, voffB); PG8_STAGE(PG8_SA(0, 0), a2, voffA);
            PG8_WAIT_V(8); PG8_WAIT_L(0); PG8_BAR; PG8_MMA(1, 0, At, B0); PG8_MMA(1, 1, At, B1); PG8_BAR; PG8_SCHED;
            PG8_LDB(B0, 1, 0); PG8_LDB(B1, 1, 1); PG8_SCHED; PG8_LDA(At, 1, 0); PG8_STAGE(PG8_SA(0, 1), a2 + hstep, voffA);
            PG8_WAIT_V(8); PG8_WAIT_L(0); PG8_BAR; PG8_MMA(0, 0, At, B0); PG8_MMA(0, 1, At, B1); PG8_BAR; PG8_SCHED;
            PG8_LDA(At, 1, 1); PG8_STAGE(PG8_SB(1, 0), b3, voffB); PG8_STAGE(PG8_SB(1, 1), b3 + hstep, voffB); PG8_STAGE(PG8_SA(1, 0), a3, voffA);
            PG8_WAIT_V(8); PG8_WAIT_L(0); PG8_BAR; PG8_MMA(1, 0, At, B0); PG8_MMA(1, 1, At, B1); PG8_BAR; PG8_SCHED;
            } else {
            PG8_LDB(B0, 0, 0); PG8_SCHED; PG8_LDA(At, 0, 0); PG8_STAGE(PG8_SA(1, 1), a1 + hstep, voffA);
            PG8_WAIT_L(8); PG8_BAR; PG8_WAIT_L(0); PG8_MMA(0, 0, At, B0); PG8_BAR; PG8_SCHED;
            PG8_LDB(B1, 0, 1); PG8_STAGE(PG8_SB(0, 0), b2, voffB);
            PG8_BAR; PG8_WAIT_L(0); PG8_MMA(0, 1, At, B1); PG8_BAR;
            PG8_LDA(At, 0, 1); PG8_STAGE(PG8_SA(0, 0), a2, voffA);
            PG8_BAR; PG8_WAIT_L(0); PG8_MMA(1, 0, At, B0); PG8_BAR; PG8_SCHED;
            PG8_STAGE(PG8_SB(0, 1), b2 + hstep, voffB);
            PG8_WAIT_V(6); PG8_BAR; PG8_MMA(1, 1, At, B1); PG8_BAR;
            PG8_LDB(B0, 1, 0); PG8_SCHED; PG8_LDA(At, 1, 0); PG8_STAGE(PG8_SA(0, 1), a2 + hstep, voffA);
            PG8_WAIT_L(8); PG8_BAR; PG8_WAIT_L(0); PG8_MMA(0, 0, At, B0); PG8_BAR; PG8_SCHED;
            PG8_LDB(B1, 1, 1); PG8_STAGE(PG8_SB(1, 0), b3, voffB);
            PG8_BAR; PG8_WAIT_L(0); PG8_MMA(0, 1, At, B1); PG8_BAR;
            PG8_LDA(At, 1, 1); PG8_STAGE(PG8_SA(1, 0), a3, voffA);
            PG8_BAR; PG8_WAIT_L(0); PG8_MMA(1, 0, At, B0); PG8_BAR; PG8_SCHED;
            PG8_STAGE(PG8_SB(1, 1), b3 + hstep, voffB);
            PG8_WAIT_V(6); PG8_BAR; PG8_MMA(1, 1, At, B1); PG8_BAR;
            }
        }
        if constexpr (ALIGN_EPI) { if (wr == 0) PG8_BAR; }
        if constexpr (!Epi::AFTER_DRAIN) { E(acc, cur, wr, wc, fr, fq, ui); S.done(cur); }
        if (!has_next) break;
#pragma unroll
        for (int a = 0; a < 2; ++a)
#pragma unroll
            for (int b = 0; b < 2; ++b)
#pragma unroll
                for (int m = 0; m < 4; ++m)
#pragma unroll
                    for (int n = 0; n < 2; ++n) acc[a][b][m][n] = (f32x4){0.f, 0.f, 0.f, 0.f};
        cur = nxt; cA = nA; cB = nB; ++ui;
        if constexpr (Epi::PREP) E.prepare(cur, ui, tid);
        if constexpr (ALIGN_EPI) { if (wr == 1) PG8_BAR; }
    }
    PG8_WAIT_V(0);
    if constexpr (!ALIGN_EPI) { if (wr == 0) PG8_BAR; }
    PG8_BAR;
    if constexpr (Epi::AFTER_DRAIN) { E.fused(acc, cur, wr, wc, fr, fq, lds, wid, lane); S.done(cur); }
#undef PG8_SA
#undef PG8_SB
#undef PG8_STAGE
#undef PG8_LDA
#undef PG8_LDB
#undef PG8_MMA
#undef PG8_WAIT_V
#undef PG8_WAIT_L
#undef PG8_BAR
#undef PG8_SCHED
}
}
constexpr int NWAVES = 8;
constexpr int D = 1024, NB = 4, T = 4096, NL = 4, BS = 32, NS = 16, PAST = 1024, INW = 2560, NMEM = 256, DFF = 2816;
constexpr int MP = NB * T, MS = BS * NS, M = MP + MS;
constexpr float EPS = 1e-6f, LOG2E = 1.4426950408889634f;
constexpr float C_SB = 0.125f * LOG2E, C_MEM = 0.0625f * LOG2E;
constexpr float SB_EXIT = 0x1p-135f;
constexpr size_t MiB = 1u << 20;
constexpr size_t WS_CTL = 0, CTL_ZERO_BYTES = 1 * MiB;
constexpr size_t WS_WL = 2 * MiB, WL_STRIDE = 28 * MiB;
constexpr size_t WL_IN = 0, WL_OUT = 5 * MiB, WL_MQ = 7 * MiB, WL_MO = 9 * MiB, WL_GU = 11 * MiB, WL_DN = 22 * MiB;
constexpr size_t WS_WMKV = 114 * MiB, WS_MEMB = 130 * MiB, WS_MK = 132 * MiB, WS_MV = 140 * MiB, WS_SSQ = 148 * MiB, WS_SBSS = 150 * MiB;
constexpr size_t WS_XF = 152 * MiB, WS_XB = 218 * MiB, WS_U = 251 * MiB, WS_VA = 268 * MiB, WS_Q = 285 * MiB, WS_K = 302 * MiB, WS_V = 319 * MiB;
constexpr size_t WS_CAT = 336 * MiB, WS_QM = 369 * MiB, WS_OM = 402 * MiB, WS_H = 435 * MiB, WS_WT = 526 * MiB, WS_SASS = 527 * MiB, WS_END = 529 * MiB;
constexpr int CW_BAR = 4096, CW_SBQ = 8192;
constexpr int RING_OFF = 0, RING_BYTES = 131072, LDSCTL_OFF = RING_BYTES, MISC_OFF = LDSCTL_OFF + 320, AUX_OFF = LDSCTL_OFF + 1024, OST_OFF = AUX_OFF + 8192, LDS_BYTES = 163840;

#define GAS __attribute__((address_space(1)))
#define LAS __attribute__((address_space(3)))
typedef unsigned short bf16;
typedef unsigned v4u __attribute__((ext_vector_type(4)));
typedef unsigned v2u __attribute__((ext_vector_type(2)));
typedef float f32x4 __attribute__((ext_vector_type(4)));
typedef float f32x16 __attribute__((ext_vector_type(16)));
typedef short bf16x8 __attribute__((ext_vector_type(8)));
typedef short s16x4 __attribute__((ext_vector_type(4)));
typedef GAS unsigned gu32;
#define RLX_AGENT __ATOMIC_RELAXED, __HIP_MEMORY_SCOPE_AGENT
#define LDS_WAIT() asm volatile("s_waitcnt lgkmcnt(0)" ::: "memory")
#define VM_WAIT() asm volatile("s_waitcnt vmcnt(0)" ::: "memory")
__device__ __forceinline__ unsigned cvtpk(float lo, float hi) { unsigned r; asm volatile("v_cvt_pk_bf16_f32 %0, %1, %2" : "=v"(r) : "v"(lo), "v"(hi)); return r; }
__device__ __forceinline__ float bf_lo(unsigned w) { return __uint_as_float(w << 16); }
__device__ __forceinline__ float bf_hi(unsigned w) { return __uint_as_float(w & 0xffff0000u); }
__device__ __forceinline__ int lane_id() { int l_; asm volatile("v_mbcnt_lo_u32_b32 %0, -1, 0\n\tv_mbcnt_hi_u32_b32 %0, -1, %0" : "=v"(l_)); return l_; }
__device__ __forceinline__ int crow(int r, int hi) { return (r & 3) + 8 * (r >> 2) + 4 * hi; }
__device__ __forceinline__ s16x4 tr_read(unsigned addr) { return __builtin_bit_cast(s16x4, __builtin_amdgcn_ds_read_tr16_b64_v4i16((LAS s16x4*)(uintptr_t)addr)); }
using pg8::xl_sum16; using pg8::xl_sum_x16; using pg8::xl_sum_x32; using pg8::xl_max_x32; using pg8::xl_other_x32;
#define MFMA32(a, b, c) __builtin_amdgcn_mfma_f32_32x32x16_bf16((a), (b), (c), 0, 0, 0)

#ifndef REP_A
#define REP_A 1
#endif
#ifndef REP_B
#define REP_B 1
#endif
#ifndef REP_E
#define REP_E 1
#endif
#ifndef REP_F
#define REP_F 1
#endif
#ifndef REP_H
#define REP_H 1
#endif
#ifndef REP_P
#define REP_P 1
#endif
#ifndef REP_SGU
#define REP_SGU 1
#endif
#ifndef REP_SB
#define REP_SB 1
#endif
#define XB_TMO      128
#define XB_XCNT(j)  (256  + 64 * (j))
#define XB_XSUB(j)  (1280 + 64 * (j))
#define XB_XGEN(j)  (2304 + 64 * (j))
#define XB_TOP      3328
#define XB_TOPGEN   3392
#define XCD_BAR_WORDS 3456
#define XB_SPIN_CAP (1u << 18)

__device__ __forceinline__ unsigned xb_ld(unsigned* p)              { return __hip_atomic_load(p, __ATOMIC_RELAXED, __HIP_MEMORY_SCOPE_AGENT); }
__device__ __forceinline__ unsigned xb_add(unsigned* p, unsigned v) { return __hip_atomic_fetch_add(p, v, __ATOMIC_RELAXED, __HIP_MEMORY_SCOPE_AGENT); }
__device__ __forceinline__ unsigned xb_xcc_id() { return (unsigned)__builtin_amdgcn_s_getreg((3 << 11) | 20) & 0xFu; }
#define XB_SPIN(cond, bar) do { unsigned _sp = 0; while (cond) { __builtin_amdgcn_s_sleep(1); \
    if ((++_sp & 255u) == 0u) { if (xb_ld(&(bar)[XB_TMO])) break; if (_sp > XB_SPIN_CAP) { atomicAdd(&(bar)[XB_TMO], 1u); break; } } } } while (0)

struct XcdBarrier {
    unsigned* bar; unsigned x;
    volatile LAS unsigned* st;
};

__device__ __forceinline__ XcdBarrier xcd_barrier_post(unsigned* bar, volatile LAS unsigned* st, int tid) {
    XcdBarrier b; b.bar = bar; b.x = xb_xcc_id(); b.st = st;
    if (tid == 0) (void)xb_add(&bar[XB_XCNT(b.x)], 1u);
    return b;
}
__device__ __forceinline__ void xcd_barrier_complete(unsigned* bar, unsigned x, unsigned& nloc, unsigned& nx) {
    const unsigned G = gridDim.x * gridDim.y * gridDim.z;
    unsigned sum, cnt, mine, sp = 0u;
    for (;;) {
        sum = 0u; cnt = 0u; mine = 0u;
#pragma unroll
        for (unsigned j = 0; j < 16; ++j) { const unsigned c = xb_ld(&bar[XB_XCNT(j)]); sum += c; cnt += (c > 0u) ? 1u : 0u; mine = (j == x) ? c : mine; }
        if (sum == G) break;
        __builtin_amdgcn_s_sleep(1);
        if ((++sp & 255u) == 0u) { if (xb_ld(&bar[XB_TMO])) break; if (sp > XB_SPIN_CAP) { atomicAdd(&bar[XB_TMO], 1u); break; } }
    }
    nloc = mine > 0u ? mine : 1u; nx = cnt > 0u ? cnt : 1u;
}

__device__ __forceinline__ void xcd_barrier(const XcdBarrier& b, int tid) {
    asm volatile("s_waitcnt vmcnt(0)" ::: "memory");
    __syncthreads();
    if (tid == 0) {
        size_t bz_ = 0; unsigned bx = b.x; asm volatile("" : "+s"(bz_), "+s"(bx)); unsigned* bar = b.bar + bz_;
        __builtin_amdgcn_s_waitcnt(0);
        unsigned nloc = b.st[0], nx = b.st[1];
        if (nloc == 0u) { xcd_barrier_complete(bar, bx, nloc, nx); b.st[0] = nloc; b.st[1] = nx; }
        const unsigned old = xb_add(&bar[XB_XSUB(bx)], 1u);
        const unsigned gen = old / nloc;
        if (old + 1u == (gen + 1u) * nloc) {
            __builtin_amdgcn_fence(__ATOMIC_RELEASE, "agent");
            asm volatile("s_waitcnt vmcnt(0)" ::: "memory");
            const unsigned og = xb_add(&bar[XB_TOP], 1u);
            const unsigned tg = og / nx;
            if (og + 1u == (tg + 1u) * nx) xb_add(&bar[XB_TOPGEN], 1u);
            else XB_SPIN(xb_ld(&bar[XB_TOPGEN]) == tg, bar);
            __builtin_amdgcn_fence(__ATOMIC_ACQUIRE, "agent");
            xb_add(&bar[XB_XGEN(bx)], 1u);
            asm volatile("s_waitcnt vmcnt(0)" ::: "memory");
        } else {
            XB_SPIN(xb_ld(&bar[XB_XGEN(bx)]) == gen, bar);
            __builtin_amdgcn_fence(__ATOMIC_ACQUIRE, "agent");
            asm volatile("s_waitcnt vmcnt(0)" ::: "memory");
        }
    }
    __syncthreads();
}


struct Frame {
    LAS unsigned char* lds; unsigned lds0;
    int wave, G, bid;
};
struct Args {
    const float* in[25]; float* out; unsigned char* ws; int ph_lo, ph_hi;
};
__device__ __forceinline__ float* out_y_p(float* o) { return o; }
__device__ __forceinline__ float* out_y_s(float* o) { return o + (size_t)MP * D; }
__device__ __forceinline__ float* out_sbk_p(float* o) { return o + (size_t)M * D; }
__device__ __forceinline__ float* out_sbv_p(float* o) { return out_sbk_p(o) + (size_t)NL * MP * 512; }
__device__ __forceinline__ float* out_mk_p(float* o) { return out_sbv_p(o) + (size_t)NL * MP * 512; }
__device__ __forceinline__ float* out_mv_p(float* o) { return out_mk_p(o) + (size_t)NL * NB * NMEM * D; }
__device__ __forceinline__ float* out_sbk_s(float* o) { return out_mv_p(o) + (size_t)NL * NB * NMEM * D; }
__device__ __forceinline__ float* out_sbv_s(float* o) { return out_sbk_s(o) + (size_t)NL * MS * 512; }
__device__ __forceinline__ float* out_sguv_s(float* o) { return out_sbv_s(o) + (size_t)NL * MS * 512; }

struct TrItem { const float* src; const float* gain; bf16* dst; int ldw, ldd; };
__device__ __forceinline__ TrItem tr_decode(const Args& a, unsigned char* ws, int it) {
    constexpr int I_IN = 640, I_SQ = 256, I_G = 704, I_L = I_IN + 3 * I_SQ + 3 * I_G + 2 * I_SQ;
    const int l = it / I_L; int r = it % I_L; unsigned char* wl = ws + WS_WL + (size_t)l * WL_STRIDE; TrItem t;
    if (r < I_IN) { const int kb = r / 40, nb = r % 40; t.src = a.in[8] + (size_t)l * D * INW + (size_t)(kb * 64) * INW + nb * 64; t.ldw = INW; t.gain = a.in[7] + l * D + kb * 64; t.dst = (bf16*)(wl + WL_IN) + (size_t)(nb * 64) * D + kb * 64; t.ldd = D; return t; } r -= I_IN;
    if (r < I_SQ) { const int kb = r / 16, nb = r % 16; const int ks = (kb * 64 + 512) & 1023;
        t.src = a.in[14] + (size_t)l * D * D + (size_t)ks * D + nb * 64; t.ldw = D; t.gain = ks < 512 ? a.in[12] + l * 512 + ks : a.in[13] + l * 512 + (ks - 512); t.dst = (bf16*)(wl + WL_OUT) + (size_t)(nb * 64) * D + kb * 64; t.ldd = D; return t; } r -= I_SQ;
    if (r < I_SQ) { const int kb = r / 16, nb = r % 16; t.src = a.in[16] + (size_t)l * D * D + (size_t)(kb * 64) * D + nb * 64; t.ldw = D; t.gain = a.in[15] + l * D + kb * 64; t.dst = (bf16*)(wl + WL_MQ) + (size_t)(nb * 64) * D + kb * 64; t.ldd = D; return t; } r -= I_SQ;
    if (r < I_SQ) { const int kb = r / 16, nb = r % 16; t.src = a.in[19] + (size_t)l * D * D + (size_t)(kb * 64) * D + nb * 64; t.ldw = D; t.gain = nullptr; t.dst = (bf16*)(wl + WL_MO) + (size_t)(nb * 64) * D + kb * 64; t.ldd = D; return t; } r -= I_SQ;
    if (r < 2 * I_G) { const int up = r >= I_G; if (up) r -= I_G; const int kb = r / 44, nb = r % 44; const int j0 = nb * 64;
        t.src = a.in[up ? 22 : 21] + (size_t)l * D * DFF + (size_t)(kb * 64) * DFF + j0; t.ldw = DFF; t.gain = a.in[20] + l * D + kb * 64; t.dst = (bf16*)(wl + WL_GU) + (size_t)(256 * (j0 >> 7) + (up ? 128 : 0) + (j0 & 127)) * D + kb * 64; t.ldd = D; return t; } r -= 2 * I_G;
    if (r < I_G) { const int kb = r / 16, nb = r % 16; t.src = a.in[23] + (size_t)l * DFF * D + (size_t)(kb * 64) * D + nb * 64; t.ldw = D; t.gain = nullptr; t.dst = (bf16*)(wl + WL_DN) + (size_t)(nb * 64) * DFF + kb * 64; t.ldd = DFF; return t; } r -= I_G;
    { const int isv = r >= I_SQ; if (isv) r -= I_SQ; const int kb = r / 16, nb = r % 16;
      t.src = a.in[isv ? 18 : 17] + (size_t)l * D * D + (size_t)(kb * 64) * D + nb * 64; t.ldw = D; t.gain = nullptr; t.dst = (bf16*)(ws + WS_WMKV) + (size_t)((l * 2 + isv) * 1024 + nb * 64) * D + kb * 64; t.ldd = D; return t; }
}
__device__ __forceinline__ void tr_load(const TrItem& t, f32x4 (&v)[16], f32x4 (&g)[2], int lane) {
    const int kr0 = lane >> 4, nc = (lane & 15) * 4;
#pragma unroll
    for (int i = 0; i < 16; ++i) v[i] = *(const GAS f32x4*)((const GAS float*)t.src + (unsigned)((kr0 + 4 * i) * t.ldw + nc));
    const f32x4 one = (f32x4){1.f, 1.f, 1.f, 1.f};
    g[0] = t.gain ? *(const f32x4*)(t.gain + 8 * (lane & 7)) : one; g[1] = t.gain ? *(const f32x4*)(t.gain + 8 * (lane & 7) + 4) : one;
}
__device__ __forceinline__ void tr_store(const TrItem& t, const f32x4 (&v)[16], const f32x4 (&g)[2], LAS float* scr, int lane) {
    const int kr0 = lane >> 4, nc = (lane & 15) * 4;
#pragma unroll
    for (int i = 0; i < 16; ++i) { const int kr = kr0 + 4 * i; LAS float* p = scr + kr * 64; const f32x4 x = v[i];
        p[(nc + 0) ^ (kr & 31)] = x[0]; p[(nc + 1) ^ (kr & 31)] = x[1]; p[(nc + 2) ^ (kr & 31)] = x[2]; p[(nc + 3) ^ (kr & 31)] = x[3]; }
    LDS_WAIT(); asm volatile("" ::: "memory");
    const int c = lane & 7;
#pragma unroll
    for (int j = 0; j < 8; ++j) { const int n = (lane >> 3) + 8 * j; float s[8];
#pragma unroll
        for (int i = 0; i < 8; ++i) s[i] = scr[(8 * c + i) * 64 + (n ^ ((8 * c + i) & 31))] * g[i >> 2][i & 3];
        v4u o; o.x = cvtpk(s[0], s[1]); o.y = cvtpk(s[2], s[3]); o.z = cvtpk(s[4], s[5]); o.w = cvtpk(s[6], s[7]);
        *(GAS v4u*)((GAS bf16*)t.dst + (unsigned)(n * t.ldd + 8 * c)) = o; }
    LDS_WAIT(); asm volatile("" ::: "memory");
}
template <bool PRO> __device__ __forceinline__ int cv_item(int l, int j) { return PRO ? (j < 4032 ? j : 4032 * (1 + (j - 4032) / 512) + 3520 + (j - 4032) % 512) : l * 4032 + j; }
template <bool PRO> __device__ __forceinline__ void convert_items(const Args& a, const Frame& F, int l, int gw, int ngw, int lo, int hi) {
    LAS float* scr = (LAS float*)(F.lds + RING_OFF + F.wave * 16384); unsigned char* ws = a.ws; const int lane = lane_id();
#pragma unroll 1
    for (int j = lo + gw; j < hi; j += ngw) { const TrItem cur = tr_decode(a, ws, cv_item<PRO>(l, j)); f32x4 v[16], g[2]; tr_load(cur, v, g, lane); tr_store(cur, v, g, scr, lane); }
}
__device__ __forceinline__ void prologue(const Args& a, const Frame& F) {
    LAS float* scr = (LAS float*)(F.lds + RING_OFF + F.wave * 16384);
    const int gw = F.bid * NWAVES + F.wave, NGW = F.G * NWAVES;
    unsigned char* ws = a.ws;
    convert_items<true>(a, F, 0, gw, NGW, 0, 4032 + (NL - 1) * 512);
    bf16* XB = (bf16*)(ws + WS_XB); float* SSQ = (float*)(ws + WS_SSQ);
    for (int m0 = gw; m0 < M; m0 += 5 * NGW) {
        f32x4 v[5][4];
#pragma unroll
        for (int k = 0; k < 5; ++k) { int m = m0 + k * NGW; m = m < M ? m : M - 1;
            const float* src = m < MP ? a.in[0] + (size_t)m * D : a.in[1] + (size_t)(m - MP) * D;
#pragma unroll
            for (int j = 0; j < 4; ++j) v[k][j] = ((const f32x4*)src)[lane_id() + 64 * j]; }
#pragma unroll
        for (int k = 0; k < 5; ++k) asm volatile("" : "+v"(v[k][0]), "+v"(v[k][1]), "+v"(v[k][2]), "+v"(v[k][3]));
#pragma unroll
        for (int k = 0; k < 5; ++k) { const int m = m0 + k * NGW;
            if (m < M) { float s = 0.f;
#pragma unroll
                for (int j = 0; j < 4; ++j) s += (v[k][j][0] * v[k][j][0] + v[k][j][1] * v[k][j][1]) + (v[k][j][2] * v[k][j][2] + v[k][j][3] * v[k][j][3]);
                s = xl_sum_x32(xl_sum_x16(xl_sum16(s)));
#pragma unroll
                for (int j = 0; j < 4; ++j) { v2u w; w.x = cvtpk(v[k][j][0], v[k][j][1]); w.y = cvtpk(v[k][j][2], v[k][j][3]); ((v2u*)(XB + (size_t)m * D))[lane_id() + 64 * j] = w; }
                if (lane_id() < 16) SSQ[(size_t)m * 16 + lane_id()] = lane_id() == 0 ? s : 0.f; } }
    }
    { bf16* WT = (bf16*)(ws + WS_WT); const int gt = F.bid * 512 + (F.wave * 64 + lane_id()), NT = F.G * 512;
      for (int i = gt; i < NL * 2 * 4 * 128 * 128; i += NT) { const int s = i & 127, t = (i >> 7) & 127, g = (i >> 14) & 3, var = (i >> 16) & 1, l = i >> 17;
          const float* W = a.in[10] + (size_t)(l * 4 + g) * 128 * 128; float v;
          if (var == 0) v = s <= t ? W[t * 128 + s] : 0.f; else v = ((t >> 4) == (s >> 4) && (s & 15) <= (t & 15)) ? W[(t & 15) * 128 + (s & 15)] : 0.f;
          WT[i] = (bf16)(cvtpk(v, 0.f) & 0xffffu); } }
    { const f32x4* src = (const f32x4*)a.in[6]; v2u* dst = (v2u*)(ws + WS_MEMB); const int gt = F.bid * 512 + (F.wave * 64 + lane_id()), NT = F.G * 512;
      for (int i = gt; i < NB * NMEM * D / 4; i += NT) { const f32x4 v = src[i]; v2u w; w.x = cvtpk(v[0], v[1]); w.y = cvtpk(v[2], v[3]); dst[i] = w; } }
}

__device__ __forceinline__ void sgu_unit(const Args& a, const Frame& F, int l, int unit) {
    unsigned char* ws = a.ws;
    const bf16* VA = (const bf16*)(ws + WS_VA); const bf16* U = (const bf16*)(ws + WS_U); bf16* CAT = (bf16*)(ws + WS_CAT); float* SASS = (float*)(ws + WS_SASS);
    const int c = unit >> 1, gp = unit & 1; const bool smp = c >= 128; const int R0 = smp ? MP + 128 * (c - 128) : 128 * c;
    const float* gv = a.in[9] + l * 512; const float* bl = a.in[11] + l * 512;
    float* sguv = out_sguv_s(a.out) + (size_t)l * MS * 512;
    int tid_ = F.wave * 64 + lane_id(); asm volatile("" : "+v"(tid_));
    const int tid = tid_, lane = tid & 63, w = F.wave;
    const int gl = w >> 2, nb = w & 3, g = 2 * gp + gl, r32 = lane & 31, hi = lane >> 5;
    const int g4 = lane >> 4, cb = g4 & 1, q4 = (lane & 15) >> 2, p4 = lane & 3;
    const bf16* WT = (const bf16*)(ws + WS_WT) + ((size_t)((l * 2 + (smp ? 1 : 0)) * 4 + g) * 128 + r32) * 128 + hi * 8;
    bf16x8 wfr[20]; v2u uu[4][4]; float bias[4];
    { int n = 0;
#pragma unroll
      for (int ks = 0; ks < 8; ++ks)
#pragma unroll
          for (int i = 0; i < 4; ++i) { if (ks > 2 * i + 1) continue; wfr[n++] = __builtin_bit_cast(bf16x8, *(const GAS v4u*)(WT + (size_t)(32 * i) * 128 + ks * 16)); } }
#pragma unroll
    for (int i = 0; i < 4; ++i) { const int t = 32 * i + r32; bias[i] = bl[g * 128 + (smp ? (t & 15) : t)];
#pragma unroll
        for (int k = 0; k < 4; ++k) uu[i][k] = *(const GAS v2u*)(U + (size_t)(R0 + t) * 512 + g * 128 + nb * 32 + 8 * k + 4 * hi); }
    v4u raws[8];
#pragma unroll
    for (int i = 0; i < 8; ++i) { const int cc = tid + 512 * i, row = cc >> 5, ch = cc & 31; raws[i] = *(const GAS v4u*)(VA + (size_t)(R0 + row) * 512 + (2 * gp + (ch >> 4)) * 128 + (ch & 15) * 8); }
    asm volatile("" : "+v"(raws[0]), "+v"(raws[1]), "+v"(raws[2]), "+v"(raws[3]), "+v"(raws[4]), "+v"(raws[5]), "+v"(raws[6]), "+v"(raws[7]));
    asm volatile("" : "+v"(wfr[0]), "+v"(wfr[1]), "+v"(wfr[2]), "+v"(wfr[3]), "+v"(wfr[4]));
    asm volatile("" : "+v"(wfr[5]), "+v"(wfr[6]), "+v"(wfr[7]), "+v"(wfr[8]), "+v"(wfr[9]));
    asm volatile("" : "+v"(wfr[10]), "+v"(wfr[11]), "+v"(wfr[12]), "+v"(wfr[13]), "+v"(wfr[14]));
    asm volatile("" : "+v"(wfr[15]), "+v"(wfr[16]), "+v"(wfr[17]), "+v"(wfr[18]), "+v"(wfr[19]));
    asm volatile("" : "+v"(uu[0][0]), "+v"(uu[0][1]), "+v"(uu[0][2]), "+v"(uu[0][3]), "+v"(bias[0]));
    asm volatile("" : "+v"(uu[1][0]), "+v"(uu[1][1]), "+v"(uu[1][2]), "+v"(uu[1][3]), "+v"(bias[1]));
    asm volatile("" : "+v"(uu[2][0]), "+v"(uu[2][1]), "+v"(uu[2][2]), "+v"(uu[2][3]), "+v"(bias[2]));
    asm volatile("" : "+v"(uu[3][0]), "+v"(uu[3][1]), "+v"(uu[3][2]), "+v"(uu[3][3]), "+v"(bias[3]));
#pragma unroll
    for (int i = 0; i < 8; ++i) { const int cc = tid + 512 * i, row = cc >> 5, ch = cc & 31, gl = ch >> 4, c16 = ch & 15, col = (2 * gp + gl) * 128 + c16 * 8;
        const v4u raw = raws[i];
        float x[8] = {bf_lo(raw.x), bf_hi(raw.x), bf_lo(raw.y), bf_hi(raw.y), bf_lo(raw.z), bf_hi(raw.z), bf_lo(raw.w), bf_hi(raw.w)};
        float ss = 0.f;
#pragma unroll
        for (int j = 0; j < 8; ++j) ss += x[j] * x[j];
        ss = xl_sum16(ss);
        const float rstd = __builtin_amdgcn_rsqf(ss * (1.0f / 128.0f) + EPS);
        const f32x4 g0 = *(const f32x4*)(gv + col), g1 = *(const f32x4*)(gv + col + 4);
        f32x4 y0, y1;
#pragma unroll
        for (int j = 0; j < 4; ++j) { y0[j] = x[j] * rstd * g0[j]; y1[j] = x[4 + j] * rstd * g1[j]; }
        if (smp) { float* o = sguv + (size_t)(R0 - MP + row) * 512 + col; *(f32x4*)o = y0; *(f32x4*)(o + 4) = y1; }
        v4u pk; pk.x = cvtpk(y0[0], y0[1]); pk.y = cvtpk(y0[2], y0[3]); pk.z = cvtpk(y1[0], y1[1]); pk.w = cvtpk(y1[2], y1[3]);
        *(LAS v4u*)(F.lds + gl * 32768 + row * 256 + ((((c16 >> 2) ^ (row & 3)) << 2) | (c16 & 3)) * 16) = pk; }
    __syncthreads();
#ifdef TPROBE
    if (F.wave == 0 && lane == 0) { volatile LAS unsigned* tc = (volatile LAS unsigned*)(F.lds + MISC_OFF + 64); const unsigned now_ = (unsigned)__builtin_amdgcn_s_memrealtime(); tc[27] += now_ - tc[32]; tc[32] = now_; }
#endif
    const int colb = (nb * 32 + 16 * cb + 4 * p4) * 2;
    const unsigned tb = F.lds0 + gl * 32768 + (8 * hi + q4) * 256 + ((((colb >> 6) ^ q4) << 6) | (colb & 63));
    f32x16 acc[4];
#pragma unroll
    for (int i = 0; i < 4; ++i)
#pragma unroll
        for (int r = 0; r < 16; ++r) acc[i][r] = 0.f;
    { int n = 0;
#pragma unroll
      for (int ks = 0; ks < 8; ++ks) {
        const s16x4 a0 = tr_read(tb + ks * 16 * 256), a1 = tr_read(tb + ks * 16 * 256 + 4 * 256);
        const bf16x8 af = (bf16x8){a0[0], a0[1], a0[2], a0[3], a1[0], a1[1], a1[2], a1[3]};
#pragma unroll
        for (int i = 0; i < 4; ++i) { if (ks > 2 * i + 1) continue; acc[i] = MFMA32(af, wfr[n++], acc[i]); }
      } }
#ifdef TPROBE
    if (F.wave == 0 && lane == 0) { volatile LAS unsigned* tc = (volatile LAS unsigned*)(F.lds + MISC_OFF + 64); const unsigned now_ = (unsigned)__builtin_amdgcn_s_memrealtime(); tc[28] += now_ - tc[32]; tc[32] = now_; }
#endif
#pragma unroll
    for (int i = 0; i < 4; ++i) { const int t = 32 * i + r32; const float bs_ = bias[i];
        const size_t rowoff = (size_t)(R0 + t); float ss = 0.f;
#pragma unroll
        for (int k = 0; k < 4; ++k) { const int e = g * 128 + nb * 32 + 8 * k + 4 * hi; const v2u u2 = uu[i][k];
            const float v0 = bf_lo(u2.x) * (acc[i][4 * k] + bs_), v1 = bf_hi(u2.x) * (acc[i][4 * k + 1] + bs_), v2 = bf_lo(u2.y) * (acc[i][4 * k + 2] + bs_), v3 = bf_hi(u2.y) * (acc[i][4 * k + 3] + bs_);
            ss += (v0 * v0 + v1 * v1) + (v2 * v2 + v3 * v3);
            v2u o; o.x = cvtpk(v0, v1); o.y = cvtpk(v2, v3); *(GAS v2u*)(CAT + rowoff * 1024 + 512 + e) = o; }
        ss = xl_sum_x32(ss);
        SASS[rowoff * 16 + g * 4 + nb] = ss; }
    __syncthreads();
}

template <bool SMP> __device__ __forceinline__ void sb_unit(const Args& a, const Frame& F, int l, int uidx) {
    unsigned char* ws = a.ws;
    const bf16* Qb = (const bf16*)(ws + WS_Q); const bf16* Kb = (const bf16*)(ws + WS_K); const bf16* Vb = (const bf16*)(ws + WS_V);
    bf16* CAT = (bf16*)(ws + WS_CAT); float* SBSS = (float*)(ws + WS_SBSS);
    int lane_ = lane_id(); asm volatile("" : "+v"(lane_));
    const int lane = lane_, r32 = lane & 31, hi = lane >> 5;
    int h, rowq0, nq, krow0 = 0, bs = 0, t0 = 0, jt;
    if (!SMP) { const int tb = uidx & 127, bh = uidx >> 7; h = bh & 7; const int b = bh >> 3; t0 = 32 * tb; rowq0 = b * T + t0; krow0 = b * T; nq = 32; jt = t0 >> 6; }
    else { h = uidx & 7; bs = uidx >> 3; rowq0 = MP + bs * NS; nq = NS; jt = PAST / 64; }
    const int tq = SMP ? PAST + (r32 < NS ? r32 : NS - 1) : t0 + r32;
    const float* ck = a.in[2] + ((size_t)(l * BS + bs) * PAST) * 512 + h * 64; const float* cv = a.in[3] + ((size_t)(l * BS + bs) * PAST) * 512 + h * 64;
    bf16x8 qf[4];
#pragma unroll
    for (int d0 = 0; d0 < 4; ++d0) qf[d0] = __builtin_bit_cast(bf16x8, *(const GAS v4u*)(Qb + (size_t)(rowq0 + (r32 < nq ? r32 : nq - 1)) * 512 + h * 64 + d0 * 16 + hi * 8));
    f32x16 o[2];
#pragma unroll
    for (int r = 0; r < 16; ++r) { o[0][r] = 0.f; o[1][r] = 0.f; }
    float R = 1.0f;
    LAS unsigned char* vt = F.lds + F.wave * 16384;
    LAS unsigned char* kt = vt + 8192;
    const unsigned vt0 = F.lds0 + F.wave * 16384;
    const int g4 = lane >> 4, cb = g4 & 1, q4 = (lane & 15) >> 2, p4 = lane & 3;
    v4u kn[8], vn[8];
    if (!SMP) {
#pragma unroll
        for (int i = 0; i < 8; ++i) { const GAS unsigned char* kb_ = (const GAS unsigned char*)(Kb + (size_t)(krow0 + 64 * jt) * 512 + h * 64); const GAS unsigned char* vb_ = (const GAS unsigned char*)(Vb + (size_t)(krow0 + 64 * jt) * 512 + h * 64);
            const unsigned lo_ = (unsigned)((lane >> 3) * 1024 + (lane & 7) * 16 + i * 8192);
            kn[i] = *(const GAS v4u*)(kb_ + lo_); vn[i] = *(const GAS v4u*)(vb_ + lo_); }
    }
    for (; jt >= 0; --jt) {
        bf16x8 kf[2][4];
        if (!SMP) {
            {
                const int r0_ = lane >> 3, ch_ = lane & 7;
                LAS unsigned char* kw_ = kt + r0_ * 128 + ((ch_ ^ (r0_ & 7)) << 4); LAS unsigned char* vw_ = vt + r0_ * 128 + (((((ch_ >> 2) ^ ((r0_ >> 1) & 1)) << 2) | (ch_ & 3)) << 4);
#pragma unroll
                for (int i = 0; i < 8; ++i) { *(LAS v4u*)(kw_ + i * 1024) = kn[i]; *(LAS v4u*)(vw_ + i * 1024) = vn[i]; } }
#pragma unroll
            for (int mb = 0; mb < 2; ++mb)
#pragma unroll
                for (int d0 = 0; d0 < 4; ++d0) kf[mb][d0] = *(const LAS bf16x8*)(kt + (32 * mb + r32) * 128 + (((2 * d0 + hi) ^ (r32 & 7)) << 4));
        } else if (jt == PAST / 64) {
#pragma unroll
            for (int mb = 0; mb < 2; ++mb) { const int kv = 32 * mb + r32;
                const bf16* kp = Kb + (size_t)(MP + bs * NS + (kv < NS ? kv : NS - 1)) * 512 + h * 64 + hi * 8;
#pragma unroll
                for (int d0 = 0; d0 < 4; ++d0) kf[mb][d0] = __builtin_bit_cast(bf16x8, *(const GAS v4u*)(kp + d0 * 16)); }
#pragma unroll
            for (int i = 0; i < 8; ++i) { const int c = lane + 64 * i, row = c >> 3, ch = c & 7;
                const v4u v = *(const GAS v4u*)(Vb + (size_t)(MP + bs * NS + (row < NS ? row : NS - 1)) * 512 + h * 64 + ch * 8);
                *(LAS v4u*)(vt + row * 128 + (((((ch >> 2) ^ ((row >> 1) & 1)) << 2) | (ch & 3)) << 4)) = v; }
        } else {
#pragma unroll
            for (int mb = 0; mb < 2; ++mb) { const float* kp = ck + (size_t)(64 * jt + 32 * mb + r32) * 512 + hi * 8;
#pragma unroll
                for (int d0 = 0; d0 < 4; ++d0) { const f32x4 x0 = *(const f32x4*)(kp + d0 * 16), x1 = *(const f32x4*)(kp + d0 * 16 + 4);
                    v4u v; v.x = cvtpk(x0[0], x0[1]); v.y = cvtpk(x0[2], x0[3]); v.z = cvtpk(x1[0], x1[1]); v.w = cvtpk(x1[2], x1[3]); kf[mb][d0] = __builtin_bit_cast(bf16x8, v); } }
#pragma unroll
            for (int i = 0; i < 8; ++i) { const int c = lane + 64 * i, row = c >> 3, ch = c & 7; const float* vp = cv + (size_t)(64 * jt + row) * 512 + ch * 8;
                const f32x4 x0 = *(const f32x4*)vp, x1 = *(const f32x4*)(vp + 4);
                v4u v; v.x = cvtpk(x0[0], x0[1]); v.y = cvtpk(x0[2], x0[3]); v.z = cvtpk(x1[0], x1[1]); v.w = cvtpk(x1[2], x1[3]);
                *(LAS v4u*)(vt + row * 128 + (((((ch >> 2) ^ ((row >> 1) & 1)) << 2) | (ch & 3)) << 4)) = v; }
        }
        f32x16 p0, p1;
#pragma unroll
        for (int r = 0; r < 16; ++r) { p0[r] = 0.f; p1[r] = 0.f; }
#pragma unroll
        for (int d0 = 0; d0 < 4; ++d0) { p0 = MFMA32(kf[0][d0], qf[d0], p0); p1 = MFMA32(kf[1][d0], qf[d0], p1); }
        const bool diag = SMP ? (jt == PAST / 64) : (64 * jt + 63 >= t0);
        if (diag) {
#pragma unroll
            for (int r = 0; r < 16; ++r) { const int kp = 64 * jt + crow(r, hi); if (kp >= tq) p0[r] = -1e30f; if (kp + 32 >= tq) p1[r] = -1e30f; } }
        float cw[32];
#pragma unroll
        for (int r = 0; r < 16; ++r) { p0[r] = __builtin_amdgcn_exp2f(fminf(p0[r], 126.0f)); p1[r] = __builtin_amdgcn_exp2f(fminf(p1[r], 126.0f));
            cw[r] = __builtin_amdgcn_rcpf(1.0f + p0[r]); cw[16 + r] = __builtin_amdgcn_rcpf(1.0f + p1[r]); }
        float gs[8], oth[8];
#pragma unroll
        for (int gq = 0; gq < 8; ++gq) { cw[4 * gq + 2] *= cw[4 * gq + 3]; cw[4 * gq + 1] *= cw[4 * gq + 2]; cw[4 * gq] *= cw[4 * gq + 1]; gs[gq] = cw[4 * gq]; }
#pragma unroll
        for (int gq = 0; gq < 8; ++gq) oth[gq] = xl_other_x32(gs[gq], hi);
        float off[8]; float tail = R;
#pragma unroll
        for (int gq = 7; gq >= 0; --gq) { off[gq] = hi == 0 ? tail * oth[gq] : tail; tail *= gs[gq] * oth[gq]; }
        R = tail;
#pragma unroll
        for (int r = 0; r < 16; ++r) { p0[r] = p0[r] * cw[r] * off[r >> 2]; p1[r] = p1[r] * cw[16 + r] * off[4 + (r >> 2)]; }
        const bool last = __all(((r32 < nq) ? R : 0.f) < SB_EXIT) || jt == 0;
        if (!SMP && !last) { const int jn = jt - 1;
#pragma unroll
            for (int i = 0; i < 8; ++i) { const GAS unsigned char* kb_ = (const GAS unsigned char*)(Kb + (size_t)(krow0 + 64 * jn) * 512 + h * 64); const GAS unsigned char* vb_ = (const GAS unsigned char*)(Vb + (size_t)(krow0 + 64 * jn) * 512 + h * 64);
                const unsigned lo_ = (unsigned)((lane >> 3) * 1024 + (lane & 7) * 16 + i * 8192);
                kn[i] = *(const GAS v4u*)(kb_ + lo_); vn[i] = *(const GAS v4u*)(vb_ + lo_); } }
        unsigned pk[16];
#pragma unroll
        for (int i = 0; i < 8; ++i) { pk[i] = cvtpk(p0[2 * i], p0[2 * i + 1]); pk[8 + i] = cvtpk(p1[2 * i], p1[2 * i + 1]); }
#pragma unroll
        for (int ks = 0; ks < 4; ++ks) { const bf16x8 pf = __builtin_bit_cast(bf16x8, (v4u){pk[4 * ks], pk[4 * ks + 1], pk[4 * ks + 2], pk[4 * ks + 3]});
#pragma unroll
            for (int nb = 0; nb < 2; ++nb) { const unsigned ad0 = vt0 + (16 * ks + 4 * hi + q4) * 128 + ((nb ^ ((q4 >> 1) & 1)) << 6) + (16 * cb + 4 * p4) * 2, ad1 = ad0 + 8 * 128;
                const s16x4 b0 = tr_read(ad0), b1 = tr_read(ad1);
                const bf16x8 vf = (bf16x8){b0[0], b0[1], b0[2], b0[3], b1[0], b1[1], b1[2], b1[3]};
                o[nb] = MFMA32(pf, vf, o[nb]); } }
#ifdef TPROBE
        if (F.wave == 0 && lane == 0) { volatile LAS unsigned* tc = (volatile LAS unsigned*)(F.lds + MISC_OFF + 64); tc[SMP ? 14 : 12] += 100u; }
#endif
        if (last) break;
    }
    float ssq[16];
#pragma unroll
    for (int r = 0; r < 16; ++r) { ssq[r] = o[0][r] * o[0][r] + o[1][r] * o[1][r];
        ssq[r] = xl_sum_x16(xl_sum16(ssq[r])); }
#pragma unroll
    for (int r = 0; r < 16; ++r) { if (SMP && r >= 8) continue;
        const int q = crow(r, hi);
        *(LAS bf16*)(vt + q * 128 + r32 * 2) = (bf16)(cvtpk(o[0][r], 0.f) & 0xffffu); *(LAS bf16*)(vt + q * 128 + 64 + r32 * 2) = (bf16)(cvtpk(o[1][r], 0.f) & 0xffffu);
        SBSS[(size_t)(rowq0 + q) * 8 + h] = ssq[r]; }
#pragma unroll
    for (int i = 0; i < 4; ++i) { if (SMP && i >= 2) continue; const int ch = lane + 64 * i, row = ch >> 3, cp = ch & 7;
        const v4u v = *(const LAS v4u*)(vt + row * 128 + cp * 16); *(GAS v4u*)(CAT + (size_t)(rowq0 + row) * 1024 + h * 64 + cp * 8) = v; }
}

template <bool SMP> __device__ __forceinline__ void mem_unit(const Args& a, const Frame& F, int l, int uidx) {
    unsigned char* ws = a.ws;
    const bf16* QM = (const bf16*)(ws + WS_QM); bf16* OM = (bf16*)(ws + WS_OM);
    int tid_ = F.wave * 64 + lane_id(); asm volatile("" : "+v"(tid_));
    const int tid = tid_, lane = tid & 63, r32 = lane & 31, hi = lane >> 5;
    int h, rowq0, nq, b;
    if (!SMP) { const int qb = uidx & 15, bh = uidx >> 4; h = bh & 3; b = bh >> 2; rowq0 = b * T + 256 * qb + 32 * F.wave; nq = 32; }
    else { h = uidx & 3; b = uidx >> 2; rowq0 = MP + b * NS; nq = NS; }
    const bool active = !SMP || F.wave == 0;
    bf16x8 qf[16];
    { const bf16* qp = QM + (size_t)(rowq0 + (r32 < nq ? r32 : nq - 1)) * 1024 + h * 256 + hi * 8;
#pragma unroll
      for (int d0 = 0; d0 < 16; ++d0) qf[d0] = __builtin_bit_cast(bf16x8, *(const GAS v4u*)(qp + d0 * 16)); }
    if (!SMP) { const bf16* src = (const bf16*)(ws + WS_MK) + (size_t)(l * 4 + b) * 256 * 1024 + h * 256;
#pragma unroll
        for (int i = 0; i < 16; ++i) { const int j = F.wave * 16 + i, key = 2 * j + (lane >> 5), ch = (lane & 31) ^ (key & 31);
            __builtin_amdgcn_global_load_lds((const GAS unsigned*)(src + (size_t)key * 1024 + ch * 8), (LAS unsigned*)(F.lds + j * 1024), 16, 0, 0); }
        VM_WAIT(); }
    else { const float* src = a.in[4] + (size_t)(l * BS + b) * NMEM * D + h * 256;
#pragma unroll 8
        for (int i = 0; i < 16; ++i) { const int c = tid + 512 * i, key = c >> 5, ch = c & 31;
            const f32x4 x0 = *(const f32x4*)(src + (size_t)key * 1024 + ch * 8), x1 = *(const f32x4*)(src + (size_t)key * 1024 + ch * 8 + 4);
            v4u v; v.x = cvtpk(x0[0], x0[1]); v.y = cvtpk(x0[2], x0[3]); v.z = cvtpk(x1[0], x1[1]); v.w = cvtpk(x1[2], x1[3]);
            *(LAS v4u*)(F.lds + key * 512 + ((ch ^ (key & 31)) << 4)) = v; } }
    __syncthreads();
#ifdef TPROBE
#define MSTAMP(k) do { if (!SMP && F.wave == 0 && lane == 0) { volatile LAS unsigned* tc = (volatile LAS unsigned*)(F.lds + MISC_OFF + 64); const unsigned now_ = (unsigned)__builtin_amdgcn_s_memrealtime(); tc[(k)] += now_ - tc[32]; tc[32] = now_; } } while (0)
#else
#define MSTAMP(k) do { } while (0)
#endif
    MSTAMP(29);
    f32x16 s[8]; unsigned pk[8][8]; float inv[16];
#pragma unroll
    for (int kb = 0; kb < 8; ++kb)
#pragma unroll
        for (int r = 0; r < 16; ++r) s[kb][r] = 0.f;
    { const int xb = r32 ^ hi;
#pragma unroll
      for (int d0 = 0; d0 < 16; ++d0) {
          LAS unsigned char* kp = F.lds + r32 * 512 + ((xb ^ (2 * d0)) << 4);
#pragma unroll
          for (int kb = 0; kb < 8; ++kb) { const bf16x8 kf = *(const LAS bf16x8*)(kp + kb * 16384); s[kb] = MFMA32(kf, qf[d0], s[kb]); }
      } }
    MSTAMP(30);
    __syncthreads();
    { const bf16* src = (const bf16*)(ws + WS_MV) + (size_t)(l * 4 + b) * 256 * 1024 + h * 256;
#pragma unroll
      for (int i = 0; i < 16; ++i) { const int j = F.wave * 16 + i, key = 2 * j + (lane >> 5), cp = lane & 31, ch = ((((cp >> 2) ^ (key & 3)) << 2) | (cp & 3));
          __builtin_amdgcn_global_load_lds((const GAS unsigned*)(src + (size_t)key * 1024 + ch * 8), (LAS unsigned*)(F.lds + j * 1024), 16, 0, 0); } }
    float lsum = 0.f;
    {
        float mx = s[0][0];
#pragma unroll
        for (int kb = 0; kb < 8; ++kb)
#pragma unroll
            for (int r = 0; r < 16; ++r) mx = fmaxf(mx, s[kb][r]);
        mx = xl_max_x32(mx);
#pragma unroll
        for (int kb = 0; kb < 8; ++kb) {
#pragma unroll
            for (int r = 0; r < 16; ++r) { s[kb][r] = __builtin_amdgcn_exp2f(s[kb][r] - mx); lsum += s[kb][r]; }
#pragma unroll
            for (int i = 0; i < 8; ++i) pk[kb][i] = cvtpk(s[kb][2 * i], s[kb][2 * i + 1]); }
        lsum = xl_sum_x32(lsum); }
    VM_WAIT();
    __syncthreads();
    { LAS float* wsf = (LAS float*)(F.lds + AUX_OFF) + F.wave * 64;
      if (hi == 0) wsf[r32] = lsum;
      LDS_WAIT();
#pragma unroll
      for (int r = 0; r < 16; ++r) inv[r] = __builtin_amdgcn_rcpf(wsf[crow(r, hi)]); }
    MSTAMP(23);
    if (active) {
        const int g4 = lane >> 4, cb = g4 & 1, q4 = (lane & 15) >> 2, p4 = lane & 3;
        const unsigned vb = F.lds0 + (4 * hi + q4) * 512 + (16 * cb + 4 * p4) * 2;
        LAS unsigned char* ost = F.lds + OST_OFF + F.wave * 2048;
#pragma unroll 1
        for (int nb = 0; nb < 8; ++nb) { f32x16 o;
#pragma unroll
            for (int r = 0; r < 16; ++r) o[r] = 0.f;
            const unsigned vn = vb + ((nb ^ q4) << 6);
#pragma unroll
            for (int ks = 0; ks < 16; ++ks) { const bf16x8 pf = __builtin_bit_cast(bf16x8, (v4u){pk[ks >> 1][4 * (ks & 1)], pk[ks >> 1][4 * (ks & 1) + 1], pk[ks >> 1][4 * (ks & 1) + 2], pk[ks >> 1][4 * (ks & 1) + 3]});
                const s16x4 b0 = tr_read(vn + ks * 16 * 512), b1 = tr_read(vn + ks * 16 * 512 + 8 * 512);
                const bf16x8 vf = (bf16x8){b0[0], b0[1], b0[2], b0[3], b1[0], b1[1], b1[2], b1[3]};
                o = MFMA32(pf, vf, o); }
#pragma unroll
            for (int r = 0; r < 16; ++r) *(LAS bf16*)(ost + crow(r, hi) * 64 + r32 * 2) = (bf16)(cvtpk(o[r] * inv[r], 0.f) & 0xffffu);
#pragma unroll
            for (int i = 0; i < 2; ++i) { if (SMP && i == 1) continue; const int ch = lane + 64 * i, row = ch >> 2, cp = ch & 3;
                const v4u v = *(const LAS v4u*)(ost + row * 64 + cp * 16); *(GAS v4u*)(OM + (size_t)(rowq0 + row) * 1024 + h * 256 + 32 * nb + cp * 8) = v; }
        }
    }
    __syncthreads();
}

__device__ __forceinline__ void mem_unit_smp(const Args& a, const Frame& F, int l, int uidx) {
    unsigned char* ws = a.ws;
    const bf16* QM = (const bf16*)(ws + WS_QM); bf16* OM = (bf16*)(ws + WS_OM);
    int tid_ = F.wave * 64 + lane_id(); asm volatile("" : "+v"(tid_));
    const int tid = tid_, lane = tid & 63, r32 = lane & 31, hi = lane >> 5, w = F.wave;
    const int h = uidx & 3, b = uidx >> 2, rowq0 = MP + b * NS;
    LAS unsigned char* tile = F.lds + w * 16384;
    LAS float* st = (LAS float*)(F.lds + AUX_OFF);
    bf16x8 qf[16];
    { const bf16* qp = QM + (size_t)(rowq0 + (r32 & 15)) * 1024 + h * 256 + hi * 8;
#pragma unroll
      for (int d0 = 0; d0 < 16; ++d0) qf[d0] = __builtin_bit_cast(bf16x8, *(const GAS v4u*)(qp + d0 * 16)); }
    const size_t coff = ((size_t)(l * BS + b) * NMEM + w) * D + h * 256;
    { const float* src = a.in[4] + coff + (size_t)hi * 8 * D + r32 * 8; f32x4 x[32];
#pragma unroll
      for (int i = 0; i < 16; ++i) { x[2 * i] = *(const f32x4*)(src + (size_t)(16 * i) * D); x[2 * i + 1] = *(const f32x4*)(src + (size_t)(16 * i) * D + 4); }
#pragma unroll
      for (int i = 0; i < 32; ++i) asm volatile("" : "+v"(x[i]));
#pragma unroll
      for (int i = 0; i < 16; ++i) { const int key = 2 * i + hi; v4u v; v.x = cvtpk(x[2 * i][0], x[2 * i][1]); v.y = cvtpk(x[2 * i][2], x[2 * i][3]); v.z = cvtpk(x[2 * i + 1][0], x[2 * i + 1][1]); v.w = cvtpk(x[2 * i + 1][2], x[2 * i + 1][3]);
          *(LAS v4u*)(tile + key * 512 + ((r32 ^ key) << 4)) = v; } }
    f32x4 y[32];
    { int voff = hi * 8 * D + r32 * 8; asm volatile("" : "+v"(voff));
      const float* src = a.in[5] + coff + voff;
#pragma unroll
      for (int i = 0; i < 16; ++i) { y[2 * i] = *(const f32x4*)(src + (size_t)(16 * i) * D); y[2 * i + 1] = *(const f32x4*)(src + (size_t)(16 * i) * D + 4); } }
    LDS_WAIT();
    f32x16 s;
#pragma unroll
    for (int r = 0; r < 16; ++r) s[r] = 0.f;
    { const int xb = r32 ^ hi;
#pragma unroll
      for (int d0 = 0; d0 < 16; ++d0) { const bf16x8 kf = *(const LAS bf16x8*)(tile + r32 * 512 + ((xb ^ (2 * d0)) << 4)); s = MFMA32(kf, qf[d0], s); } }
    float mx = s[0];
#pragma unroll
    for (int r = 1; r < 16; ++r) mx = fmaxf(mx, s[r]);
    mx = xl_max_x32(mx);
    float ls = 0.f;
#pragma unroll
    for (int r = 0; r < 16; ++r) { s[r] = __builtin_amdgcn_exp2f(s[r] - mx); ls += s[r]; }
    ls = xl_sum_x32(ls);
    if (hi == 0) { st[w * 64 + r32] = mx; st[w * 64 + 32 + r32] = ls; }
#pragma unroll
    for (int i = 0; i < 32; ++i) asm volatile("" : "+v"(y[i]));
#pragma unroll
    for (int i = 0; i < 16; ++i) { const int key = 2 * i + hi; v4u v; v.x = cvtpk(y[2 * i][0], y[2 * i][1]); v.y = cvtpk(y[2 * i][2], y[2 * i][3]); v.z = cvtpk(y[2 * i + 1][0], y[2 * i + 1][1]); v.w = cvtpk(y[2 * i + 1][2], y[2 * i + 1][3]);
        *(LAS v4u*)(tile + key * 512 + ((((r32 >> 2) ^ (key & 3)) << 2 | (r32 & 3)) << 4)) = v; }
    __syncthreads();
    unsigned pk[8];
    { float mm[8], m = -3.0e38f, L = 0.f;
#pragma unroll
      for (int j = 0; j < 8; ++j) { mm[j] = st[j * 64 + r32]; m = fmaxf(m, mm[j]); }
#pragma unroll
      for (int j = 0; j < 8; ++j) L += st[j * 64 + 32 + r32] * __builtin_amdgcn_exp2f(mm[j] - m);
      const float f = __builtin_amdgcn_exp2f(mx - m) * __builtin_amdgcn_rcpf(L);
#pragma unroll
      for (int i = 0; i < 8; ++i) pk[i] = cvtpk(s[2 * i] * f, s[2 * i + 1] * f); }
    { const int g4 = lane >> 4, cb = g4 & 1, q4 = (lane & 15) >> 2, p4 = lane & 3;
      const unsigned vb = F.lds0 + (4 * hi + q4) * 512 + (16 * cb + 4 * p4) * 2;
      f32x16 o[8];
#pragma unroll
      for (int nb = 0; nb < 8; ++nb) {
#pragma unroll
          for (int r = 0; r < 16; ++r) o[nb][r] = 0.f;
          const unsigned vn = vb + ((nb ^ q4) << 6);
#pragma unroll
          for (int kl = 0; kl < 2; ++kl) { const int ks = 2 * w + kl; const bf16x8 pf = __builtin_bit_cast(bf16x8, (v4u){pk[4 * kl], pk[4 * kl + 1], pk[4 * kl + 2], pk[4 * kl + 3]});
              const s16x4 b0 = tr_read(vn + ks * 16 * 512), b1 = tr_read(vn + ks * 16 * 512 + 8 * 512);
              const bf16x8 vf = (bf16x8){b0[0], b0[1], b0[2], b0[3], b1[0], b1[1], b1[2], b1[3]};
              o[nb] = MFMA32(pf, vf, o[nb]); } }
      LAS float* part = (LAS float*)tile;
#pragma unroll
      for (int nb = 0; nb < 8; ++nb)
#pragma unroll
          for (int r = 0; r < 8; ++r) part[crow(r, hi) * 256 + 32 * nb + r32] = o[nb][r];
    }
    __syncthreads();
    { const int q = tid >> 5, c8 = (tid & 31) * 8; f32x4 o0 = (f32x4){0.f, 0.f, 0.f, 0.f}, o1 = o0;
#pragma unroll
      for (int j = 0; j < 8; ++j) { const LAS float* pp = (const LAS float*)(F.lds + j * 16384) + q * 256 + c8; o0 = o0 + *(const LAS f32x4*)pp; o1 = o1 + *(const LAS f32x4*)(pp + 4); }
      v4u v; v.x = cvtpk(o0[0], o0[1]); v.y = cvtpk(o0[2], o0[3]); v.z = cvtpk(o1[0], o1[1]); v.w = cvtpk(o1[2], o1[3]);
      *(GAS v4u*)(OM + (size_t)(rowq0 + q) * 1024 + h * 256 + c8) = v; }
    __syncthreads();
}

template <int MODE, int K> __device__ __forceinline__ void mini_gemm(const Frame& F, unsigned char* ws, const bf16* A, const bf16* Bt) {
    int tid_ = F.wave * 64 + lane_id(); asm volatile("" : "+v"(tid_));
    const int tid = tid_, lane = tid & 63, r32 = lane & 31, hi = lane >> 5, w = F.wave;
    constexpr int KS = K >> 3, NIT = KS / 16, BT = (NIT % 8 == 0) ? 8 : 11;
    static_assert(NIT % BT == 0, "batching");
    const int rb = F.bid >> 4, cb = F.bid & 15, row0 = MP + 32 * rb, col0 = 64 * cb;
    const bf16* ap = A + (size_t)(row0 + r32) * K + w * KS + hi * 8;
    const bf16* bp0 = Bt + (size_t)(col0 + r32) * K + w * KS + hi * 8; const bf16* bp1 = bp0 + (size_t)32 * K;
    const int row = tid >> 4, c4 = (tid & 15) * 4, grow = row0 + row, gcol = col0 + c4;
    f32x4 e0, e1, e2, e3, e4, e5; v2u xo;
    if (MODE == 2) { const float* SSQ = (const float*)(ws + WS_SSQ) + (size_t)grow * 16; e0 = *(const f32x4*)SSQ; e1 = *(const f32x4*)(SSQ + 4); e2 = *(const f32x4*)(SSQ + 8); e3 = *(const f32x4*)(SSQ + 12); e4 = e0; e5 = e0; xo.x = 0u; xo.y = 0u; }
    else { if (MODE == 1) { const float* SBSS = (const float*)(ws + WS_SBSS) + (size_t)grow * 8; const float* SASS = (const float*)(ws + WS_SASS) + (size_t)grow * 16;
               e0 = *(const f32x4*)SBSS; e1 = *(const f32x4*)(SBSS + 4); e2 = *(const f32x4*)SASS; e3 = *(const f32x4*)(SASS + 4); e4 = *(const f32x4*)(SASS + 8); e5 = *(const f32x4*)(SASS + 12); }
           else { e0 = (f32x4){0.f, 0.f, 0.f, 0.f}; e1 = e0; e2 = e0; e3 = e0; e4 = e0; e5 = e0; }
           xo = *(const GAS v2u*)((const bf16*)(ws + WS_XB) + (size_t)grow * 1024 + gcol); }
    f32x16 acc0, acc1;
#pragma unroll
    for (int r = 0; r < 16; ++r) { acc0[r] = 0.f; acc1[r] = 0.f; }
#pragma unroll
    for (int k0 = 0; k0 < NIT; k0 += BT) { v4u fa[BT], fb0[BT], fb1[BT];
#pragma unroll
        for (int i = 0; i < BT; ++i) { fa[i] = *(const GAS v4u*)(ap + (k0 + i) * 16); fb0[i] = *(const GAS v4u*)(bp0 + (k0 + i) * 16); fb1[i] = *(const GAS v4u*)(bp1 + (k0 + i) * 16); }
#pragma unroll
        for (int i = 0; i < BT; ++i) asm volatile("" : "+v"(fa[i]), "+v"(fb0[i]), "+v"(fb1[i]));
#pragma unroll
        for (int i = 0; i < BT; ++i) { const bf16x8 af = __builtin_bit_cast(bf16x8, fa[i]); acc0 = MFMA32(af, __builtin_bit_cast(bf16x8, fb0[i]), acc0); acc1 = MFMA32(af, __builtin_bit_cast(bf16x8, fb1[i]), acc1); } }
    LAS float* P = (LAS float*)F.lds + w * 2048;
#pragma unroll
    for (int r = 0; r < 16; ++r) { P[crow(r, hi) * 64 + r32] = acc0[r]; P[crow(r, hi) * 64 + 32 + r32] = acc1[r]; }
    __syncthreads();
    f32x4 sb = (f32x4){0.f, 0.f, 0.f, 0.f}, sa = (f32x4){0.f, 0.f, 0.f, 0.f};
#pragma unroll
    for (int ww = 0; ww < 4; ++ww) { sb = sb + *(const LAS f32x4*)((LAS float*)F.lds + ww * 2048 + row * 64 + c4); sa = sa + *(const LAS f32x4*)((LAS float*)F.lds + (ww + 4) * 2048 + row * 64 + c4); }
    if (MODE == 2) {
        const float s = (((e0[0] + e0[1]) + (e0[2] + e0[3])) + ((e1[0] + e1[1]) + (e1[2] + e1[3]))) + (((e2[0] + e2[1]) + (e2[2] + e2[3])) + ((e3[0] + e3[1]) + (e3[2] + e3[3])));
        const float r = __builtin_amdgcn_rsqf(s * (1.0f / 1024.0f) + EPS) * C_MEM; const f32x4 v = (sb + sa) * r;
        v2u o; o.x = cvtpk(v[0], v[1]); o.y = cvtpk(v[2], v[3]); *(GAS v2u*)((bf16*)(ws + WS_QM) + (size_t)grow * 1024 + gcol) = o;
    } else {
        f32x4 val = sb + sa;
        if (MODE == 1) {
            const float tb = ((e0[0] + e0[1]) + (e0[2] + e0[3])) + ((e1[0] + e1[1]) + (e1[2] + e1[3]));
            const float ta = (((e2[0] + e2[1]) + (e2[2] + e2[3])) + ((e3[0] + e3[1]) + (e3[2] + e3[3]))) + (((e4[0] + e4[1]) + (e4[2] + e4[3])) + ((e5[0] + e5[1]) + (e5[2] + e5[3])));
            val = sb * __builtin_amdgcn_rsqf(tb * (1.0f / 512.0f) + EPS) + sa * __builtin_amdgcn_rsqf(ta * (1.0f / 512.0f) + EPS); }
        bf16* xb = (bf16*)(ws + WS_XB) + (size_t)grow * 1024 + gcol;
        f32x4 x; x[0] = bf_lo(xo.x); x[1] = bf_hi(xo.x); x[2] = bf_lo(xo.y); x[3] = bf_hi(xo.y);
        x = x + val;
        v2u o; o.x = cvtpk(x[0], x[1]); o.y = cvtpk(x[2], x[3]); *(GAS v2u*)xb = o;
        float ss = (x[0] * x[0] + x[1] * x[1]) + (x[2] * x[2] + x[3] * x[3]);
        ss = xl_sum16(ss);
        if ((tid & 15) == 0) ((float*)(ws + WS_SSQ))[(size_t)grow * 16 + cb] = ss;
    }
    __syncthreads();
}

__global__ void __launch_bounds__(NWAVES * 64, 2) mk_fwd(Args args) {
    extern __shared__ __attribute__((aligned(16))) unsigned char lds[];
    const int wave0 = __builtin_amdgcn_readfirstlane((int)threadIdx.x >> 6);
#define PH_FRAME() Frame F; { int w_ = wave0, g_ = (int)gridDim.x, b_ = (int)blockIdx.x; unsigned l0_ = (unsigned)(uintptr_t)lds; asm volatile("" : "+s"(w_), "+s"(g_), "+s"(b_), "+s"(l0_)); \
        F.lds = (LAS unsigned char*)lds; F.lds0 = l0_; F.wave = w_; F.G = g_; F.bid = b_; } \
        size_t wz_ = 0; asm volatile("" : "+s"(wz_)); unsigned char* ws = args.ws + wz_;
    gu32* ctl; { unsigned char* ws0 = args.ws; ctl = (gu32*)(ws0 + WS_CTL); }
    for (int u = wave0 * 64 + lane_id(); u < (LDS_BYTES - LDSCTL_OFF) / 4; u += NWAVES * 64) ((LAS unsigned*)((LAS unsigned char*)lds + LDSCTL_OFF))[u] = 0u;
    __syncthreads();
    XcdBarrier bar = xcd_barrier_post((unsigned*)(ctl + CW_BAR), (volatile LAS unsigned*)((LAS unsigned char*)lds + MISC_OFF) + 8, wave0 * 64 + lane_id());
    const int lo = args.ph_lo, hi_ph = args.ph_hi; int ph = 0;
#ifdef TPROBE
    volatile LAS unsigned* tacc = (volatile LAS unsigned*)((LAS unsigned char*)lds + MISC_OFF + 64);
    if (wave0 * 64 + lane_id() == 0) tacc[32] = (unsigned)__builtin_amdgcn_s_memrealtime();
#define TSTAMP(k) do { if (wave0 * 64 + lane_id() == 0) { const unsigned now_ = (unsigned)__builtin_amdgcn_s_memrealtime(); tacc[(k)] += now_ - tacc[32]; if ((k) >= 16) tacc[31] += now_ - tacc[32]; tacc[32] = now_; } } while (0)
#else
#define TSTAMP(k) do { } while (0)
#endif
#define PH_ON() (lo <= ph && ph < hi_ph)
#ifndef EXTRA_BAR
#define EXTRA_BAR 0
#endif
#define PH_END(kk) do { if (lo <= ph && ph + 1 < hi_ph) { xcd_barrier(bar, wave0 * 64 + lane_id()); for (int xb_ = 0; xb_ < EXTRA_BAR; ++xb_) xcd_barrier(bar, wave0 * 64 + lane_id()); } ++ph; TSTAMP(16 + (kk)); } while (0)

#ifndef NO_PRO
    if (PH_ON()) {
#pragma unroll 1
        for (int rp = 0; rp < REP_P; ++rp) { PH_FRAME(); prologue(args, F); } }
#endif
    TSTAMP(0); PH_END(0);
    for (int l = 0; l < NL; ++l) {
        if (PH_ON())
#pragma unroll 1
        for (int rp = 0; rp < REP_A; ++rp) { PH_FRAME(); const unsigned char* wl = ws + WS_WL + (size_t)l * WL_STRIDE;
            { pg8::Gemm g{(const bf16*)(ws + WS_XB), (const bf16*)(wl + WL_IN), M, INW, D}; pg8::StaticOrder S; S.init(M, INW, F.G, F.bid);
              pg8::EpiIn E{ws, args.out, l, C_SB, (LAS float*)(F.lds + AUX_OFF + 2048)};
#ifndef NO_GA
              pg8::gemm_phase<pg8::EpiIn, pg8::StaticOrder, true, true>(F.lds + RING_OFF, g, S, E, F.wave);
#endif
              }
#ifndef NO_CVA
            if (l + 1 < NL && F.bid >= 148) { __syncthreads(); convert_items<false>(args, F, l + 1, (F.bid - 148) * NWAVES + F.wave, 108 * NWAVES, 0, 2592); }
#endif
        }
        TSTAMP(2); PH_END(2);
        if (PH_ON())
#pragma unroll 1
        for (int rp = 0; rp < REP_B; ++rp) { PH_FRAME();
            if (l == 0) { pg8::Gemm g{(const bf16*)(ws + WS_MEMB), (const bf16*)(ws + WS_WMKV), NB * NMEM, 8 * D, D}; pg8::StaticOrder S; S.init(NB * NMEM, 8 * D, F.G, F.bid >= 128 ? F.bid - 128 : 256);
              pg8::EpiKV E{out_mk_p(args.out), out_mv_p(args.out), (bf16*)(ws + WS_MK), (bf16*)(ws + WS_MV), 0};
#ifndef NO_GKV
              pg8::gemm_phase<pg8::EpiKV, pg8::StaticOrder, true, true>(F.lds + RING_OFF, g, S, E, F.wave);
#endif
              __syncthreads();
            }
#ifndef NO_SGU
#pragma unroll 1
            for (int r2 = 0; r2 < REP_SGU; ++r2) {
            sgu_unit(args, F, l, 2 * (16 * (F.bid & 7) + (F.bid >> 4)) + ((F.bid >> 3) & 1));
            if (F.bid < 8) sgu_unit(args, F, l, 256 + F.bid);
            }
#endif
            TSTAMP(11);
#ifndef NO_SB
            { const int x = F.bid & 7; gu32* qh = (gu32*)(ws + WS_CTL) + CW_SBQ + (l * 8 + x) * 64;
#pragma unroll 1
              for (;;) { unsigned q = 0u; if (lane_id() == 0) q = __hip_atomic_fetch_add(qh, 1u, __ATOMIC_RELAXED, __HIP_MEMORY_SCOPE_AGENT);
                  const int qi = (int)__builtin_amdgcn_readfirstlane(q);
                  if (qi >= 32 + 4 * (T / 32)) break;
                  if (qi < 32) sb_unit<true>(args, F, l, 32 * x + qi); else sb_unit<false>(args, F, l, (4 * x + ((qi - 32) >> 7)) * 128 + ((qi - 32) & 127)); } }
#endif
            __syncthreads();
        }
        TSTAMP(3); PH_END(3);
        if (PH_ON()) { PH_FRAME(); const unsigned char* wl = ws + WS_WL + (size_t)l * WL_STRIDE; pg8::Gemm g{(const bf16*)(ws + WS_CAT), (const bf16*)(wl + WL_OUT), MP, D, D}; pg8::StaticOrder S; S.init(MP, D, F.G, F.bid);
            pg8::EpiRes<true> E{ws, (LAS float*)(F.lds + AUX_OFF + 2048)};
#ifndef NO_GD
            pg8::gemm_phase<pg8::EpiRes<true>, pg8::StaticOrder, true, true>(F.lds + RING_OFF, g, S, E, F.wave);
#endif
            mini_gemm<1, D>(F, ws, (const bf16*)(ws + WS_CAT), (const bf16*)(wl + WL_OUT));
            }
        TSTAMP(4); PH_END(4);
        if (PH_ON())
#pragma unroll 1
        for (int rp = 0; rp < REP_E; ++rp) { PH_FRAME(); const unsigned char* wl = ws + WS_WL + (size_t)l * WL_STRIDE; pg8::Gemm g{(const bf16*)(ws + WS_XB), (const bf16*)(wl + WL_MQ), MP, D, D}; pg8::StaticOrder S; S.init(MP, D, F.G, F.bid);
            pg8::EpiQ E{(const float*)(ws + WS_SSQ), (bf16*)(ws + WS_QM), C_MEM, (LAS float*)(F.lds + AUX_OFF + 2048)};
#ifndef NO_GE
            pg8::gemm_phase<pg8::EpiQ, pg8::StaticOrder, true, true>(F.lds + RING_OFF, g, S, E, F.wave);
#endif
            mini_gemm<2, D>(F, ws, (const bf16*)(ws + WS_XB), (const bf16*)(wl + WL_MQ));
            }
        TSTAMP(5); PH_END(5);
        if (PH_ON())
#pragma unroll 1
        for (int rp = 0; rp < REP_F; ++rp) { PH_FRAME();
#ifndef NO_MEM
            if (F.bid >= 192) mem_unit_smp(args, F, l, F.bid - 192);
            if (F.bid < NB * 4 * (T / 256)) { const int pm_ = 8 * (F.bid & 7) + (F.bid >> 5), h_ = (F.bid >> 3) & 3;
                mem_unit<false>(args, F, l, ((pm_ >> 4) * 4 + h_) * 16 + (pm_ & 15)); }
            TSTAMP(13);
#ifndef NO_MEMS
            if (F.bid < 64) mem_unit_smp(args, F, l, 64 + F.bid);
#endif
#endif
            __syncthreads();
        }
        TSTAMP(6); PH_END(6);
        if (PH_ON()) { PH_FRAME(); const unsigned char* wl = ws + WS_WL + (size_t)l * WL_STRIDE; pg8::Gemm g{(const bf16*)(ws + WS_OM), (const bf16*)(wl + WL_MO), MP, D, D}; pg8::StaticOrder S; S.init(MP, D, F.G, F.bid);
            pg8::EpiRes<false> E{ws, nullptr};
#ifndef NO_GG
            pg8::gemm_phase<pg8::EpiRes<false>, pg8::StaticOrder, true, true>(F.lds + RING_OFF, g, S, E, F.wave);
#endif
            mini_gemm<0, D>(F, ws, (const bf16*)(ws + WS_OM), (const bf16*)(wl + WL_MO));
            }
        TSTAMP(7); PH_END(7);
        if (PH_ON())
#pragma unroll 1
        for (int rp = 0; rp < REP_H; ++rp) { PH_FRAME(); const unsigned char* wl = ws + WS_WL + (size_t)l * WL_STRIDE; pg8::Gemm g{(const bf16*)(ws + WS_XB), (const bf16*)(wl + WL_GU), M, 2 * DFF, D}; pg8::StaticOrder S; S.init(M, 2 * DFF, F.G, F.bid);
            pg8::EpiGU E{(const float*)(ws + WS_SSQ), (bf16*)(ws + WS_H), (LAS float*)(F.lds + AUX_OFF + 2048)};
#ifndef NO_GH
            pg8::gemm_phase<pg8::EpiGU, pg8::StaticOrder, true, true>(F.lds + RING_OFF, g, S, E, F.wave);
#endif
#ifndef NO_CVH
            if (l + 1 < NL && F.bid >= 172) { __syncthreads(); convert_items<false>(args, F, l + 1, (F.bid - 172) * NWAVES + F.wave, 84 * NWAVES, 2592, 3520); }
#endif
            }
        TSTAMP(8); PH_END(8);
        if (PH_ON()) { PH_FRAME(); const unsigned char* wl = ws + WS_WL + (size_t)l * WL_STRIDE; pg8::Gemm g{(const bf16*)(ws + WS_H), (const bf16*)(wl + WL_DN), MP, D, DFF}; pg8::StaticOrder S; S.init(MP, D, F.G, F.bid);
            pg8::EpiRes<false> E{ws, nullptr};
#ifndef NO_GI
            pg8::gemm_phase<pg8::EpiRes<false>, pg8::StaticOrder, true, true, true>(F.lds + RING_OFF, g, S, E, F.wave);
#endif
            mini_gemm<0, DFF>(F, ws, (const bf16*)(ws + WS_H), (const bf16*)(wl + WL_DN));
            }
        TSTAMP(9); PH_END(9);
    }
    if (PH_ON()) { PH_FRAME();
        const float* gf = args.in[24]; const int gw = F.bid * NWAVES + F.wave, NGW = F.G * NWAVES;
        f32x4 gg[4];
#pragma unroll
        for (int j = 0; j < 4; ++j) gg[j] = ((const f32x4*)gf)[lane_id() + 64 * j];
        for (int m0 = gw; m0 < M; m0 += 5 * NGW) {
            float sq[5]; v2u xo[5][4];
#pragma unroll
            for (int k = 0; k < 5; ++k) { int m = m0 + k * NGW; m = m < M ? m : M - 1;
                sq[k] = lane_id() < 16 ? ((const float*)(ws + WS_SSQ))[(size_t)m * 16 + lane_id()] : 0.f;
#pragma unroll
                for (int j = 0; j < 4; ++j) xo[k][j] = ((const v2u*)((const bf16*)(ws + WS_XB) + (size_t)m * D))[lane_id() + 64 * j]; }
#pragma unroll
            for (int k = 0; k < 5; ++k) asm volatile("" : "+v"(sq[k]), "+v"(xo[k][0]), "+v"(xo[k][1]), "+v"(xo[k][2]), "+v"(xo[k][3]));
#pragma unroll
            for (int k = 0; k < 5; ++k) { const int m = m0 + k * NGW;
                if (m < M) { float s = xl_sum16(sq[k]); s = __builtin_bit_cast(float, __builtin_amdgcn_readfirstlane(__builtin_bit_cast(int, s)));
                    const float rstd = __builtin_amdgcn_rsqf(s * (1.0f / 1024.0f) + EPS);
                    float* dst = m < MP ? out_y_p(args.out) + (size_t)m * D : out_y_s(args.out) + (size_t)(m - MP) * D;
#pragma unroll
                    for (int j = 0; j < 4; ++j) { f32x4 v; v[0] = bf_lo(xo[k][j].x); v[1] = bf_hi(xo[k][j].x); v[2] = bf_lo(xo[k][j].y); v[3] = bf_hi(xo[k][j].y);
                        ((f32x4*)dst)[lane_id() + 64 * j] = v * rstd * gg[j]; } } }
        }
    }
    TSTAMP(10);
#ifdef TPROBE
    { unsigned long long* tsum = (unsigned long long*)(args.ws + WS_CTL + 65536);
      if (wave0 * 64 + lane_id() == 0) atomicAdd(tsum, (unsigned long long)tacc[TPROBE]);
      xcd_barrier(bar, wave0 * 64 + lane_id());
      if (blockIdx.x == 0 && wave0 * 64 + lane_id() == 0) { const unsigned long long tot = __hip_atomic_load(tsum, __ATOMIC_RELAXED, __HIP_MEMORY_SCOPE_AGENT);
          const unsigned long long wait = tot * 10ull / gridDim.x, t0 = __builtin_amdgcn_s_memrealtime();
          while (__builtin_amdgcn_s_memrealtime() - t0 < wait) __builtin_amdgcn_s_sleep(8); } }
#endif
#undef PH_ON
#undef PH_END
}

static int mk_grid = 0;
static void mk_launch(void* const* d_in, float* out, unsigned char* ws, hipStream_t stream, int ph_lo, int ph_hi) {
    if (mk_grid == 0) {
        int dev = 0, cus = 0;
        if (hipGetDevice(&dev) != hipSuccess || hipDeviceGetAttribute(&cus, hipDeviceAttributeMultiprocessorCount, dev) != hipSuccess) { mk_grid = -1; return; }
        if (hipFuncSetAttribute((const void*)mk_fwd, hipFuncAttributeMaxDynamicSharedMemorySize, LDS_BYTES) != hipSuccess) { mk_grid = -1; return; }
        (void)hipGetLastError();
        if (cus < 256) { fprintf(stderr, "kernel_launch: this kernel needs 256 CUs (got %d); nothing launched\n", cus); mk_grid = -1; return; }
        mk_grid = 256;
    }
    if (mk_grid < 0) return;
    (void)hipMemsetAsync(ws + WS_CTL, 0, CTL_ZERO_BYTES, stream);
    Args a{};
    for (int i = 0; i < 25; ++i) a.in[i] = (const float*)d_in[i];
    a.out = out; a.ws = ws; a.ph_lo = ph_lo; a.ph_hi = ph_hi;
    hipLaunchKernelGGL(mk_fwd, dim3(mk_grid), dim3(NWAVES * 64), LDS_BYTES, stream, a);
}
extern "C" void kernel_launch(void* const* d_in, const int* in_sizes, int n_in, void* d_out, int out_size, void* d_ws, size_t ws_size, hipStream_t stream) {
    mk_launch(d_in, (float*)d_out, (unsigned char*)d_ws, stream, 0, 34);
}
```

```cpp
#include <hip/hip_runtime.h>
#include <cstdint>
#include <cstdio>
#include <cmath>
namespace pg8 {
#define PG8_LAS __attribute__((address_space(3)))
typedef unsigned short bf16_t;
typedef short bf16x8 __attribute__((ext_vector_type(8)));
typedef float f32x4 __attribute__((ext_vector_type(4)));
typedef unsigned u32x4 __attribute__((ext_vector_type(4)));
constexpr int BM = 256, BK = 64, HALF = 128, HTB = HALF * BK * 2  , STAGE_BYTES = 8 * HTB, NXCD = 8, WGM = 8;

__host__ __device__ __forceinline__ int lds_byte(int r, int c) { const int st = (r >> 4) * 2 + (c >> 5), rr = r & 15, cc = c & 31, ob = rr * 64 + cc * 2; return st * 1024 + (ob ^ (((ob >> 9) & 1) << 5)); }
__host__ __device__ __forceinline__ void stage_rc(int b, int& R, int& C) { const int st = b / 1024, sb = b % 1024, swz = sb ^ (((sb >> 9) & 1) << 5); R = (st >> 1) * 16 + swz / 64; C = (st & 1) * 32 + (swz % 64) / 2; }
__host__ __device__ __forceinline__ int perm32(int rho) { const int n = rho >> 4, i = rho & 15; return 8 * (i >> 2) + 4 * n + (i & 3); }

template <int CTRL> __device__ __forceinline__ float xl_dpp(float v) { return __builtin_bit_cast(float, __builtin_amdgcn_mov_dpp(__builtin_bit_cast(int, v), CTRL, 0xF, 0xF, true)); }
__device__ __forceinline__ float xl_sum16(float v) {
    v += xl_dpp<0xB1>(v); v += xl_dpp<0x4E>(v); v += xl_dpp<0x141>(v); v += xl_dpp<0x140>(v); return v; }
__device__ __forceinline__ void xl_swap16(float v, float& a, float& b) { a = v; b = v; asm volatile("s_nop 1\n\tv_permlane16_swap_b32 %0, %1" : "+v"(a), "+v"(b)); }
__device__ __forceinline__ void xl_swap32(float v, float& a, float& b) { a = v; b = v; asm volatile("s_nop 1\n\tv_permlane32_swap_b32 %0, %1" : "+v"(a), "+v"(b)); }
__device__ __forceinline__ float xl_sum_x16(float v) { float a, b; xl_swap16(v, a, b); return a + b; }
__device__ __forceinline__ float xl_sum_x32(float v) { float a, b; xl_swap32(v, a, b); return a + b; }
__device__ __forceinline__ float xl_max_x32(float v) { float a, b; xl_swap32(v, a, b); return fmaxf(a, b); }
__device__ __forceinline__ float xl_other_x32(float v, int hi) { float a, b; xl_swap32(v, a, b); return hi ? a : b; }
__device__ __forceinline__ int pg8_lane_id() { int l_; asm volatile("v_mbcnt_lo_u32_b32 %0, -1, 0\n\tv_mbcnt_hi_u32_b32 %0, -1, %0" : "=v"(l_)); return l_; }
struct Unit { int pm, pn; };
struct Gemm { const bf16_t* A; const bf16_t* Bt; int M, N, K; };

struct StaticOrder {
    int nM, nN, nwg, G, c;
    __host__ __device__ void init(int M, int N, int G_, int c_) { nM = M / BM; nN = N / BM; nwg = nM * nN; G = G_; c = c_; }
    __host__ __device__ bool next(int i, Unit& u) const {
        const long L = (long)i * G + c; if (L >= nwg) return false;
        int wgid = (int)L; { const int q = nwg / NXCD, r = nwg % NXCD, xcd = wgid % NXCD, off = wgid / NXCD; wgid = (xcd < r ? xcd * (q + 1) : r * (q + 1) + (xcd - r) * q) + off; }
        const int nig = WGM * nN, gid = wgid / nig, fm = gid * WGM, gsz = (nM - fm) < WGM ? (nM - fm) : WGM;
        u.pm = fm + ((wgid % nig) % gsz); u.pn = nN - 1 - (wgid % nig) / gsz; return true;
    }
    __device__ __forceinline__ void a_ready(const Unit&) const {}
    __device__ __forceinline__ void done(const Unit&) const {}
};

__device__ __forceinline__ unsigned cvt_pk_bf16(float lo, float hi) { unsigned r; asm volatile("v_cvt_pk_bf16_f32 %0, %1, %2" : "=v"(r) : "v"(lo), "v"(hi)); return r; }
typedef float f32x2 __attribute__((ext_vector_type(2)));
constexpr int E_MP = 16384, E_MS = 512;
constexpr size_t EMiB = 1u << 20, EW_SSQ = 148 * EMiB, EW_SBSS = 150 * EMiB, EW_SASS = 527 * EMiB, EW_XF = 152 * EMiB, EW_XB = 218 * EMiB, EW_U = 251 * EMiB, EW_VA = 268 * EMiB, EW_Q = 285 * EMiB, EW_K = 302 * EMiB, EW_V = 319 * EMiB;
constexpr size_t EO_SBK_P = (size_t)16896 * 1024, EO_SBV_P = EO_SBK_P + (size_t)4 * 16384 * 512, EO_MK_P = EO_SBV_P + (size_t)4 * 16384 * 512, EO_MV_P = EO_MK_P + (size_t)4 * 4 * 256 * 1024, EO_SBK_S = EO_MV_P + (size_t)4 * 4 * 256 * 1024, EO_SBV_S = EO_SBK_S + (size_t)4 * 512 * 512;
constexpr float E_EPS = 1e-6f, E_LOG2E = 1.4426950408889634f;
typedef unsigned u32x2 __attribute__((ext_vector_type(2)));
__device__ __forceinline__ void load_rstd(const float* SSQ, int row0, int fq, float (&rs)[2][4]) {
#pragma unroll
    for (int ai = 0; ai < 2; ++ai)
#pragma unroll
        for (int m = 0; m < 4; ++m) { const f32x4 a = *(const f32x4*)(SSQ + (size_t)(row0 + ai * HALF + m * 16) * 16 + fq * 4);
            float s = (a[0] + a[1]) + (a[2] + a[3]); s = xl_sum_x16(s); s = xl_sum_x32(s);
            rs[ai][m] = __builtin_amdgcn_rsqf(s * (1.0f / 1024.0f) + E_EPS); }
}
__device__ __forceinline__ void prep_rstd(const float* SSQ, PG8_LAS float* aux, const Unit& u, int ui, int tid) {
    if (tid < 256) { const f32x4* p = (const f32x4*)(SSQ + (size_t)(u.pm * BM + tid) * 16); const f32x4 a = p[0], b = p[1], c = p[2], d = p[3];
        const float s = (((a[0] + a[1]) + (a[2] + a[3])) + ((b[0] + b[1]) + (b[2] + b[3]))) + (((c[0] + c[1]) + (c[2] + c[3])) + ((d[0] + d[1]) + (d[2] + d[3])));
        aux[(ui & 1) * 256 + tid] = __builtin_amdgcn_rsqf(s * (1.0f / 1024.0f) + E_EPS); }
}
__device__ __forceinline__ f32x4 ld_untracked(const float* p) { f32x4 v; asm volatile("global_load_dwordx4 %0, %1, off" : "=v"(v) : "v"(p) : "memory"); return v; }
__device__ __forceinline__ void prep_rstd_load(const float* SSQ, const Unit& u, int tid, f32x4 (&pr)[6]) {
    if (tid < 256) { const float* p = SSQ + (size_t)(u.pm * BM + tid) * 16; pr[0] = ld_untracked(p); pr[1] = ld_untracked(p + 4); pr[2] = ld_untracked(p + 8); pr[3] = ld_untracked(p + 12); }
}
__device__ __forceinline__ void prep_rstd_commit(PG8_LAS float* aux, const f32x4 (&pr)[6], int ui, int tid) {
    if (tid < 256) { const f32x4 a = pr[0], b = pr[1], c = pr[2], d = pr[3];
        const float s = (((a[0] + a[1]) + (a[2] + a[3])) + ((b[0] + b[1]) + (b[2] + b[3]))) + (((c[0] + c[1]) + (c[2] + c[3])) + ((d[0] + d[1]) + (d[2] + d[3])));
        aux[(ui & 1) * 256 + tid] = __builtin_amdgcn_rsqf(s * (1.0f / 1024.0f) + E_EPS); }
}
__device__ __forceinline__ void aux_rstd(const PG8_LAS float* aux, int ui, int wr, int fr, float (&rs)[2][4]) {
#pragma unroll
    for (int ai = 0; ai < 2; ++ai)
#pragma unroll
        for (int m = 0; m < 4; ++m) rs[ai][m] = aux[(ui & 1) * 256 + ai * HALF + wr * 64 + m * 16 + fr];
}
__device__ __forceinline__ float gelu_tanh_f(float x) {
    const float y = x * (1.0f + 0.044715f * x * x);
    const float e = __builtin_amdgcn_exp2f(y * (-2.0f * 0.7978845608028654f * E_LOG2E));
    return x * __builtin_amdgcn_rcpf(1.0f + e);
}
__device__ __forceinline__ u32x4 pack8(const f32x4 a, const f32x4 b) { u32x4 w; w.x = cvt_pk_bf16(a[0], a[1]); w.y = cvt_pk_bf16(a[2], a[3]); w.z = cvt_pk_bf16(b[0], b[1]); w.w = cvt_pk_bf16(b[2], b[3]); return w; }

struct EpiIn {
    static constexpr bool PERM = true, AFTER_DRAIN = false, MIDSCALE = false, PREP = true; static constexpr int MID_T = 0;
    unsigned char* ws; float* out; int l; float qscale; PG8_LAS float* aux;
    __device__ __forceinline__ void midscale(f32x4 (&)[2][2][4][2], const Unit&, int, int, int) const {}
    __device__ __forceinline__ void prepare(const Unit& u, int ui, int tid) const { size_t z_ = 0; asm volatile("" : "+s"(z_)); prep_rstd((const float*)(ws + z_ + EW_SSQ), aux, u, ui, tid); }
    __device__ __forceinline__ void prepare_load(const Unit& u, int tid, f32x4 (&pr)[6]) const { size_t z_ = 0; asm volatile("" : "+s"(z_)); prep_rstd_load((const float*)(ws + z_ + EW_SSQ), u, tid, pr); }
    __device__ __forceinline__ void prepare_commit(const f32x4 (&pr)[6], int ui, int tid) const { prep_rstd_commit(aux, pr, ui, tid); }
    __device__ __forceinline__ void operator()(const f32x4 (&acc)[2][2][4][2], const Unit& u, int wr, int wc, int fr, int fq, int ui) const {
        size_t z_ = 0; asm volatile("" : "+s"(z_)); unsigned char* w = ws + z_; float* o = out + z_;
        const int row0 = u.pm * BM + wr * 64 + fr, typ = u.pn >> 1, col0 = (u.pn & 1) * 256 + wc * 32 + 8 * fq;
        float rs[2][4]; aux_rstd(aux, ui, wr, fr, rs);
        bf16_t* ob = (bf16_t*)(w + (typ == 0 ? EW_U : typ == 1 ? EW_VA : typ == 2 ? EW_Q : typ == 3 ? EW_K : EW_V));
        float* of = nullptr;
        if (typ >= 3) { const bool smp = u.pm * BM >= E_MP;
            of = o + (smp ? (typ == 3 ? EO_SBK_S : EO_SBV_S) + (size_t)l * E_MS * 512 - (size_t)E_MP * 512 : (typ == 3 ? EO_SBK_P : EO_SBV_P) + (size_t)l * E_MP * 512); }
#pragma unroll
        for (int ai = 0; ai < 2; ++ai)
#pragma unroll
            for (int m = 0; m < 4; ++m) { const int row = row0 + ai * HALF + m * 16; const float r = rs[ai][m];
#pragma unroll
                for (int bj = 0; bj < 2; ++bj) { f32x4 v0 = acc[ai][bj][m][0] * r, v1 = acc[ai][bj][m][1] * r; const size_t off = (size_t)row * 512 + col0 + bj * HALF;
                    if (typ <= 1) {
#pragma unroll
                        for (int i = 0; i < 4; ++i) { v0[i] = gelu_tanh_f(v0[i]); v1[i] = gelu_tanh_f(v1[i]); } }
                    else if (typ == 2) { v0 = v0 * qscale; v1 = v1 * qscale; }
                    else { *(f32x4*)(of + off) = v0; *(f32x4*)(of + off + 4) = v1; }
                    *(u32x4*)(ob + off) = pack8(v0, v1); }
                asm volatile("" ::: "memory"); }
#ifdef TPROBE
        if (wr == 0 && wc == 0 && fr == 0 && fq == 0) {
            volatile PG8_LAS unsigned* tc = (volatile PG8_LAS unsigned*)((PG8_LAS unsigned char*)aux - 2048 - 640);
            const unsigned now_ = (unsigned)__builtin_amdgcn_s_memrealtime(); tc[typ <= 1 ? 1 : typ == 2 ? 15 : 26] += now_ - tc[32]; tc[32] = now_; }
#endif
    }
};
template <bool MID> struct EpiRes {
    static constexpr bool PERM = true, AFTER_DRAIN = false, MIDSCALE = MID, PREP = MID; static constexpr int MID_T = 8;
    unsigned char* ws; PG8_LAS float* aux;
    __device__ __forceinline__ void prepare_load(const Unit& u, int tid, f32x4 (&pr)[6]) const {
        if (MID && tid < 256) { size_t z_ = 0; asm volatile("" : "+s"(z_)); unsigned char* w = ws + z_; const float* SBSS = (const float*)(w + EW_SBSS); const float* SASS = (const float*)(w + EW_SASS);
            const size_t row = (size_t)(u.pm * BM + tid);
            pr[0] = ld_untracked(SBSS + row * 8); pr[1] = ld_untracked(SBSS + row * 8 + 4);
            pr[2] = ld_untracked(SASS + row * 16); pr[3] = ld_untracked(SASS + row * 16 + 4); pr[4] = ld_untracked(SASS + row * 16 + 8); pr[5] = ld_untracked(SASS + row * 16 + 12); }
    }
    __device__ __forceinline__ void prepare_commit(const f32x4 (&pr)[6], int ui, int tid) const {
        if (MID && tid < 256) { const f32x4 b0 = pr[0], b1 = pr[1], a0 = pr[2], a1 = pr[3], a2 = pr[4], a3 = pr[5];
            const float sb = ((b0[0] + b0[1]) + (b0[2] + b0[3])) + ((b1[0] + b1[1]) + (b1[2] + b1[3]));
            const float sa = (((a0[0] + a0[1]) + (a0[2] + a0[3])) + ((a1[0] + a1[1]) + (a1[2] + a1[3]))) + (((a2[0] + a2[1]) + (a2[2] + a2[3])) + ((a3[0] + a3[1]) + (a3[2] + a3[3])));
            const float rb = __builtin_amdgcn_rsqf(sb * (1.0f / 512.0f) + E_EPS), qa = sa * (1.0f / 512.0f) + E_EPS;
            aux[(ui & 1) * 512 + tid] = rb * __builtin_amdgcn_sqrtf(qa); aux[(ui & 1) * 512 + 256 + tid] = __builtin_amdgcn_rsqf(qa); }
    }
    __device__ __forceinline__ void prepare(const Unit& u, int ui, int tid) const { f32x4 pr[6]; prepare_load(u, tid, pr); asm volatile("s_waitcnt vmcnt(0)" : "+v"(pr[0]), "+v"(pr[1]), "+v"(pr[2]), "+v"(pr[3]), "+v"(pr[4]), "+v"(pr[5]) :: "memory"); prepare_commit(pr, ui, tid); }
    __device__ __forceinline__ void midscale(f32x4 (&acc)[2][2][4][2], const Unit& u, int wr, int fr, int ui) const {
#pragma unroll
        for (int ai = 0; ai < 2; ++ai)
#pragma unroll
            for (int m = 0; m < 4; ++m) { const float r = aux[(ui & 1) * 512 + ai * HALF + wr * 64 + m * 16 + fr];
#pragma unroll
                for (int bj = 0; bj < 2; ++bj)
#pragma unroll
                    for (int n = 0; n < 2; ++n) acc[ai][bj][m][n] = acc[ai][bj][m][n] * r; }
    }
    __device__ __forceinline__ void operator()(const f32x4 (&acc)[2][2][4][2], const Unit& u, int wr, int wc, int fr, int fq, int ui) const {
        size_t z_ = 0; asm volatile("" : "+s"(z_)); unsigned char* w = ws + z_; bf16_t* XB = (bf16_t*)(w + EW_XB); float* SSQ = (float*)(w + EW_SSQ);
        const int row0 = u.pm * BM + wr * 64 + fr, col0 = u.pn * BM + wc * 32 + 8 * fq;
#pragma unroll
        for (int ai = 0; ai < 2; ++ai) {
            u32x4 xo[4][2];
#pragma unroll
            for (int m = 0; m < 4; ++m)
#pragma unroll
                for (int bj = 0; bj < 2; ++bj) xo[m][bj] = *(const u32x4*)(XB + (size_t)(row0 + ai * HALF + m * 16) * 1024 + col0 + bj * HALF);
            asm volatile("" : "+v"(xo[0][0]), "+v"(xo[0][1]), "+v"(xo[1][0]), "+v"(xo[1][1]), "+v"(xo[2][0]), "+v"(xo[2][1]), "+v"(xo[3][0]), "+v"(xo[3][1]));
#pragma unroll
            for (int m = 0; m < 4; ++m) { const int row = row0 + ai * HALF + m * 16; float ss = 0.f, ra = 1.0f;
                if (MID) ra = aux[(ui & 1) * 512 + 256 + ai * HALF + wr * 64 + m * 16 + fr];
#pragma unroll
                for (int bj = 0; bj < 2; ++bj) { const size_t off = (size_t)row * 1024 + col0 + bj * HALF;
                    const u32x4 xv = xo[m][bj];
                    f32x4 x0, x1;
                    x0[0] = __uint_as_float(xv.x << 16); x0[1] = __uint_as_float(xv.x & 0xffff0000u); x0[2] = __uint_as_float(xv.y << 16); x0[3] = __uint_as_float(xv.y & 0xffff0000u);
                    x1[0] = __uint_as_float(xv.z << 16); x1[1] = __uint_as_float(xv.z & 0xffff0000u); x1[2] = __uint_as_float(xv.w << 16); x1[3] = __uint_as_float(xv.w & 0xffff0000u);
                    x0 = x0 + (MID ? acc[ai][bj][m][0] * ra : acc[ai][bj][m][0]); x1 = x1 + (MID ? acc[ai][bj][m][1] * ra : acc[ai][bj][m][1]);
                    *(u32x4*)(XB + off) = pack8(x0, x1);
                    ss += ((x0[0] * x0[0] + x0[1] * x0[1]) + (x0[2] * x0[2] + x0[3] * x0[3])) + ((x1[0] * x1[0] + x1[1] * x1[1]) + (x1[2] * x1[2] + x1[3] * x1[3])); }
                ss = xl_sum_x16(ss); ss = xl_sum_x32(ss);
                if (fq == 0) SSQ[(size_t)row * 16 + u.pn * 4 + wc] = ss; }
        }
    }
};
struct EpiQ {
    static constexpr bool PERM = true, AFTER_DRAIN = false, MIDSCALE = false, PREP = true; static constexpr int MID_T = 0;
    const float* SSQ; bf16_t* QM; float qscale; PG8_LAS float* aux;
    __device__ __forceinline__ void midscale(f32x4 (&)[2][2][4][2], const Unit&, int, int, int) const {}
    __device__ __forceinline__ void prepare(const Unit& u, int ui, int tid) const { prep_rstd(SSQ, aux, u, ui, tid); }
    __device__ __forceinline__ void prepare_load(const Unit& u, int tid, f32x4 (&pr)[6]) const { prep_rstd_load(SSQ, u, tid, pr); }
    __device__ __forceinline__ void prepare_commit(const f32x4 (&pr)[6], int ui, int tid) const { prep_rstd_commit(aux, pr, ui, tid); }
    __device__ __forceinline__ void operator()(const f32x4 (&acc)[2][2][4][2], const Unit& u, int wr, int wc, int fr, int fq, int ui) const {
        const int row0 = u.pm * BM + wr * 64 + fr, col0 = u.pn * BM + wc * 32 + 8 * fq;
        float rs[2][4]; aux_rstd(aux, ui, wr, fr, rs);
#pragma unroll
        for (int ai = 0; ai < 2; ++ai)
#pragma unroll
            for (int m = 0; m < 4; ++m) { const float r = rs[ai][m] * qscale;
                const int rbk = u.pm * 8 + wr * 2 + ai * 4 + (m >> 1), rr = fr + 16 * (m & 1);
                bf16_t* tp = QM + (size_t)(rbk * 4 + u.pn) * 8192 + (size_t)(((2 * wc + (fq >> 1)) * 32 + rr) * 2 + (fq & 1)) * 8;
#pragma unroll
                for (int bj = 0; bj < 2; ++bj) *(u32x4*)(tp + bj * 8 * 512) = pack8(acc[ai][bj][m][0] * r, acc[ai][bj][m][1] * r); }
    }
};
struct EpiGU {
    static constexpr bool PERM = true, AFTER_DRAIN = false, MIDSCALE = false, PREP = true; static constexpr int MID_T = 0;
    const float* SSQ; bf16_t* H; PG8_LAS float* aux;
    __device__ __forceinline__ void midscale(f32x4 (&)[2][2][4][2], const Unit&, int, int, int) const {}
    __device__ __forceinline__ void prepare(const Unit& u, int ui, int tid) const { prep_rstd(SSQ, aux, u, ui, tid); }
    __device__ __forceinline__ void prepare_load(const Unit& u, int tid, f32x4 (&pr)[6]) const { prep_rstd_load(SSQ, u, tid, pr); }
    __device__ __forceinline__ void prepare_commit(const f32x4 (&pr)[6], int ui, int tid) const { prep_rstd_commit(aux, pr, ui, tid); }
    __device__ __forceinline__ void operator()(const f32x4 (&acc)[2][2][4][2], const Unit& u, int wr, int wc, int fr, int fq, int ui) const {
        const int row0 = u.pm * BM + wr * 64 + fr, col0 = u.pn * HALF + wc * 32 + 8 * fq;
        float rs[2][4]; aux_rstd(aux, ui, wr, fr, rs);
#pragma unroll
        for (int ai = 0; ai < 2; ++ai)
#pragma unroll
            for (int m = 0; m < 4; ++m) { const float r = rs[ai][m]; f32x4 h[2];
#pragma unroll
                for (int n = 0; n < 2; ++n) { const f32x4 g = acc[ai][0][m][n] * r, uu = acc[ai][1][m][n] * r;
#pragma unroll
                    for (int i = 0; i < 4; ++i) h[n][i] = g[i] * uu[i] * __builtin_amdgcn_rcpf(1.0f + __builtin_amdgcn_exp2f(-E_LOG2E * g[i])); }
                *(u32x4*)(H + (size_t)(row0 + ai * HALF + m * 16) * 2816 + col0) = pack8(h[0], h[1]); }
    }
};
struct EpiKV {
    static constexpr bool PERM = true, AFTER_DRAIN = false, MIDSCALE = false, PREP = false; static constexpr int MID_T = 0;
    float *mk_out, *mv_out; bf16_t *MK, *MVt; int pn0;
    __device__ __forceinline__ void midscale(f32x4 (&)[2][2][4][2], const Unit&, int, int, int) const {}
    __device__ __forceinline__ void prepare(const Unit&, int, int) const {}
    __device__ __forceinline__ void prepare_load(const Unit&, int, f32x4 (&)[6]) const {}
    __device__ __forceinline__ void prepare_commit(const f32x4 (&)[6], int, int) const {}
    __device__ __forceinline__ void operator()(const f32x4 (&acc)[2][2][4][2], const Unit& u, int wr, int wc, int fr, int fq, int ui) const {
        const int pn = u.pn + pn0, l = pn >> 3, isv = (pn >> 2) & 1, hh = pn & 3, b = u.pm;
        const int key0 = wr * 64 + fr, col0 = hh * 256 + wc * 32 + 8 * fq;
        float* of = (isv ? mv_out : mk_out) + (size_t)(l * 4 + b) * 256 * 1024 + (size_t)key0 * 1024 + col0;
#pragma unroll
        for (int ai = 0; ai < 2; ++ai)
#pragma unroll
            for (int m = 0; m < 4; ++m) { float* p = of + (size_t)(ai * HALF + m * 16) * 1024;
#pragma unroll
                for (int bj = 0; bj < 2; ++bj) { *(f32x4*)(p + bj * HALF) = acc[ai][bj][m][0]; *(f32x4*)(p + bj * HALF + 4) = acc[ai][bj][m][1]; }
                asm volatile("" ::: "memory"); }
        bf16_t* ob = (isv ? MVt : MK) + ((size_t)(l * 4 + b) * 256 + key0) * 1024 + col0;
#pragma unroll
        for (int ai = 0; ai < 2; ++ai)
#pragma unroll
            for (int m = 0; m < 4; ++m) {
#pragma unroll
                for (int bj = 0; bj < 2; ++bj) *(u32x4*)(ob + (size_t)(ai * HALF + m * 16) * 1024 + bj * HALF) = pack8(acc[ai][bj][m][0], acc[ai][bj][m][1]);
                asm volatile("" ::: "memory"); }
    }
};
template <class Epi, class Sched, bool ALIGN_EPI = false, bool SP2 = false, bool KREV = false>
__device__ __forceinline__ void gemm_phase(PG8_LAS unsigned char* lds, const Gemm g, const Sched& S, const Epi& E, int wave_id) {
    int tid_ = wave_id * 64 + pg8_lane_id(); asm volatile("" : "+v"(tid_));
    const int tid = tid_, wid = __builtin_amdgcn_readfirstlane(tid >> 6), lane = tid & 63, wr = wid >> 2, wc = wid & 3, fr = lane & 15, fq = lane >> 4;
    const int K = g.K, nt = K / BK;
    unsigned voffA[2], voffB[2];
#pragma unroll
    for (int i = 0; i < 2; ++i) { int R, C; stage_rc(tid * 16 + i * 8192, R, C); const int Rb = Epi::PERM ? ((R & ~31) + perm32(R & 31)) : R;
        voffA[i] = (unsigned)(R * K + C) * 2u; voffB[i] = (unsigned)(Rb * K + C) * 2u; }
    const ptrdiff_t kstep = KREV ? -(ptrdiff_t)(BK * 2) : (ptrdiff_t)(BK * 2);
    const size_t k0off = KREV ? (size_t)(nt - 1) * (BK * 2) : 0;
    const size_t hstep = (size_t)HALF * K * 2;
    const size_t tstep = 2 * hstep;
    const unsigned ldsw = (unsigned)wid * 1024u;
    const int aoff = lds_byte(wr * 64 + fr, fq * 8), boff = lds_byte(wc * 32 + fr, fq * 8);
#define PG8_SA(b, h) (((b) * 2 + (h)) * HTB)
#define PG8_SB(b, h) ((4 + (b) * 2 + (h)) * HTB)
#define PG8_STAGE(bufoff, gbase, voff) do { _Pragma("unroll") for (int _i = 0; _i < 2; ++_i) \
        __builtin_amdgcn_global_load_lds((const unsigned*)((const char*)(gbase) + (voff)[_i]), (PG8_LAS unsigned*)(lds + (bufoff) + ldsw + _i * 8192), 16, 0, 0); } while (0)
#define PG8_LDA(dst, b, h) do { _Pragma("unroll") for (int m = 0; m < 4; ++m) _Pragma("unroll") for (int k = 0; k < 2; ++k) dst[m][k] = *(const PG8_LAS bf16x8*)(lds + PG8_SA(b, h) + aoff + m * 2048 + k * 1024); } while (0)
#define PG8_LDB(dst, b, h) do { _Pragma("unroll") for (int n = 0; n < 2; ++n) _Pragma("unroll") for (int k = 0; k < 2; ++k) dst[n][k] = *(const PG8_LAS bf16x8*)(lds + PG8_SB(b, h) + boff + n * 2048 + k * 1024); } while (0)
#define PG8_MMA(ai, bj, At, Bt) do { __builtin_amdgcn_s_setprio(1); _Pragma("unroll") for (int m = 0; m < 4; ++m) _Pragma("unroll") for (int n = 0; n < 2; ++n) _Pragma("unroll") for (int k = 0; k < 2; ++k) \
        acc[ai][bj][m][n] = __builtin_amdgcn_mfma_f32_16x16x32_bf16(Bt[n][k], At[m][k], acc[ai][bj][m][n], 0, 0, 0); __builtin_amdgcn_s_setprio(0); } while (0)
#define PG8_WAIT_V(n) asm volatile("s_waitcnt vmcnt(" #n ")" ::: "memory")
#define PG8_WAIT_L(n) asm volatile("s_waitcnt lgkmcnt(" #n ")" ::: "memory")
#define PG8_BAR __builtin_amdgcn_s_barrier()
#define PG8_SCHED __builtin_amdgcn_sched_barrier(0)
    Unit cur, nxt; int ui = 0;
    if (!S.next(0, cur)) return;
    f32x4 acc[2][2][4][2];
#pragma unroll
    for (int a = 0; a < 2; ++a)
#pragma unroll
        for (int b = 0; b < 2; ++b)
#pragma unroll
            for (int m = 0; m < 4; ++m)
#pragma unroll
                for (int n = 0; n < 2; ++n) acc[a][b][m][n] = (f32x4){0.f, 0.f, 0.f, 0.f};
    bf16x8 At[4][2], B0[2][2], B1[2][2];
    const char* cA = (const char*)g.A + (size_t)cur.pm * tstep + k0off; const char* cB = (const char*)g.Bt + (size_t)cur.pn * tstep + k0off;
    S.a_ready(cur);
    if constexpr (Epi::PREP) E.prepare(cur, 0, tid);
    if constexpr (SP2) {
        PG8_STAGE(PG8_SB(0, 0), cB, voffB); PG8_STAGE(PG8_SB(0, 1), cB + hstep, voffB); PG8_STAGE(PG8_SA(0, 0), cA, voffA); PG8_STAGE(PG8_SA(0, 1), cA + hstep, voffA);
        if (wr == 1) PG8_BAR;
        PG8_WAIT_V(2); PG8_BAR;
        PG8_STAGE(PG8_SB(1, 0), cB + kstep, voffB); PG8_STAGE(PG8_SA(1, 0), cA + kstep, voffA); PG8_STAGE(PG8_SB(1, 1), cB + hstep + kstep, voffB);
        PG8_WAIT_V(6); PG8_BAR;
    } else {
        PG8_STAGE(PG8_SB(0, 0), cB, voffB); PG8_STAGE(PG8_SA(0, 0), cA, voffA); PG8_STAGE(PG8_SB(0, 1), cB + hstep, voffB); PG8_STAGE(PG8_SA(0, 1), cA + hstep, voffA);
        if (wr == 1) PG8_BAR;
        PG8_WAIT_V(4); PG8_BAR;
        PG8_STAGE(PG8_SB(1, 0), cB + kstep, voffB); PG8_STAGE(PG8_SA(1, 0), cA + kstep, voffA); PG8_STAGE(PG8_SB(1, 1), cB + hstep + kstep, voffB);
        PG8_WAIT_V(6); PG8_BAR;
    }
    for (;;) {
        const bool has_next = S.next(ui + 1, nxt);
        const char* nA = has_next ? (const char*)g.A + (size_t)nxt.pm * tstep + k0off : cA; const char* nB = has_next ? (const char*)g.Bt + (size_t)nxt.pn * tstep + k0off : cB;
        for (int t = 0; t < nt; t += 2) {
            if constexpr (Epi::MIDSCALE) { if (t == Epi::MID_T) E.midscale(acc, cur, wr, fr, ui); }
            const bool last = (t == nt - 2);
            const char* a1 = cA + (ptrdiff_t)(t + 1) * kstep;
            const char* a2 = last ? nA : cA + (ptrdiff_t)(t + 2) * kstep; const char* b2 = last ? nB : cB + (ptrdiff_t)(t + 2) * kstep;
            const char* a3 = a2 + kstep; const char* b3 = b2 + kstep;
            if (last && has_next) S.a_ready(nxt);
            if constexpr (SP2) {
            PG8_LDB(B0, 0, 0); PG8_LDB(B1, 0, 1); PG8_SCHED; PG8_LDA(At, 0, 0); PG8_STAGE(PG8_SA(1, 1), a1 + hstep, voffA);
            PG8_WAIT_V(8); PG8_WAIT_L(0); PG8_BAR; PG8_MMA(0, 0, At, B0); PG8_MMA(0, 1, At, B1); PG8_BAR; PG8_SCHED;
            PG8_LDA(At, 0, 1); PG8_STAGE(PG8_SB(0, 0), b2, voffB); PG8_STAGE(PG8_SB(0, 1), b2 + hstep, voffB); PG8_STAGE(PG8_SA(0, 0), a2, voffA);
            PG8_WAIT_V(8); PG8_WAIT_L(0); PG8_BAR; PG8_MMA(1, 0, At, B0); PG8_MMA(1, 1, At, B1); PG8_BAR; PG8_SCHED;
            PG8_LDB(B0, 1, 0); PG8_LDB(B1, 1, 1); PG8_SCHED; PG8_LDA(At, 1, 0); PG8_STAGE(PG8_SA(0, 1), a2 + hstep, voffA);
            PG8_WAIT_V(8); PG8_WAIT_L(0); PG8_BAR; PG8_MMA(0, 0, At, B0); PG8_MMA(0, 1, At, B1); PG8_BAR; PG8_SCHED;
            PG8_LDA(At, 1, 1); PG8_STAGE(PG8_SB(1, 0), b3, voffB); PG8_STAGE(PG8_SB(1, 1), b3 + hstep, voffB); PG8_STAGE(PG8_SA(1, 0), a3, voffA);
            PG8_WAIT_V(8); PG8_WAIT_L(0); PG8_BAR; PG8_MMA(1, 0, At, B0); PG8_MMA(1, 1, At, B1); PG8_BAR; PG8_SCHED;
            } else {
            PG8_LDB(B0, 0, 0); PG8_SCHED; PG8_LDA(At, 0, 0); PG8_STAGE(PG8_SA(1, 1), a1 + hstep, voffA);
            PG8_WAIT_L(8); PG8_BAR; PG8_WAIT_L(0); PG8_MMA(0, 0, At, B0); PG8_BAR; PG8_SCHED;
            PG8_LDB(B1, 0, 1); PG8_STAGE(PG8_SB(0, 0), b2, voffB);
            PG8_BAR; PG8_WAIT_L(0); PG8_MMA(0, 1, At, B1); PG8_BAR;
            PG8_LDA(At, 0, 1); PG8_STAGE(PG8_SA(0, 0), a2, voffA);
            PG8_BAR; PG8_WAIT_L(0); PG8_MMA(1, 0, At, B0); PG8_BAR; PG8_SCHED;
            PG8_STAGE(PG8_SB(0, 1), b2 + hstep, voffB);
            PG8_WAIT_V(6); PG8_BAR; PG8_MMA(1, 1, At, B1); PG8_BAR;
            PG8_LDB(B0, 1, 0); PG8_SCHED; PG8_LDA(At, 1, 0); PG8_STAGE(PG8_SA(0, 1), a2 + hstep, voffA);
            PG8_WAIT_L(8); PG8_BAR; PG8_WAIT_L(0); PG8_MMA(0, 0, At, B0); PG8_BAR; PG8_SCHED;
            PG8_LDB(B1, 1, 1); PG8_STAGE(PG8_SB(1, 0), b3, voffB);
            PG8_BAR; PG8_WAIT_L(0); PG8_MMA(0, 1, At, B1); PG8_BAR;
            PG8_LDA(At, 1, 1); PG8_STAGE(PG8_SA(1, 0), a3, voffA);
            PG8_BAR; PG8_WAIT_L(0); PG8_MMA(1, 0, At, B0); PG8_BAR; PG8_SCHED;
            PG8_STAGE(PG8_SB(1, 1), b3 + hstep, voffB);
            PG8_WAIT_V(6); PG8_BAR; PG8_MMA(1, 1, At, B1); PG8_BAR;
            }
        }
        if constexpr (ALIGN_EPI) { if (wr == 0) PG8_BAR; }
        if constexpr (!Epi::AFTER_DRAIN) { E(acc, cur, wr, wc, fr, fq, ui); S.done(cur); }
        if (!has_next) break;
#pragma unroll
        for (int a = 0; a < 2; ++a)
#pragma unroll
            for (int b = 0; b < 2; ++b)
#pragma unroll
                for (int m = 0; m < 4; ++m)
#pragma unroll
                    for (int n = 0; n < 2; ++n) acc[a][b][m][n] = (f32x4){0.f, 0.f, 0.f, 0.f};
        cur = nxt; cA = nA; cB = nB; ++ui;
        if constexpr (Epi::PREP) E.prepare(cur, ui, tid);
        if constexpr (ALIGN_EPI) { if (wr == 1) PG8_BAR; }
    }
    PG8_WAIT_V(0);
    if constexpr (!ALIGN_EPI) { if (wr == 0) PG8_BAR; }
    PG8_BAR;
    if constexpr (Epi::AFTER_DRAIN) { E.fused(acc, cur, wr, wc, fr, fq, lds, wid, lane); S.done(cur); }
#undef PG8_SA
#undef PG8_SB
#undef PG8_STAGE
#undef PG8_LDA
#undef PG8_LDB
#undef PG8_MMA
#undef PG8_WAIT_V
#undef PG8_WAIT_L
#undef PG8_BAR
#undef PG8_SCHED
}
}
constexpr int NWAVES = 8;
constexpr int D = 1024, NB = 4, T = 4096, NL = 4, BS = 32, NS = 16, PAST = 1024, INW = 2560, NMEM = 256, DFF = 2816;
constexpr int MP = NB * T, MS = BS * NS, M = MP + MS;
constexpr float EPS = 1e-6f, LOG2E = 1.4426950408889634f;
constexpr float C_SB = 0.125f * LOG2E, C_MEM = 0.0625f * LOG2E;
constexpr float SB_EXIT = 0x1p-135f;
constexpr size_t MiB = 1u << 20;
constexpr size_t WS_CTL = 0, CTL_ZERO_BYTES = 1 * MiB;
constexpr size_t WS_WL = 2 * MiB, WL_STRIDE = 28 * MiB;
constexpr size_t WL_IN = 0, WL_OUT = 5 * MiB, WL_MQ = 7 * MiB, WL_MO = 9 * MiB, WL_GU = 11 * MiB, WL_DN = 22 * MiB;
constexpr size_t WS_WMKV = 114 * MiB, WS_MEMB = 130 * MiB, WS_MK = 132 * MiB, WS_MV = 140 * MiB, WS_SSQ = 148 * MiB, WS_SBSS = 150 * MiB;
constexpr size_t WS_XF = 152 * MiB, WS_XB = 218 * MiB, WS_U = 251 * MiB, WS_VA = 268 * MiB, WS_Q = 285 * MiB, WS_K = 302 * MiB, WS_V = 319 * MiB;
constexpr size_t WS_CAT = 336 * MiB, WS_QM = 369 * MiB, WS_OM = 402 * MiB, WS_H = 435 * MiB, WS_WT = 526 * MiB, WS_SASS = 527 * MiB, WS_END = 529 * MiB;
constexpr int CW_BAR = 4096, CW_SBQ = 8192;
constexpr int RING_OFF = 0, RING_BYTES = 131072, LDSCTL_OFF = RING_BYTES, MISC_OFF = LDSCTL_OFF + 320, AUX_OFF = LDSCTL_OFF + 1024, OST_OFF = AUX_OFF + 8192, LDS_BYTES = 163840;

#define GAS __attribute__((address_space(1)))
#define LAS __attribute__((address_space(3)))
typedef unsigned short bf16;
typedef unsigned v4u __attribute__((ext_vector_type(4)));
typedef unsigned v2u __attribute__((ext_vector_type(2)));
typedef float f32x4 __attribute__((ext_vector_type(4)));
typedef float f32x16 __attribute__((ext_vector_type(16)));
typedef short bf16x8 __attribute__((ext_vector_type(8)));
typedef short s16x4 __attribute__((ext_vector_type(4)));
typedef GAS unsigned gu32;
#define RLX_AGENT __ATOMIC_RELAXED, __HIP_MEMORY_SCOPE_AGENT
#define LDS_WAIT() asm volatile("s_waitcnt lgkmcnt(0)" ::: "memory")
#define VM_WAIT() asm volatile("s_waitcnt vmcnt(0)" ::: "memory")
__device__ __forceinline__ unsigned cvtpk(float lo, float hi) { unsigned r; asm volatile("v_cvt_pk_bf16_f32 %0, %1, %2" : "=v"(r) : "v"(lo), "v"(hi)); return r; }
__device__ __forceinline__ float bf_lo(unsigned w) { return __uint_as_float(w << 16); }
__device__ __forceinline__ float bf_hi(unsigned w) { return __uint_as_float(w & 0xffff0000u); }
__device__ __forceinline__ int lane_id() { int l_; asm volatile("v_mbcnt_lo_u32_b32 %0, -1, 0\n\tv_mbcnt_hi_u32_b32 %0, -1, %0" : "=v"(l_)); return l_; }
__device__ __forceinline__ int crow(int r, int hi) { return (r & 3) + 8 * (r >> 2) + 4 * hi; }
__device__ __forceinline__ s16x4 tr_read(unsigned addr) { return __builtin_bit_cast(s16x4, __builtin_amdgcn_ds_read_tr16_b64_v4i16((LAS s16x4*)(uintptr_t)addr)); }
using pg8::xl_sum16; using pg8::xl_sum_x16; using pg8::xl_sum_x32; using pg8::xl_max_x32; using pg8::xl_other_x32;
#define MFMA32(a, b, c) __builtin_amdgcn_mfma_f32_32x32x16_bf16((a), (b), (c), 0, 0, 0)

#ifndef REP_A
#define REP_A 1
#endif
#ifndef REP_B
#define REP_B 1
#endif
#ifndef REP_E
#define REP_E 1
#endif
#ifndef REP_F
#define REP_F 1
#endif
#ifndef REP_H
#define REP_H 1
#endif
#ifndef REP_P
#define REP_P 1
#endif
#ifndef REP_SGU
#define REP_SGU 1
#endif
#ifndef REP_SB
#define REP_SB 1
#endif
#define XB_TMO      128
#define XB_XCNT(j)  (256  + 64 * (j))
#define XB_XSUB(j)  (1280 + 64 * (j))
#define XB_XGEN(j)  (2304 + 64 * (j))
#define XB_TOP      3328
#define XB_TOPGEN   3392
#define XCD_BAR_WORDS 3456
#define XB_SPIN_CAP (1u << 18)

__device__ __forceinline__ unsigned xb_ld(unsigned* p)              { return __hip_atomic_load(p, __ATOMIC_RELAXED, __HIP_MEMORY_SCOPE_AGENT); }
__device__ __forceinline__ unsigned xb_add(unsigned* p, unsigned v) { return __hip_atomic_fetch_add(p, v, __ATOMIC_RELAXED, __HIP_MEMORY_SCOPE_AGENT); }
__device__ __forceinline__ unsigned xb_xcc_id() { return (unsigned)__builtin_amdgcn_s_getreg((3 << 11) | 20) & 0xFu; }
#define XB_SPIN(cond, bar) do { unsigned _sp = 0; while (cond) { __builtin_amdgcn_s_sleep(1); \
    if ((++_sp & 255u) == 0u) { if (xb_ld(&(bar)[XB_TMO])) break; if (_sp > XB_SPIN_CAP) { atomicAdd(&(bar)[XB_TMO], 1u); break; } } } } while (0)

struct XcdBarrier {
    unsigned* bar; unsigned x;
    volatile LAS unsigned* st;
};

__device__ __forceinline__ XcdBarrier xcd_barrier_post(unsigned* bar, volatile LAS unsigned* st, int tid) {
    XcdBarrier b; b.bar = bar; b.x = xb_xcc_id(); b.st = st;
    if (tid == 0) (void)xb_add(&bar[XB_XCNT(b.x)], 1u);
    return b;
}
__device__ __forceinline__ void xcd_barrier_complete(unsigned* bar, unsigned x, unsigned& nloc, unsigned& nx) {
    const unsigned G = gridDim.x * gridDim.y * gridDim.z;
    unsigned sum, cnt, mine, sp = 0u;
    for (;;) {
        sum = 0u; cnt = 0u; mine = 0u;
#pragma unroll
        for (unsigned j = 0; j < 16; ++j) { const unsigned c = xb_ld(&bar[XB_XCNT(j)]); sum += c; cnt += (c > 0u) ? 1u : 0u; mine = (j == x) ? c : mine; }
        if (sum == G) break;
        __builtin_amdgcn_s_sleep(1);
        if ((++sp & 255u) == 0u) { if (xb_ld(&bar[XB_TMO])) break; if (sp > XB_SPIN_CAP) { atomicAdd(&bar[XB_TMO], 1u); break; } }
    }
    nloc = mine > 0u ? mine : 1u; nx = cnt > 0u ? cnt : 1u;
}

__device__ __forceinline__ void xcd_barrier(const XcdBarrier& b, int tid) {
    asm volatile("s_waitcnt vmcnt(0)" ::: "memory");
    __syncthreads();
    if (tid == 0) {
        size_t bz_ = 0; unsigned bx = b.x; asm volatile("" : "+s"(bz_), "+s"(bx)); unsigned* bar = b.bar + bz_;
        __builtin_amdgcn_s_waitcnt(0);
        unsigned nloc = b.st[0], nx = b.st[1];
        if (nloc == 0u) { xcd_barrier_complete(bar, bx, nloc, nx); b.st[0] = nloc; b.st[1] = nx; }
        const unsigned old = xb_add(&bar[XB_XSUB(bx)], 1u);
        const unsigned gen = old / nloc;
        if (old + 1u == (gen + 1u) * nloc) {
            __builtin_amdgcn_fence(__ATOMIC_RELEASE, "agent");
            asm volatile("s_waitcnt vmcnt(0)" ::: "memory");
            const unsigned og = xb_add(&bar[XB_TOP], 1u);
            const unsigned tg = og / nx;
            if (og + 1u == (tg + 1u) * nx) xb_add(&bar[XB_TOPGEN], 1u);
            else XB_SPIN(xb_ld(&bar[XB_TOPGEN]) == tg, bar);
            __builtin_amdgcn_fence(__ATOMIC_ACQUIRE, "agent");
            xb_add(&bar[XB_XGEN(bx)], 1u);
            asm volatile("s_waitcnt vmcnt(0)" ::: "memory");
        } else {
            XB_SPIN(xb_ld(&bar[XB_XGEN(bx)]) == gen, bar);
            __builtin_amdgcn_fence(__ATOMIC_ACQUIRE, "agent");
            asm volatile("s_waitcnt vmcnt(0)" ::: "memory");
        }
    }
    __syncthreads();
}


struct Frame {
    LAS unsigned char* lds; unsigned lds0;
    int wave, G, bid;
};
struct Args {
    const float* in[25]; float* out; unsigned char* ws; int ph_lo, ph_hi;
};
__device__ __forceinline__ float* out_y_p(float* o) { return o; }
__device__ __forceinline__ float* out_y_s(float* o) { return o + (size_t)MP * D; }
__device__ __forceinline__ float* out_sbk_p(float* o) { return o + (size_t)M * D; }
__device__ __forceinline__ float* out_sbv_p(float* o) { return out_sbk_p(o) + (size_t)NL * MP * 512; }
__device__ __forceinline__ float* out_mk_p(float* o) { return out_sbv_p(o) + (size_t)NL * MP * 512; }
__device__ __forceinline__ float* out_mv_p(float* o) { return out_mk_p(o) + (size_t)NL * NB * NMEM * D; }
__device__ __forceinline__ float* out_sbk_s(float* o) { return out_mv_p(o) + (size_t)NL * NB * NMEM * D; }
__device__ __forceinline__ float* out_sbv_s(float* o) { return out_sbk_s(o) + (size_t)NL * MS * 512; }
__device__ __forceinline__ float* out_sguv_s(float* o) { return out_sbv_s(o) + (size_t)NL * MS * 512; }

struct TrItem { const float* src; const float* gain; bf16* dst; int ldw, ldd; };
__device__ __forceinline__ TrItem tr_decode(const Args& a, unsigned char* ws, int it) {
    constexpr int I_IN = 640, I_SQ = 256, I_G = 704, I_L = I_IN + 3 * I_SQ + 3 * I_G + 2 * I_SQ;
    const int l = it / I_L; int r = it % I_L; unsigned char* wl = ws + WS_WL + (size_t)l * WL_STRIDE; TrItem t;
    if (r < I_IN) { const int kb = r / 40, nb = r % 40; t.src = a.in[8] + (size_t)l * D * INW + (size_t)(kb * 64) * INW + nb * 64; t.ldw = INW; t.gain = a.in[7] + l * D + kb * 64; t.dst = (bf16*)(wl + WL_IN) + (size_t)(nb * 64) * D + kb * 64; t.ldd = D; return t; } r -= I_IN;
    if (r < I_SQ) { const int kb = r / 16, nb = r % 16; const int ks = (kb * 64 + 512) & 1023;
        t.src = a.in[14] + (size_t)l * D * D + (size_t)ks * D + nb * 64; t.ldw = D; t.gain = ks < 512 ? a.in[12] + l * 512 + ks : a.in[13] + l * 512 + (ks - 512); t.dst = (bf16*)(wl + WL_OUT) + (size_t)(nb * 64) * D + kb * 64; t.ldd = D; return t; } r -= I_SQ;
    if (r < I_SQ) { const int kb = r / 16, nb = r % 16; t.src = a.in[16] + (size_t)l * D * D + (size_t)(kb * 64) * D + nb * 64; t.ldw = D; t.gain = a.in[15] + l * D + kb * 64; t.dst = (bf16*)(wl + WL_MQ) + (size_t)(nb * 64) * D + kb * 64; t.ldd = D; return t; } r -= I_SQ;
    if (r < I_SQ) { const int kb = r / 16, nb = r % 16; t.src = a.in[19] + (size_t)l * D * D + (size_t)(kb * 64) * D + nb * 64; t.ldw = D; t.gain = nullptr; t.dst = (bf16*)(wl + WL_MO) + (size_t)(nb * 64) * D + kb * 64; t.ldd = D; return t; } r -= I_SQ;
    if (r < 2 * I_G) { const int up = r >= I_G; if (up) r -= I_G; const int kb = r / 44, nb = r % 44; const int j0 = nb * 64;
        t.src = a.in[up ? 22 : 21] + (size_t)l * D * DFF + (size_t)(kb * 64) * DFF + j0; t.ldw = DFF; t.gain = a.in[20] + l * D + kb * 64; t.dst = (bf16*)(wl + WL_GU) + (size_t)(256 * (j0 >> 7) + (up ? 128 : 0) + (j0 & 127)) * D + kb * 64; t.ldd = D; return t; } r -= 2 * I_G;
    if (r < I_G) { const int kb = r / 16, nb = r % 16; t.src = a.in[23] + (size_t)l * DFF * D + (size_t)(kb * 64) * D + nb * 64; t.ldw = D; t.gain = nullptr; t.dst = (bf16*)(wl + WL_DN) + (size_t)(nb * 64) * DFF + kb * 64; t.ldd = DFF; return t; } r -= I_G;
    { const int isv = r >= I_SQ; if (isv) r -= I_SQ; const int kb = r / 16, nb = r % 16;
      t.src = a.in[isv ? 18 : 17] + (size_t)l * D * D + (size_t)(kb * 64) * D + nb * 64; t.ldw = D; t.gain = nullptr; t.dst = (bf16*)(ws + WS_WMKV) + (size_t)((l * 2 + isv) * 1024 + nb * 64) * D + kb * 64; t.ldd = D; return t; }
}
__device__ __forceinline__ void tr_load(const TrItem& t, f32x4 (&v)[16], f32x4 (&g)[2], int lane) {
    const int kr0 = lane >> 4, nc = (lane & 15) * 4;
#pragma unroll
    for (int i = 0; i < 16; ++i) v[i] = *(const GAS f32x4*)((const GAS float*)t.src + (unsigned)((kr0 + 4 * i) * t.ldw + nc));
    const f32x4 one = (f32x4){1.f, 1.f, 1.f, 1.f};
    g[0] = t.gain ? *(const f32x4*)(t.gain + 8 * (lane & 7)) : one; g[1] = t.gain ? *(const f32x4*)(t.gain + 8 * (lane & 7) + 4) : one;
}
__device__ __forceinline__ void tr_store(const TrItem& t, const f32x4 (&v)[16], const f32x4 (&g)[2], LAS float* scr, int lane) {
    const int kr0 = lane >> 4, nc = (lane & 15) * 4;
#pragma unroll
    for (int i = 0; i < 16; ++i) { const int kr = kr0 + 4 * i; LAS float* p = scr + kr * 64; const f32x4 x = v[i];
        p[(nc + 0) ^ (kr & 31)] = x[0]; p[(nc + 1) ^ (kr & 31)] = x[1]; p[(nc + 2) ^ (kr & 31)] = x[2]; p[(nc + 3) ^ (kr & 31)] = x[3]; }
    LDS_WAIT(); asm volatile("" ::: "memory");
    const int c = lane & 7;
#pragma unroll
    for (int j = 0; j < 8; ++j) { const int n = (lane >> 3) + 8 * j; float s[8];
#pragma unroll
        for (int i = 0; i < 8; ++i) s[i] = scr[(8 * c + i) * 64 + (n ^ ((8 * c + i) & 31))] * g[i >> 2][i & 3];
        v4u o; o.x = cvtpk(s[0], s[1]); o.y = cvtpk(s[2], s[3]); o.z = cvtpk(s[4], s[5]); o.w = cvtpk(s[6], s[7]);
        *(GAS v4u*)((GAS bf16*)t.dst + (unsigned)(n * t.ldd + 8 * c)) = o; }
    LDS_WAIT(); asm volatile("" ::: "memory");
}
template <bool PRO> __device__ __forceinline__ int cv_item(int l, int j) { return PRO ? (j < 4032 ? j : 4032 * (1 + (j - 4032) / 512) + 3520 + (j - 4032) % 512) : l * 4032 + j; }
template <bool PRO> __device__ __forceinline__ void convert_items(const Args& a, const Frame& F, int l, int gw, int ngw, int lo, int hi) {
    LAS float* scr = (LAS float*)(F.lds + RING_OFF + F.wave * 16384); unsigned char* ws = a.ws; const int lane = lane_id();
#pragma unroll 1
    for (int j = lo + gw; j < hi; j += ngw) { const TrItem cur = tr_decode(a, ws, cv_item<PRO>(l, j)); f32x4 v[16], g[2]; tr_load(cur, v, g, lane); tr_store(cur, v, g, scr, lane); }
}
__device__ __forceinline__ void prologue(const Args& a, const Frame& F) {
    LAS float* scr = (LAS float*)(F.lds + RING_OFF + F.wave * 16384);
    const int gw = F.bid * NWAVES + F.wave, NGW = F.G * NWAVES;
    unsigned char* ws = a.ws;
    convert_items<true>(a, F, 0, gw, NGW, 0, 4032 + (NL - 1) * 512);
    bf16* XB = (bf16*)(ws + WS_XB); float* SSQ = (float*)(ws + WS_SSQ);
    for (int m0 = gw; m0 < M; m0 += 3 * NGW) {
        f32x4 v[3][4];
#pragma unroll
        for (int k = 0; k < 3; ++k) { int m = m0 + k * NGW; m = m < M ? m : M - 1;
            const float* src = m < MP ? a.in[0] + (size_t)m * D : a.in[1] + (size_t)(m - MP) * D;
#pragma unroll
            for (int j = 0; j < 4; ++j) v[k][j] = ((const f32x4*)src)[lane_id() + 64 * j]; }
#pragma unroll
        for (int k = 0; k < 3; ++k) asm volatile("" : "+v"(v[k][0]), "+v"(v[k][1]), "+v"(v[k][2]), "+v"(v[k][3]));
#pragma unroll
        for (int k = 0; k < 3; ++k) { const int m = m0 + k * NGW;
            if (m < M) { float s = 0.f;
#pragma unroll
                for (int j = 0; j < 4; ++j) s += (v[k][j][0] * v[k][j][0] + v[k][j][1] * v[k][j][1]) + (v[k][j][2] * v[k][j][2] + v[k][j][3] * v[k][j][3]);
                s = xl_sum_x32(xl_sum_x16(xl_sum16(s)));
#pragma unroll
                for (int j = 0; j < 4; ++j) { v2u w; w.x = cvtpk(v[k][j][0], v[k][j][1]); w.y = cvtpk(v[k][j][2], v[k][j][3]); ((v2u*)(XB + (size_t)m * D))[lane_id() + 64 * j] = w; }
                if (lane_id() < 16) SSQ[(size_t)m * 16 + lane_id()] = lane_id() == 0 ? s : 0.f; } }
    }
    { bf16* WT = (bf16*)(ws + WS_WT); const int gt = F.bid * 512 + (F.wave * 64 + lane_id()), NT = F.G * 512;
      for (int i = gt; i < NL * 2 * 4 * 128 * 128; i += NT) { const int s = i & 127, t = (i >> 7) & 127, g = (i >> 14) & 3, var = (i >> 16) & 1, l = i >> 17;
          const float* W = a.in[10] + (size_t)(l * 4 + g) * 128 * 128; float v;
          if (var == 0) v = s <= t ? W[t * 128 + s] : 0.f; else v = ((t >> 4) == (s >> 4) && (s & 15) <= (t & 15)) ? W[(t & 15) * 128 + (s & 15)] : 0.f;
          WT[(size_t)(i >> 14) * 16384 + ((((t >> 5) * 8 + (s >> 4)) * 32 + (t & 31)) * 16 + (s & 15))] = (bf16)(cvtpk(v, 0.f) & 0xffffu); } }
    { const f32x4* src = (const f32x4*)a.in[6]; v2u* dst = (v2u*)(ws + WS_MEMB); const int gt = F.bid * 512 + (F.wave * 64 + lane_id()), NT = F.G * 512;
      for (int i = gt; i < NB * NMEM * D / 4; i += NT) { const f32x4 v = src[i]; v2u w; w.x = cvtpk(v[0], v[1]); w.y = cvtpk(v[2], v[3]); dst[i] = w; } }
}

__device__ __forceinline__ void sgu_unit(const Args& a, const Frame& F, int l, int unit) {
    unsigned char* ws = a.ws;
    const bf16* VA = (const bf16*)(ws + WS_VA); const bf16* U = (const bf16*)(ws + WS_U); bf16* CAT = (bf16*)(ws + WS_CAT); float* SASS = (float*)(ws + WS_SASS);
    const int c = unit >> 1, gp = unit & 1; const bool smp = c >= 128; const int R0 = smp ? MP + 128 * (c - 128) : 128 * c;
    const float* gv = a.in[9] + l * 512; const float* bl = a.in[11] + l * 512;
    float* sguv = out_sguv_s(a.out) + (size_t)l * MS * 512;
    int tid_ = F.wave * 64 + lane_id(); asm volatile("" : "+v"(tid_));
    const int tid = tid_, lane = tid & 63, w = F.wave;
    const int gl = w >> 2, nb = w & 3, g = 2 * gp + gl, r32 = lane & 31, hi = lane >> 5;
    const int g4 = lane >> 4, cb = g4 & 1, q4 = (lane & 15) >> 2, p4 = lane & 3;
    const bf16* WT = (const bf16*)(ws + WS_WT) + (size_t)((l * 2 + (smp ? 1 : 0)) * 4 + g) * 16384 + r32 * 16 + hi * 8;
    bf16x8 wfr[20]; float bias[4];
    { int n = 0;
#pragma unroll
      for (int ks = 0; ks < 8; ++ks)
#pragma unroll
          for (int i = 0; i < 4; ++i) { if (ks > 2 * i + 1) continue; wfr[n++] = __builtin_bit_cast(bf16x8, *(const GAS v4u*)(WT + (i * 8 + ks) * 512)); } }
#pragma unroll
    for (int i = 0; i < 4; ++i) { const int t = 32 * i + r32; bias[i] = bl[g * 128 + (smp ? (t & 15) : t)]; }
    f32x4 g0, g1; { const int ch = tid & 31, col = (2 * gp + (ch >> 4)) * 128 + (ch & 15) * 8; g0 = *(const f32x4*)(gv + col); g1 = *(const f32x4*)(gv + col + 4); }
    v4u uraw[8];
#pragma unroll
    for (int i = 0; i < 8; ++i) { const int cc = tid + 512 * i, row = cc >> 5, ch = cc & 31; uraw[i] = *(const GAS v4u*)(U + (size_t)(R0 + row) * 512 + 2 * gp * 128 + ch * 8); }
    v4u raws[8];
#pragma unroll
    for (int i = 0; i < 8; ++i) { const int cc = tid + 512 * i, row = cc >> 5, ch = cc & 31; raws[i] = *(const GAS v4u*)(VA + (size_t)(R0 + row) * 512 + (2 * gp + (ch >> 4)) * 128 + (ch & 15) * 8); }
    asm volatile("" : "+v"(raws[0]), "+v"(raws[1]), "+v"(raws[2]), "+v"(raws[3]), "+v"(raws[4]), "+v"(raws[5]), "+v"(raws[6]), "+v"(raws[7]));
    asm volatile("" : "+v"(wfr[0]), "+v"(wfr[1]), "+v"(wfr[2]), "+v"(wfr[3]), "+v"(wfr[4]));
    asm volatile("" : "+v"(wfr[5]), "+v"(wfr[6]), "+v"(wfr[7]), "+v"(wfr[8]), "+v"(wfr[9]));
    asm volatile("" : "+v"(wfr[10]), "+v"(wfr[11]), "+v"(wfr[12]), "+v"(wfr[13]), "+v"(wfr[14]));
    asm volatile("" : "+v"(wfr[15]), "+v"(wfr[16]), "+v"(wfr[17]), "+v"(wfr[18]), "+v"(wfr[19]));
    asm volatile("" : "+v"(uraw[0]), "+v"(uraw[1]), "+v"(uraw[2]), "+v"(uraw[3]), "+v"(uraw[4]), "+v"(uraw[5]), "+v"(uraw[6]), "+v"(uraw[7]));
    asm volatile("" : "+v"(bias[0]), "+v"(bias[1]), "+v"(bias[2]), "+v"(bias[3]), "+v"(g0), "+v"(g1));
#pragma unroll
    for (int i = 0; i < 8; ++i) { const int cc = tid + 512 * i, row = cc >> 5, ch = cc & 31; *(LAS v4u*)(F.lds + 65536 + row * 512 + ((ch ^ (row & 31)) << 4)) = uraw[i]; }
#pragma unroll
    for (int i = 0; i < 8; ++i) { const int cc = tid + 512 * i, row = cc >> 5, ch = cc & 31, gl = ch >> 4, c16 = ch & 15, col = (2 * gp + gl) * 128 + c16 * 8;
        const v4u raw = raws[i];
        float x[8] = {bf_lo(raw.x), bf_hi(raw.x), bf_lo(raw.y), bf_hi(raw.y), bf_lo(raw.z), bf_hi(raw.z), bf_lo(raw.w), bf_hi(raw.w)};
        float ss = 0.f;
#pragma unroll
        for (int j = 0; j < 8; ++j) ss += x[j] * x[j];
        ss = xl_sum16(ss);
        const float rstd = __builtin_amdgcn_rsqf(ss * (1.0f / 128.0f) + EPS);
        f32x4 y0, y1;
#pragma unroll
        for (int j = 0; j < 4; ++j) { y0[j] = x[j] * rstd * g0[j]; y1[j] = x[4 + j] * rstd * g1[j]; }
        if (smp) { float* o = sguv + (size_t)(R0 - MP + row) * 512 + col; *(f32x4*)o = y0; *(f32x4*)(o + 4) = y1; }
        v4u pk; pk.x = cvtpk(y0[0], y0[1]); pk.y = cvtpk(y0[2], y0[3]); pk.z = cvtpk(y1[0], y1[1]); pk.w = cvtpk(y1[2], y1[3]);
        *(LAS v4u*)(F.lds + gl * 32768 + row * 256 + ((((c16 >> 2) ^ (row & 3)) << 2) | (c16 & 3)) * 16) = pk; }
    __syncthreads();
#ifdef TPROBE
    if (F.wave == 0 && lane == 0) { volatile LAS unsigned* tc = (volatile LAS unsigned*)(F.lds + MISC_OFF + 64); const unsigned now_ = (unsigned)__builtin_amdgcn_s_memrealtime(); tc[27] += now_ - tc[32]; tc[32] = now_; }
#endif
    const int colb = (nb * 32 + 16 * cb + 4 * p4) * 2;
    const unsigned tb = F.lds0 + gl * 32768 + (8 * hi + q4) * 256 + ((((colb >> 6) ^ q4) << 6) | (colb & 63));
    f32x16 acc[4];
#pragma unroll
    for (int i = 0; i < 4; ++i)
#pragma unroll
        for (int r = 0; r < 16; ++r) acc[i][r] = 0.f;
    { int n = 0;
#pragma unroll
      for (int ks = 0; ks < 8; ++ks) {
        const s16x4 a0 = tr_read(tb + ks * 16 * 256), a1 = tr_read(tb + ks * 16 * 256 + 4 * 256);
        const bf16x8 af = (bf16x8){a0[0], a0[1], a0[2], a0[3], a1[0], a1[1], a1[2], a1[3]};
#pragma unroll
        for (int i = 0; i < 4; ++i) { if (ks > 2 * i + 1) continue; acc[i] = MFMA32(af, wfr[n++], acc[i]); }
      } }
#ifdef TPROBE
    if (F.wave == 0 && lane == 0) { volatile LAS unsigned* tc = (volatile LAS unsigned*)(F.lds + MISC_OFF + 64); const unsigned now_ = (unsigned)__builtin_amdgcn_s_memrealtime(); tc[28] += now_ - tc[32]; tc[32] = now_; }
#endif
#pragma unroll
    for (int i = 0; i < 4; ++i) { const int t = 32 * i + r32; const float bs_ = bias[i];
        const size_t rowoff = (size_t)(R0 + t); float ss = 0.f;
#pragma unroll
        for (int k = 0; k < 4; ++k) { const int e = g * 128 + nb * 32 + 8 * k + 4 * hi; const v2u u2 = *(const LAS v2u*)(F.lds + 65536 + t * 512 + (((gl * 16 + nb * 4 + k) ^ r32) << 4) + 8 * hi);
            const float v0 = bf_lo(u2.x) * (acc[i][4 * k] + bs_), v1 = bf_hi(u2.x) * (acc[i][4 * k + 1] + bs_), v2 = bf_lo(u2.y) * (acc[i][4 * k + 2] + bs_), v3 = bf_hi(u2.y) * (acc[i][4 * k + 3] + bs_);
            ss += (v0 * v0 + v1 * v1) + (v2 * v2 + v3 * v3);
            v2u o; o.x = cvtpk(v0, v1); o.y = cvtpk(v2, v3); *(GAS v2u*)(CAT + rowoff * 1024 + 512 + e) = o; }
        ss = xl_sum_x32(ss);
        SASS[rowoff * 16 + g * 4 + nb] = ss; }
    __syncthreads();
}

__device__ __forceinline__ float vmin126(float x) { float r; asm("v_min_f32 %0, 0x42fc0000, %1" : "=v"(r) : "v"(x)); return r; }
template <bool SMP> __device__ __forceinline__ void sb_unit(const Args& a, const Frame& F, int l, int uidx) {
    unsigned char* ws = a.ws;
    const bf16* Qb = (const bf16*)(ws + WS_Q); const bf16* Kb = (const bf16*)(ws + WS_K); const bf16* Vb = (const bf16*)(ws + WS_V);
    bf16* CAT = (bf16*)(ws + WS_CAT); float* SBSS = (float*)(ws + WS_SBSS);
    int lane_ = lane_id(); asm volatile("" : "+v"(lane_));
    const int lane = lane_, r32 = lane & 31, hi = lane >> 5;
    int h, rowq0, nq, krow0 = 0, bs = 0, t0 = 0, jt;
    if (!SMP) { const int tb = uidx & 127, bh = uidx >> 7; h = bh & 7; const int b = bh >> 3; t0 = 32 * tb; rowq0 = b * T + t0; krow0 = b * T; nq = 32; jt = t0 >> 6; }
    else { h = uidx & 7; bs = uidx >> 3; rowq0 = MP + bs * NS; nq = NS; jt = PAST / 64; }
    const int tq = SMP ? PAST + (r32 < NS ? r32 : NS - 1) : t0 + r32;
    const float* ck = a.in[2] + ((size_t)(l * BS + bs) * PAST) * 512 + h * 64; const float* cv = a.in[3] + ((size_t)(l * BS + bs) * PAST) * 512 + h * 64;
    bf16x8 qf[4];
#pragma unroll
    for (int d0 = 0; d0 < 4; ++d0) qf[d0] = __builtin_bit_cast(bf16x8, *(const GAS v4u*)(Qb + (size_t)(rowq0 + (r32 < nq ? r32 : nq - 1)) * 512 + h * 64 + d0 * 16 + hi * 8));
    f32x16 o[2];
#pragma unroll
    for (int r = 0; r < 16; ++r) { o[0][r] = 0.f; o[1][r] = 0.f; }
    float R = 1.0f;
    LAS unsigned char* vt = F.lds + F.wave * 16384;
    LAS unsigned char* kt = vt + 8192;
    const unsigned vt0 = F.lds0 + F.wave * 16384;
    const int g4 = lane >> 4, cb = g4 & 1, q4 = (lane & 15) >> 2, p4 = lane & 3;
    v4u kn[8], vn[8];
    if (!SMP) {
#pragma unroll
        for (int i = 0; i < 8; ++i) { const GAS unsigned char* kb_ = (const GAS unsigned char*)(Kb + (size_t)(krow0 + 64 * jt) * 512 + h * 64); const GAS unsigned char* vb_ = (const GAS unsigned char*)(Vb + (size_t)(krow0 + 64 * jt) * 512 + h * 64);
            const unsigned lo_ = (unsigned)((lane >> 3) * 1024 + (lane & 7) * 16 + i * 8192);
            kn[i] = *(const GAS v4u*)(kb_ + lo_); vn[i] = *(const GAS v4u*)(vb_ + lo_); }
    }
    for (; jt >= 0; --jt) {
        bf16x8 kf[2][4];
        if (!SMP) {
            {
                const int r0_ = lane >> 3, ch_ = lane & 7;
                LAS unsigned char* kw_ = kt + r0_ * 128 + ((ch_ ^ (r0_ & 7)) << 4); LAS unsigned char* vw_ = vt + r0_ * 128 + (((((ch_ >> 2) ^ ((r0_ >> 1) & 1)) << 2) | (ch_ & 3)) << 4);
#pragma unroll
                for (int i = 0; i < 8; ++i) { *(LAS v4u*)(kw_ + i * 1024) = kn[i]; *(LAS v4u*)(vw_ + i * 1024) = vn[i]; } }
#pragma unroll
            for (int mb = 0; mb < 2; ++mb)
#pragma unroll
                for (int d0 = 0; d0 < 4; ++d0) kf[mb][d0] = *(const LAS bf16x8*)(kt + (32 * mb + r32) * 128 + (((2 * d0 + hi) ^ (r32 & 7)) << 4));
        } else if (jt == PAST / 64) {
#pragma unroll
            for (int mb = 0; mb < 2; ++mb) { const int kv = 32 * mb + r32;
                const bf16* kp = Kb + (size_t)(MP + bs * NS + (kv < NS ? kv : NS - 1)) * 512 + h * 64 + hi * 8;
#pragma unroll
                for (int d0 = 0; d0 < 4; ++d0) kf[mb][d0] = __builtin_bit_cast(bf16x8, *(const GAS v4u*)(kp + d0 * 16)); }
#pragma unroll
            for (int i = 0; i < 8; ++i) { const int c = lane + 64 * i, row = c >> 3, ch = c & 7;
                const v4u v = *(const GAS v4u*)(Vb + (size_t)(MP + bs * NS + (row < NS ? row : NS - 1)) * 512 + h * 64 + ch * 8);
                *(LAS v4u*)(vt + row * 128 + (((((ch >> 2) ^ ((row >> 1) & 1)) << 2) | (ch & 3)) << 4)) = v; }
        } else {
#pragma unroll
            for (int mb = 0; mb < 2; ++mb) { const float* kp = ck + (size_t)(64 * jt + 32 * mb + r32) * 512 + hi * 8;
#pragma unroll
                for (int d0 = 0; d0 < 4; ++d0) { const f32x4 x0 = *(const f32x4*)(kp + d0 * 16), x1 = *(const f32x4*)(kp + d0 * 16 + 4);
                    v4u v; v.x = cvtpk(x0[0], x0[1]); v.y = cvtpk(x0[2], x0[3]); v.z = cvtpk(x1[0], x1[1]); v.w = cvtpk(x1[2], x1[3]); kf[mb][d0] = __builtin_bit_cast(bf16x8, v); } }
#pragma unroll
            for (int i = 0; i < 8; ++i) { const int c = lane + 64 * i, row = c >> 3, ch = c & 7; const float* vp = cv + (size_t)(64 * jt + row) * 512 + ch * 8;
                const f32x4 x0 = *(const f32x4*)vp, x1 = *(const f32x4*)(vp + 4);
                v4u v; v.x = cvtpk(x0[0], x0[1]); v.y = cvtpk(x0[2], x0[3]); v.z = cvtpk(x1[0], x1[1]); v.w = cvtpk(x1[2], x1[3]);
                *(LAS v4u*)(vt + row * 128 + (((((ch >> 2) ^ ((row >> 1) & 1)) << 2) | (ch & 3)) << 4)) = v; }
        }
        f32x16 p0, p1;
#pragma unroll
        for (int r = 0; r < 16; ++r) { p0[r] = 0.f; p1[r] = 0.f; }
#pragma unroll
        for (int d0 = 0; d0 < 4; ++d0) { p0 = MFMA32(kf[0][d0], qf[d0], p0); p1 = MFMA32(kf[1][d0], qf[d0], p1); }
        const bool diag = SMP ? (jt == PAST / 64) : (64 * jt + 63 >= t0);
        if (diag) {
#pragma unroll
            for (int r = 0; r < 16; ++r) { const int kp = 64 * jt + crow(r, hi); if (kp >= tq) p0[r] = -1e30f; if (kp + 32 >= tq) p1[r] = -1e30f; } }
        float cw[32];
#pragma unroll
        for (int r = 0; r < 16; ++r) { p0[r] = __builtin_amdgcn_exp2f(vmin126(p0[r])); p1[r] = __builtin_amdgcn_exp2f(vmin126(p1[r]));
            cw[r] = __builtin_amdgcn_rcpf(1.0f + p0[r]); cw[16 + r] = __builtin_amdgcn_rcpf(1.0f + p1[r]); }
        float gs[8], oth[8];
#pragma unroll
        for (int gq = 0; gq < 8; ++gq) { cw[4 * gq + 2] *= cw[4 * gq + 3]; cw[4 * gq + 1] *= cw[4 * gq + 2]; cw[4 * gq] *= cw[4 * gq + 1]; gs[gq] = cw[4 * gq]; }
#pragma unroll
        for (int gq = 0; gq < 8; ++gq) oth[gq] = xl_other_x32(gs[gq], hi);
        float off[8]; float tail = R;
#pragma unroll
        for (int gq = 7; gq >= 0; --gq) { off[gq] = hi == 0 ? tail * oth[gq] : tail; tail *= gs[gq] * oth[gq]; }
        R = tail;
#pragma unroll
        for (int r = 0; r < 16; ++r) { p0[r] = p0[r] * cw[r] * off[r >> 2]; p1[r] = p1[r] * cw[16 + r] * off[4 + (r >> 2)]; }
        const bool last = __all(((r32 < nq) ? R : 0.f) < SB_EXIT) || jt == 0;
        if (!SMP && !last) { const int jn = jt - 1;
#pragma unroll
            for (int i = 0; i < 8; ++i) { const GAS unsigned char* kb_ = (const GAS unsigned char*)(Kb + (size_t)(krow0 + 64 * jn) * 512 + h * 64); const GAS unsigned char* vb_ = (const GAS unsigned char*)(Vb + (size_t)(krow0 + 64 * jn) * 512 + h * 64);
                const unsigned lo_ = (unsigned)((lane >> 3) * 1024 + (lane & 7) * 16 + i * 8192);
                kn[i] = *(const GAS v4u*)(kb_ + lo_); vn[i] = *(const GAS v4u*)(vb_ + lo_); } }
        unsigned pk[16];
#pragma unroll
        for (int i = 0; i < 8; ++i) { pk[i] = cvtpk(p0[2 * i], p0[2 * i + 1]); pk[8 + i] = cvtpk(p1[2 * i], p1[2 * i + 1]); }
#pragma unroll
        for (int ks = 0; ks < 4; ++ks) { const bf16x8 pf = __builtin_bit_cast(bf16x8, (v4u){pk[4 * ks], pk[4 * ks + 1], pk[4 * ks + 2], pk[4 * ks + 3]});
#pragma unroll
            for (int nb = 0; nb < 2; ++nb) { const unsigned ad0 = vt0 + (16 * ks + 4 * hi + q4) * 128 + ((nb ^ ((q4 >> 1) & 1)) << 6) + (16 * cb + 4 * p4) * 2, ad1 = ad0 + 8 * 128;
                const s16x4 b0 = tr_read(ad0), b1 = tr_read(ad1);
                const bf16x8 vf = (bf16x8){b0[0], b0[1], b0[2], b0[3], b1[0], b1[1], b1[2], b1[3]};
                o[nb] = MFMA32(pf, vf, o[nb]); } }
#ifdef TPROBE
        if (F.wave == 0 && lane == 0) { volatile LAS unsigned* tc = (volatile LAS unsigned*)(F.lds + MISC_OFF + 64); tc[SMP ? 14 : 12] += 100u; }
#endif
        if (last) break;
    }
    float ssq[16];
#pragma unroll
    for (int r = 0; r < 16; ++r) { ssq[r] = o[0][r] * o[0][r] + o[1][r] * o[1][r];
        ssq[r] = xl_sum_x16(xl_sum16(ssq[r])); }
#pragma unroll
    for (int r = 0; r < 16; ++r) { if (SMP && r >= 8) continue;
        const int q = crow(r, hi);
        *(LAS bf16*)(vt + q * 128 + r32 * 2) = (bf16)(cvtpk(o[0][r], 0.f) & 0xffffu); *(LAS bf16*)(vt + q * 128 + 64 + r32 * 2) = (bf16)(cvtpk(o[1][r], 0.f) & 0xffffu);
        SBSS[(size_t)(rowq0 + q) * 8 + h] = ssq[r]; }
#pragma unroll
    for (int i = 0; i < 4; ++i) { if (SMP && i >= 2) continue; const int ch = lane + 64 * i, row = ch >> 3, cp = ch & 7;
        const v4u v = *(const LAS v4u*)(vt + row * 128 + cp * 16); *(GAS v4u*)(CAT + (size_t)(rowq0 + row) * 1024 + h * 64 + cp * 8) = v; }
}

template <bool SMP> __device__ __forceinline__ void mem_unit(const Args& a, const Frame& F, int l, int uidx) {
    unsigned char* ws = a.ws;
    const bf16* QM = (const bf16*)(ws + WS_QM); bf16* OM = (bf16*)(ws + WS_OM);
    int tid_ = F.wave * 64 + lane_id(); asm volatile("" : "+v"(tid_));
    const int tid = tid_, lane = tid & 63, r32 = lane & 31, hi = lane >> 5;
    int h, rowq0, nq, b;
    if (!SMP) { const int qb = uidx & 15, bh = uidx >> 4; h = bh & 3; b = bh >> 2; rowq0 = b * T + 256 * qb + 32 * F.wave; nq = 32; }
    else { h = uidx & 3; b = uidx >> 2; rowq0 = MP + b * NS; nq = NS; }
    const bool active = !SMP || F.wave == 0;
    bf16x8 qf[16];
    { const bf16* qp = QM + (size_t)((rowq0 >> 5) * 4 + h) * 8192 + (r32 * 2 + hi) * 8;
#pragma unroll
      for (int d0 = 0; d0 < 16; ++d0) qf[d0] = __builtin_bit_cast(bf16x8, *(const GAS v4u*)(qp + d0 * 512)); }
    if (!SMP) { const bf16* src = (const bf16*)(ws + WS_MK) + (size_t)(l * 4 + b) * 256 * 1024 + h * 256;
#pragma unroll
        for (int i = 0; i < 16; ++i) { const int j = F.wave * 16 + i, key = 2 * j + (lane >> 5), ch = (lane & 31) ^ (key & 31);
            __builtin_amdgcn_global_load_lds((const GAS unsigned*)(src + (size_t)key * 1024 + ch * 8), (LAS unsigned*)(F.lds + j * 1024), 16, 0, 0); }
        VM_WAIT(); }
    else { const float* src = a.in[4] + (size_t)(l * BS + b) * NMEM * D + h * 256;
#pragma unroll 8
        for (int i = 0; i < 16; ++i) { const int c = tid + 512 * i, key = c >> 5, ch = c & 31;
            const f32x4 x0 = *(const f32x4*)(src + (size_t)key * 1024 + ch * 8), x1 = *(const f32x4*)(src + (size_t)key * 1024 + ch * 8 + 4);
            v4u v; v.x = cvtpk(x0[0], x0[1]); v.y = cvtpk(x0[2], x0[3]); v.z = cvtpk(x1[0], x1[1]); v.w = cvtpk(x1[2], x1[3]);
            *(LAS v4u*)(F.lds + key * 512 + ((ch ^ (key & 31)) << 4)) = v; } }
    __syncthreads();
#ifdef TPROBE
#define MSTAMP(k) do { if (!SMP && F.wave == 0 && lane == 0) { volatile LAS unsigned* tc = (volatile LAS unsigned*)(F.lds + MISC_OFF + 64); const unsigned now_ = (unsigned)__builtin_amdgcn_s_memrealtime(); tc[(k)] += now_ - tc[32]; tc[32] = now_; } } while (0)
#else
#define MSTAMP(k) do { } while (0)
#endif
    MSTAMP(29);
    f32x16 s[8]; unsigned pk[8][8]; float inv[16];
#pragma unroll
    for (int kb = 0; kb < 8; ++kb)
#pragma unroll
        for (int r = 0; r < 16; ++r) s[kb][r] = 0.f;
    { const int xb = r32 ^ hi;
#pragma unroll
      for (int d0 = 0; d0 < 16; ++d0) {
          LAS unsigned char* kp = F.lds + r32 * 512 + ((xb ^ (2 * d0)) << 4);
#pragma unroll
          for (int kb = 0; kb < 8; ++kb) { const bf16x8 kf = *(const LAS bf16x8*)(kp + kb * 16384); s[kb] = MFMA32(kf, qf[d0], s[kb]); }
      } }
    MSTAMP(30);
    __syncthreads();
    { const bf16* src = (const bf16*)(ws + WS_MV) + (size_t)(l * 4 + b) * 256 * 1024 + h * 256;
#pragma unroll
      for (int i = 0; i < 16; ++i) { const int j = F.wave * 16 + i, key = 2 * j + (lane >> 5), cp = lane & 31, ch = ((((cp >> 2) ^ (key & 3)) << 2) | (cp & 3));
          __builtin_amdgcn_global_load_lds((const GAS unsigned*)(src + (size_t)key * 1024 + ch * 8), (LAS unsigned*)(F.lds + j * 1024), 16, 0, 0); } }
    float lsum = 0.f;
    {
        float mx = s[0][0];
#pragma unroll
        for (int kb = 0; kb < 8; ++kb)
#pragma unroll
            for (int r = 0; r < 16; ++r) mx = fmaxf(mx, s[kb][r]);
        mx = xl_max_x32(mx);
#pragma unroll
        for (int kb = 0; kb < 8; ++kb) {
#pragma unroll
            for (int r = 0; r < 16; ++r) { s[kb][r] = __builtin_amdgcn_exp2f(s[kb][r] - mx); lsum += s[kb][r]; }
#pragma unroll
            for (int i = 0; i < 8; ++i) pk[kb][i] = cvtpk(s[kb][2 * i], s[kb][2 * i + 1]); }
        lsum = xl_sum_x32(lsum); }
    VM_WAIT();
    __syncthreads();
    { LAS float* wsf = (LAS float*)(F.lds + AUX_OFF) + F.wave * 64;
      if (hi == 0) wsf[r32] = lsum;
      LDS_WAIT();
#pragma unroll
      for (int r = 0; r < 16; ++r) inv[r] = __builtin_amdgcn_rcpf(wsf[crow(r, hi)]); }
    MSTAMP(23);
    if (active) {
        const int g4 = lane >> 4, cb = g4 & 1, q4 = (lane & 15) >> 2, p4 = lane & 3;
        const unsigned vb = F.lds0 + (4 * hi + q4) * 512 + (16 * cb + 4 * p4) * 2;
        LAS unsigned char* ost = F.lds + OST_OFF + F.wave * 2048;
#pragma unroll 1
        for (int nb = 0; nb < 8; ++nb) { f32x16 o;
#pragma unroll
            for (int r = 0; r < 16; ++r) o[r] = 0.f;
            const unsigned vn = vb + ((nb ^ q4) << 6);
#pragma unroll
            for (int ks = 0; ks < 16; ++ks) { const bf16x8 pf = __builtin_bit_cast(bf16x8, (v4u){pk[ks >> 1][4 * (ks & 1)], pk[ks >> 1][4 * (ks & 1) + 1], pk[ks >> 1][4 * (ks & 1) + 2], pk[ks >> 1][4 * (ks & 1) + 3]});
                const s16x4 b0 = tr_read(vn + ks * 16 * 512), b1 = tr_read(vn + ks * 16 * 512 + 8 * 512);
                const bf16x8 vf = (bf16x8){b0[0], b0[1], b0[2], b0[3], b1[0], b1[1], b1[2], b1[3]};
                o = MFMA32(pf, vf, o); }
#pragma unroll
            for (int r = 0; r < 16; ++r) *(LAS bf16*)(ost + crow(r, hi) * 64 + r32 * 2) = (bf16)(cvtpk(o[r] * inv[r], 0.f) & 0xffffu);
#pragma unroll
            for (int i = 0; i < 2; ++i) { if (SMP && i == 1) continue; const int ch = lane + 64 * i, row = ch >> 2, cp = ch & 3;
                const v4u v = *(const LAS v4u*)(ost + row * 64 + cp * 16); *(GAS v4u*)(OM + (size_t)(rowq0 + row) * 1024 + h * 256 + 32 * nb + cp * 8) = v; }
        }
    }
    __syncthreads();
}

__device__ __forceinline__ void mem_unit_smp(const Args& a, const Frame& F, int l, int uidx) {
    unsigned char* ws = a.ws;
    const bf16* QM = (const bf16*)(ws + WS_QM); bf16* OM = (bf16*)(ws + WS_OM);
    int tid_ = F.wave * 64 + lane_id(); asm volatile("" : "+v"(tid_));
    const int tid = tid_, lane = tid & 63, r32 = lane & 31, hi = lane >> 5, w = F.wave;
    const int h = uidx & 3, b = uidx >> 2, rowq0 = MP + b * NS;
    LAS unsigned char* tile = F.lds + w * 16384;
    LAS float* st = (LAS float*)(F.lds + AUX_OFF);
    bf16x8 qf[16];
    { const bf16* qp = QM + (size_t)(rowq0 + (r32 & 15)) * 1024 + h * 256 + hi * 8;
#pragma unroll
      for (int d0 = 0; d0 < 16; ++d0) qf[d0] = __builtin_bit_cast(bf16x8, *(const GAS v4u*)(qp + d0 * 16)); }
    const size_t coff = ((size_t)(l * BS + b) * NMEM + w) * D + h * 256;
    { const float* src = a.in[4] + coff + (size_t)hi * 8 * D + r32 * 8; f32x4 x[32];
#pragma unroll
      for (int i = 0; i < 16; ++i) { x[2 * i] = *(const f32x4*)(src + (size_t)(16 * i) * D); x[2 * i + 1] = *(const f32x4*)(src + (size_t)(16 * i) * D + 4); }
#pragma unroll
      for (int i = 0; i < 32; ++i) asm volatile("" : "+v"(x[i]));
#pragma unroll
      for (int i = 0; i < 16; ++i) { const int key = 2 * i + hi; v4u v; v.x = cvtpk(x[2 * i][0], x[2 * i][1]); v.y = cvtpk(x[2 * i][2], x[2 * i][3]); v.z = cvtpk(x[2 * i + 1][0], x[2 * i + 1][1]); v.w = cvtpk(x[2 * i + 1][2], x[2 * i + 1][3]);
          *(LAS v4u*)(tile + key * 512 + ((r32 ^ key) << 4)) = v; } }
    f32x4 y[32];
    { int voff = hi * 8 * D + r32 * 8; asm volatile("" : "+v"(voff));
      const float* src = a.in[5] + coff + voff;
#pragma unroll
      for (int i = 0; i < 16; ++i) { y[2 * i] = *(const f32x4*)(src + (size_t)(16 * i) * D); y[2 * i + 1] = *(const f32x4*)(src + (size_t)(16 * i) * D + 4); } }
    LDS_WAIT();
    f32x16 s;
#pragma unroll
    for (int r = 0; r < 16; ++r) s[r] = 0.f;
    { const int xb = r32 ^ hi;
#pragma unroll
      for (int d0 = 0; d0 < 16; ++d0) { const bf16x8 kf = *(const LAS bf16x8*)(tile + r32 * 512 + ((xb ^ (2 * d0)) << 4)); s = MFMA32(kf, qf[d0], s); } }
    float mx = s[0];
#pragma unroll
    for (int r = 1; r < 16; ++r) mx = fmaxf(mx, s[r]);
    mx = xl_max_x32(mx);
    float ls = 0.f;
#pragma unroll
    for (int r = 0; r < 16; ++r) { s[r] = __builtin_amdgcn_exp2f(s[r] - mx); ls += s[r]; }
    ls = xl_sum_x32(ls);
    if (hi == 0) { st[w * 64 + r32] = mx; st[w * 64 + 32 + r32] = ls; }
#pragma unroll
    for (int i = 0; i < 32; ++i) asm volatile("" : "+v"(y[i]));
#pragma unroll
    for (int i = 0; i < 16; ++i) { const int key = 2 * i + hi; v4u v; v.x = cvtpk(y[2 * i][0], y[2 * i][1]); v.y = cvtpk(y[2 * i][2], y[2 * i][3]); v.z = cvtpk(y[2 * i + 1][0], y[2 * i + 1][1]); v.w = cvtpk(y[2 * i + 1][2], y[2 * i + 1][3]);
        *(LAS v4u*)(tile + key * 512 + ((((r32 >> 2) ^ (key & 3)) << 2 | (r32 & 3)) << 4)) = v; }
    __syncthreads();
    unsigned pk[8];
    { float mm[8], m = -3.0e38f, L = 0.f;
#pragma unroll
      for (int j = 0; j < 8; ++j) { mm[j] = st[j * 64 + r32]; m = fmaxf(m, mm[j]); }
#pragma unroll
      for (int j = 0; j < 8; ++j) L += st[j * 64 + 32 + r32] * __builtin_amdgcn_exp2f(mm[j] - m);
      const float f = __builtin_amdgcn_exp2f(mx - m) * __builtin_amdgcn_rcpf(L);
#pragma unroll
      for (int i = 0; i < 8; ++i) pk[i] = cvtpk(s[2 * i] * f, s[2 * i + 1] * f); }
    { const int g4 = lane >> 4, cb = g4 & 1, q4 = (lane & 15) >> 2, p4 = lane & 3;
      const unsigned vb = F.lds0 + (4 * hi + q4) * 512 + (16 * cb + 4 * p4) * 2;
      f32x16 o[8];
#pragma unroll
      for (int nb = 0; nb < 8; ++nb) {
#pragma unroll
          for (int r = 0; r < 16; ++r) o[nb][r] = 0.f;
          const unsigned vn = vb + ((nb ^ q4) << 6);
#pragma unroll
          for (int kl = 0; kl < 2; ++kl) { const int ks = 2 * w + kl; const bf16x8 pf = __builtin_bit_cast(bf16x8, (v4u){pk[4 * kl], pk[4 * kl + 1], pk[4 * kl + 2], pk[4 * kl + 3]});
              const s16x4 b0 = tr_read(vn + ks * 16 * 512), b1 = tr_read(vn + ks * 16 * 512 + 8 * 512);
              const bf16x8 vf = (bf16x8){b0[0], b0[1], b0[2], b0[3], b1[0], b1[1], b1[2], b1[3]};
              o[nb] = MFMA32(pf, vf, o[nb]); } }
      LAS float* part = (LAS float*)tile;
#pragma unroll
      for (int nb = 0; nb < 8; ++nb)
#pragma unroll
          for (int r = 0; r < 8; ++r) part[crow(r, hi) * 256 + 32 * nb + r32] = o[nb][r];
    }
    __syncthreads();
    { const int q = tid >> 5, c8 = (tid & 31) * 8; f32x4 o0 = (f32x4){0.f, 0.f, 0.f, 0.f}, o1 = o0;
#pragma unroll
      for (int j = 0; j < 8; ++j) { const LAS float* pp = (const LAS float*)(F.lds + j * 16384) + q * 256 + c8; o0 = o0 + *(const LAS f32x4*)pp; o1 = o1 + *(const LAS f32x4*)(pp + 4); }
      v4u v; v.x = cvtpk(o0[0], o0[1]); v.y = cvtpk(o0[2], o0[3]); v.z = cvtpk(o1[0], o1[1]); v.w = cvtpk(o1[2], o1[3]);
      *(GAS v4u*)(OM + (size_t)(rowq0 + q) * 1024 + h * 256 + c8) = v; }
    __syncthreads();
}

template <int MODE, int K> __device__ __forceinline__ void mini_gemm(const Frame& F, unsigned char* ws, const bf16* A, const bf16* Bt) {
    int tid_ = F.wave * 64 + lane_id(); asm volatile("" : "+v"(tid_));
    const int tid = tid_, lane = tid & 63, r32 = lane & 31, hi = lane >> 5, w = F.wave;
    constexpr int KS = K >> 3, NIT = KS / 16, BT = (NIT % 8 == 0) ? 8 : 11;
    static_assert(NIT % BT == 0, "batching");
    const int rb = F.bid >> 4, cb = F.bid & 15, row0 = MP + 32 * rb, col0 = 64 * cb;
    const bf16* ap = A + (size_t)(row0 + r32) * K + w * KS + hi * 8;
    const bf16* bp0 = Bt + (size_t)(col0 + r32) * K + w * KS + hi * 8; const bf16* bp1 = bp0 + (size_t)32 * K;
    const int row = tid >> 4, c4 = (tid & 15) * 4, grow = row0 + row, gcol = col0 + c4;
    f32x4 e0, e1, e2, e3, e4, e5; v2u xo;
    if (MODE == 2) { const float* SSQ = (const float*)(ws + WS_SSQ) + (size_t)grow * 16; e0 = *(const f32x4*)SSQ; e1 = *(const f32x4*)(SSQ + 4); e2 = *(const f32x4*)(SSQ + 8); e3 = *(const f32x4*)(SSQ + 12); e4 = e0; e5 = e0; xo.x = 0u; xo.y = 0u; }
    else { if (MODE == 1) { const float* SBSS = (const float*)(ws + WS_SBSS) + (size_t)grow * 8; const float* SASS = (const float*)(ws + WS_SASS) + (size_t)grow * 16;
               e0 = *(const f32x4*)SBSS; e1 = *(const f32x4*)(SBSS + 4); e2 = *(const f32x4*)SASS; e3 = *(const f32x4*)(SASS + 4); e4 = *(const f32x4*)(SASS + 8); e5 = *(const f32x4*)(SASS + 12); }
           else { e0 = (f32x4){0.f, 0.f, 0.f, 0.f}; e1 = e0; e2 = e0; e3 = e0; e4 = e0; e5 = e0; }
           xo = *(const GAS v2u*)((const bf16*)(ws + WS_XB) + (size_t)grow * 1024 + gcol); }
    f32x16 acc0, acc1;
#pragma unroll
    for (int r = 0; r < 16; ++r) { acc0[r] = 0.f; acc1[r] = 0.f; }
#pragma unroll
    for (int k0 = 0; k0 < NIT; k0 += BT) { v4u fa[BT], fb0[BT], fb1[BT];
#pragma unroll
        for (int i = 0; i < BT; ++i) { fa[i] = *(const GAS v4u*)(ap + (k0 + i) * 16); fb0[i] = *(const GAS v4u*)(bp0 + (k0 + i) * 16); fb1[i] = *(const GAS v4u*)(bp1 + (k0 + i) * 16); }
#pragma unroll
        for (int i = 0; i < BT; ++i) asm volatile("" : "+v"(fa[i]), "+v"(fb0[i]), "+v"(fb1[i]));
#pragma unroll
        for (int i = 0; i < BT; ++i) { const bf16x8 af = __builtin_bit_cast(bf16x8, fa[i]); acc0 = MFMA32(af, __builtin_bit_cast(bf16x8, fb0[i]), acc0); acc1 = MFMA32(af, __builtin_bit_cast(bf16x8, fb1[i]), acc1); } }
    LAS float* P = (LAS float*)F.lds + w * 2048;
#pragma unroll
    for (int r = 0; r < 16; ++r) { P[crow(r, hi) * 64 + r32] = acc0[r]; P[crow(r, hi) * 64 + 32 + r32] = acc1[r]; }
    __syncthreads();
    f32x4 sb = (f32x4){0.f, 0.f, 0.f, 0.f}, sa = (f32x4){0.f, 0.f, 0.f, 0.f};
#pragma unroll
    for (int ww = 0; ww < 4; ++ww) { sb = sb + *(const LAS f32x4*)((LAS float*)F.lds + ww * 2048 + row * 64 + c4); sa = sa + *(const LAS f32x4*)((LAS float*)F.lds + (ww + 4) * 2048 + row * 64 + c4); }
    if (MODE == 2) {
        const float s = (((e0[0] + e0[1]) + (e0[2] + e0[3])) + ((e1[0] + e1[1]) + (e1[2] + e1[3]))) + (((e2[0] + e2[1]) + (e2[2] + e2[3])) + ((e3[0] + e3[1]) + (e3[2] + e3[3])));
        const float r = __builtin_amdgcn_rsqf(s * (1.0f / 1024.0f) + EPS) * C_MEM; const f32x4 v = (sb + sa) * r;
        v2u o; o.x = cvtpk(v[0], v[1]); o.y = cvtpk(v[2], v[3]); *(GAS v2u*)((bf16*)(ws + WS_QM) + (size_t)grow * 1024 + gcol) = o;
    } else {
        f32x4 val = sb + sa;
        if (MODE == 1) {
            const float tb = ((e0[0] + e0[1]) + (e0[2] + e0[3])) + ((e1[0] + e1[1]) + (e1[2] + e1[3]));
            const float ta = (((e2[0] + e2[1]) + (e2[2] + e2[3])) + ((e3[0] + e3[1]) + (e3[2] + e3[3]))) + (((e4[0] + e4[1]) + (e4[2] + e4[3])) + ((e5[0] + e5[1]) + (e5[2] + e5[3])));
            val = sb * __builtin_amdgcn_rsqf(tb * (1.0f / 512.0f) + EPS) + sa * __builtin_amdgcn_rsqf(ta * (1.0f / 512.0f) + EPS); }
        bf16* xb = (bf16*)(ws + WS_XB) + (size_t)grow * 1024 + gcol;
        f32x4 x; x[0] = bf_lo(xo.x); x[1] = bf_hi(xo.x); x[2] = bf_lo(xo.y); x[3] = bf_hi(xo.y);
        x = x + val;
        v2u o; o.x = cvtpk(x[0], x[1]); o.y = cvtpk(x[2], x[3]); *(GAS v2u*)xb = o;
        float ss = (x[0] * x[0] + x[1] * x[1]) + (x[2] * x[2] + x[3] * x[3]);
        ss = xl_sum16(ss);
        if ((tid & 15) == 0) ((float*)(ws + WS_SSQ))[(size_t)grow * 16 + cb] = ss;
    }
    __syncthreads();
}

__global__ void __launch_bounds__(NWAVES * 64, 2) mk_fwd(Args args) {
    extern __shared__ __attribute__((aligned(16))) unsigned char lds[];
    const int wave0 = __builtin_amdgcn_readfirstlane((int)threadIdx.x >> 6);
#define PH_FRAME() Frame F; { int w_ = wave0, g_ = (int)gridDim.x, b_ = (int)blockIdx.x; unsigned l0_ = (unsigned)(uintptr_t)lds; asm volatile("" : "+s"(w_), "+s"(g_), "+s"(b_), "+s"(l0_)); \
        F.lds = (LAS unsigned char*)lds; F.lds0 = l0_; F.wave = w_; F.G = g_; F.bid = b_; } \
        size_t wz_ = 0; asm volatile("" : "+s"(wz_)); unsigned char* ws = args.ws + wz_;
    gu32* ctl; { unsigned char* ws0 = args.ws; ctl = (gu32*)(ws0 + WS_CTL); }
    for (int u = wave0 * 64 + lane_id(); u < (LDS_BYTES - LDSCTL_OFF) / 4; u += NWAVES * 64) ((LAS unsigned*)((LAS unsigned char*)lds + LDSCTL_OFF))[u] = 0u;
    __syncthreads();
    XcdBarrier bar = xcd_barrier_post((unsigned*)(ctl + CW_BAR), (volatile LAS unsigned*)((LAS unsigned char*)lds + MISC_OFF) + 8, wave0 * 64 + lane_id());
    const int lo = args.ph_lo, hi_ph = args.ph_hi; int ph = 0;
#ifdef TPROBE
    volatile LAS unsigned* tacc = (volatile LAS unsigned*)((LAS unsigned char*)lds + MISC_OFF + 64);
    if (wave0 * 64 + lane_id() == 0) tacc[32] = (unsigned)__builtin_amdgcn_s_memrealtime();
#define TSTAMP(k) do { if (wave0 * 64 + lane_id() == 0) { const unsigned now_ = (unsigned)__builtin_amdgcn_s_memrealtime(); tacc[(k)] += now_ - tacc[32]; if ((k) >= 16) tacc[31] += now_ - tacc[32]; tacc[32] = now_; } } while (0)
#else
#define TSTAMP(k) do { } while (0)
#endif
#define PH_ON() (lo <= ph && ph < hi_ph)
#ifndef EXTRA_BAR
#define EXTRA_BAR 0
#endif
#define PH_END(kk) do { if (lo <= ph && ph + 1 < hi_ph) { xcd_barrier(bar, wave0 * 64 + lane_id()); for (int xb_ = 0; xb_ < EXTRA_BAR; ++xb_) xcd_barrier(bar, wave0 * 64 + lane_id()); } ++ph; TSTAMP(16 + (kk)); } while (0)

#ifndef NO_PRO
    if (PH_ON()) {
#pragma unroll 1
        for (int rp = 0; rp < REP_P; ++rp) { PH_FRAME(); prologue(args, F); } }
#endif
    TSTAMP(0); PH_END(0);
    for (int l = 0; l < NL; ++l) {
        if (PH_ON())
#pragma unroll 1
        for (int rp = 0; rp < REP_A; ++rp) { PH_FRAME(); const unsigned char* wl = ws + WS_WL + (size_t)l * WL_STRIDE;
            { pg8::Gemm g{(const bf16*)(ws + WS_XB), (const bf16*)(wl + WL_IN), M, INW, D}; pg8::StaticOrder S; S.init(M, INW, F.G, F.bid);
              pg8::EpiIn E{ws, args.out, l, C_SB, (LAS float*)(F.lds + AUX_OFF + 2048)};
#ifndef NO_GA
              pg8::gemm_phase<pg8::EpiIn, pg8::StaticOrder, true, true>(F.lds + RING_OFF, g, S, E, F.wave);
#endif
              }
#ifndef NO_CVA
            if (l + 1 < NL && F.bid >= 148) { __syncthreads(); convert_items<false>(args, F, l + 1, (F.bid - 148) * NWAVES + F.wave, 108 * NWAVES, 0, 2592); }
#endif
        }
        TSTAMP(2); PH_END(2);
        if (PH_ON())
#pragma unroll 1
        for (int rp = 0; rp < REP_B; ++rp) { PH_FRAME();
            if (l == 0) { pg8::Gemm g{(const bf16*)(ws + WS_MEMB), (const bf16*)(ws + WS_WMKV), NB * NMEM, 8 * D, D}; pg8::StaticOrder S; S.init(NB * NMEM, 8 * D, F.G, F.bid >= 128 ? F.bid - 128 : 256);
              pg8::EpiKV E{out_mk_p(args.out), out_mv_p(args.out), (bf16*)(ws + WS_MK), (bf16*)(ws + WS_MV), 0};
#ifndef NO_GKV
              pg8::gemm_phase<pg8::EpiKV, pg8::StaticOrder, true, true>(F.lds + RING_OFF, g, S, E, F.wave);
#endif
              __syncthreads();
            }
#ifndef NO_SGU
#pragma unroll 1
            for (int r2 = 0; r2 < REP_SGU; ++r2) {
            sgu_unit(args, F, l, 2 * (16 * (F.bid & 7) + (F.bid >> 4)) + ((F.bid >> 3) & 1));
            if (F.bid < 8) sgu_unit(args, F, l, 256 + F.bid);
            }
#endif
            TSTAMP(11);
#ifndef NO_SB
            { const int x = F.bid & 7; gu32* qh = (gu32*)(ws + WS_CTL) + CW_SBQ + (l * 8 + x) * 64;
#pragma unroll 1
              for (;;) { unsigned q = 0u; if (lane_id() == 0) q = __hip_atomic_fetch_add(qh, 1u, __ATOMIC_RELAXED, __HIP_MEMORY_SCOPE_AGENT);
                  const int qi = (int)__builtin_amdgcn_readfirstlane(q);
                  if (qi >= 32 + 4 * (T / 32)) break;
                  if (qi < 32) sb_unit<true>(args, F, l, 32 * x + qi); else sb_unit<false>(args, F, l, (4 * x + ((qi - 32) & 3)) * 128 + 127 - ((qi - 32) >> 2)); } }
#endif
            __syncthreads();
        }
        TSTAMP(3); PH_END(3);
        if (PH_ON()) { PH_FRAME(); const unsigned char* wl = ws + WS_WL + (size_t)l * WL_STRIDE; pg8::Gemm g{(const bf16*)(ws + WS_CAT), (const bf16*)(wl + WL_OUT), MP, D, D}; pg8::StaticOrder S; S.init(MP, D, F.G, F.bid);
            pg8::EpiRes<true> E{ws, (LAS float*)(F.lds + AUX_OFF + 2048)};
#ifndef NO_GD
            pg8::gemm_phase<pg8::EpiRes<true>, pg8::StaticOrder, true, true>(F.lds + RING_OFF, g, S, E, F.wave);
#endif
            mini_gemm<1, D>(F, ws, (const bf16*)(ws + WS_CAT), (const bf16*)(wl + WL_OUT));
            }
        TSTAMP(4); PH_END(4);
        if (PH_ON())
#pragma unroll 1
        for (int rp = 0; rp < REP_E; ++rp) { PH_FRAME(); const unsigned char* wl = ws + WS_WL + (size_t)l * WL_STRIDE; pg8::Gemm g{(const bf16*)(ws + WS_XB), (const bf16*)(wl + WL_MQ), MP, D, D}; pg8::StaticOrder S; S.init(MP, D, F.G, F.bid);
            pg8::EpiQ E{(const float*)(ws + WS_SSQ), (bf16*)(ws + WS_QM), C_MEM, (LAS float*)(F.lds + AUX_OFF + 2048)};
#ifndef NO_GE
            pg8::gemm_phase<pg8::EpiQ, pg8::StaticOrder, true, true>(F.lds + RING_OFF, g, S, E, F.wave);
#endif
            mini_gemm<2, D>(F, ws, (const bf16*)(ws + WS_XB), (const bf16*)(wl + WL_MQ));
            }
        TSTAMP(5); PH_END(5);
        if (PH_ON())
#pragma unroll 1
        for (int rp = 0; rp < REP_F; ++rp) { PH_FRAME();
#ifndef NO_MEM
            if (F.bid >= 192) mem_unit_smp(args, F, l, F.bid - 192);
            if (F.bid < NB * 4 * (T / 256)) { const int pm_ = 8 * (F.bid & 7) + (F.bid >> 5), h_ = (F.bid >> 3) & 3;
                mem_unit<false>(args, F, l, ((pm_ >> 4) * 4 + h_) * 16 + (pm_ & 15)); }
            TSTAMP(13);
#ifndef NO_MEMS
            if (F.bid < 64) mem_unit_smp(args, F, l, 64 + F.bid);
#endif
#endif
            __syncthreads();
        }
        TSTAMP(6); PH_END(6);
        if (PH_ON()) { PH_FRAME(); const unsigned char* wl = ws + WS_WL + (size_t)l * WL_STRIDE; pg8::Gemm g{(const bf16*)(ws + WS_OM), (const bf16*)(wl + WL_MO), MP, D, D}; pg8::StaticOrder S; S.init(MP, D, F.G, F.bid);
            pg8::EpiRes<false> E{ws, nullptr};
#ifndef NO_GG
            pg8::gemm_phase<pg8::EpiRes<false>, pg8::StaticOrder, true, true>(F.lds + RING_OFF, g, S, E, F.wave);
#endif
            mini_gemm<0, D>(F, ws, (const bf16*)(ws + WS_OM), (const bf16*)(wl + WL_MO));
            }
        TSTAMP(7); PH_END(7);
        if (PH_ON())
#pragma unroll 1
        for (int rp = 0; rp < REP_H; ++rp) { PH_FRAME(); const unsigned char* wl = ws + WS_WL + (size_t)l * WL_STRIDE; pg8::Gemm g{(const bf16*)(ws + WS_XB), (const bf16*)(wl + WL_GU), M, 2 * DFF, D}; pg8::StaticOrder S; S.init(M, 2 * DFF, F.G, F.bid);
            pg8::EpiGU E{(const float*)(ws + WS_SSQ), (bf16*)(ws + WS_H), (LAS float*)(F.lds + AUX_OFF + 2048)};
#ifndef NO_GH
            pg8::gemm_phase<pg8::EpiGU, pg8::StaticOrder, true, true>(F.lds + RING_OFF, g, S, E, F.wave);
#endif
#ifndef NO_CVH
            if (l + 1 < NL && F.bid >= 172) { __syncthreads(); convert_items<false>(args, F, l + 1, (F.bid - 172) * NWAVES + F.wave, 84 * NWAVES, 2592, 3520); }
#endif
            }
        TSTAMP(8); PH_END(8);
        if (PH_ON()) { PH_FRAME(); const unsigned char* wl = ws + WS_WL + (size_t)l * WL_STRIDE; pg8::Gemm g{(const bf16*)(ws + WS_H), (const bf16*)(wl + WL_DN), MP, D, DFF}; pg8::StaticOrder S; S.init(MP, D, F.G, F.bid);
            pg8::EpiRes<false> E{ws, nullptr};
#ifndef NO_GI
            pg8::gemm_phase<pg8::EpiRes<false>, pg8::StaticOrder, true, true, true>(F.lds + RING_OFF, g, S, E, F.wave);
#endif
            mini_gemm<0, DFF>(F, ws, (const bf16*)(ws + WS_H), (const bf16*)(wl + WL_DN));
            }
        TSTAMP(9); PH_END(9);
    }
    if (PH_ON()) { PH_FRAME();
        const float* gf = args.in[24]; const int gw = F.bid * NWAVES + F.wave, NGW = F.G * NWAVES;
        f32x4 gg[4];
#pragma unroll
        for (int j = 0; j < 4; ++j) gg[j] = ((const f32x4*)gf)[lane_id() + 64 * j];
        for (int m0 = gw; m0 < M; m0 += 3 * NGW) {
            float sq[3]; v2u xo[3][4];
#pragma unroll
            for (int k = 0; k < 3; ++k) { int m = m0 + k * NGW; m = m < M ? m : M - 1;
                sq[k] = lane_id() < 16 ? ((const float*)(ws + WS_SSQ))[(size_t)m * 16 + lane_id()] : 0.f;
#pragma unroll
                for (int j = 0; j < 4; ++j) xo[k][j] = ((const v2u*)((const bf16*)(ws + WS_XB) + (size_t)m * D))[lane_id() + 64 * j]; }
#pragma unroll
            for (int k = 0; k < 3; ++k) asm volatile("" : "+v"(sq[k]), "+v"(xo[k][0]), "+v"(xo[k][1]), "+v"(xo[k][2]), "+v"(xo[k][3]));
#pragma unroll
            for (int k = 0; k < 3; ++k) { const int m = m0 + k * NGW;
                if (m < M) { float s = xl_sum16(sq[k]); s = __builtin_bit_cast(float, __builtin_amdgcn_readfirstlane(__builtin_bit_cast(int, s)));
                    const float rstd = __builtin_amdgcn_rsqf(s * (1.0f / 1024.0f) + EPS);
                    float* dst = m < MP ? out_y_p(args.out) + (size_t)m * D : out_y_s(args.out) + (size_t)(m - MP) * D;
#pragma unroll
                    for (int j = 0; j < 4; ++j) { f32x4 v; v[0] = bf_lo(xo[k][j].x); v[1] = bf_hi(xo[k][j].x); v[2] = bf_lo(xo[k][j].y); v[3] = bf_hi(xo[k][j].y);
                        ((f32x4*)dst)[lane_id() + 64 * j] = v * rstd * gg[j]; } } }
        }
    }
    TSTAMP(10);
#ifdef TPROBE
    { unsigned long long* tsum = (unsigned long long*)(args.ws + WS_CTL + 65536);
      if (wave0 * 64 + lane_id() == 0) atomicAdd(tsum, (unsigned long long)tacc[TPROBE]);
      xcd_barrier(bar, wave0 * 64 + lane_id());
      if (blockIdx.x == 0 && wave0 * 64 + lane_id() == 0) { const unsigned long long tot = __hip_atomic_load(tsum, __ATOMIC_RELAXED, __HIP_MEMORY_SCOPE_AGENT);
          const unsigned long long wait = tot * 10ull / gridDim.x, t0 = __builtin_amdgcn_s_memrealtime();
          while (__builtin_amdgcn_s_memrealtime() - t0 < wait) __builtin_amdgcn_s_sleep(8); } }
#endif
#undef PH_ON
#undef PH_END
}

static int mk_grid = 0;
static void mk_launch(void* const* d_in, float* out, unsigned char* ws, hipStream_t stream, int ph_lo, int ph_hi) {
    if (mk_grid == 0) {
        int dev = 0, cus = 0;
        if (hipGetDevice(&dev) != hipSuccess || hipDeviceGetAttribute(&cus, hipDeviceAttributeMultiprocessorCount, dev) != hipSuccess) { mk_grid = -1; return; }
        if (hipFuncSetAttribute((const void*)mk_fwd, hipFuncAttributeMaxDynamicSharedMemorySize, LDS_BYTES) != hipSuccess) { mk_grid = -1; return; }
        (void)hipGetLastError();
        if (cus < 256) { fprintf(stderr, "kernel_launch: this kernel needs 256 CUs (got %d); nothing launched\n", cus); mk_grid = -1; return; }
        mk_grid = 256;
    }
    if (mk_grid < 0) return;
    (void)hipMemsetAsync(ws + WS_CTL, 0, CTL_ZERO_BYTES, stream);
    Args a{};
    for (int i = 0; i < 25; ++i) a.in[i] = (const float*)d_in[i];
    a.out = out; a.ws = ws; a.ph_lo = ph_lo; a.ph_hi = ph_hi;
    hipLaunchKernelGGL(mk_fwd, dim3(mk_grid), dim3(NWAVES * 64), LDS_BYTES, stream, a);
}
extern "C" void kernel_launch(void* const* d_in, const int* in_sizes, int n_in, void* d_out, int out_size, void* d_ws, size_t ws_size, hipStream_t stream) {
    mk_launch(d_in, (float*)d_out, (unsigned char*)d_ws, stream, 0, 34);
}
```

```cpp
#include <hip/hip_runtime.h>
#include <cstdint>
#include <cstdio>
#include <cmath>
namespace pg8 {
#define PG8_LAS __attribute__((address_space(3)))
typedef unsigned short bf16_t;
typedef short bf16x8 __attribute__((ext_vector_type(8)));
typedef float f32x4 __attribute__((ext_vector_type(4)));
typedef unsigned u32x4 __attribute__((ext_vector_type(4)));
constexpr int BM = 256, BK = 64, HALF = 128, HTB = HALF * BK * 2  , STAGE_BYTES = 8 * HTB, NXCD = 8, WGM = 8;

__host__ __device__ __forceinline__ int lds_byte(int r, int c) { const int st = (r >> 4) * 2 + (c >> 5), rr = r & 15, cc = c & 31, ob = rr * 64 + cc * 2; return st * 1024 + (ob ^ (((ob >> 9) & 1) << 5)); }
__host__ __device__ __forceinline__ void stage_rc(int b, int& R, int& C) { const int st = b / 1024, sb = b % 1024, swz = sb ^ (((sb >> 9) & 1) << 5); R = (st >> 1) * 16 + swz / 64; C = (st & 1) * 32 + (swz % 64) / 2; }
__host__ __device__ __forceinline__ int perm32(int rho) { const int n = rho >> 4, i = rho & 15; return 8 * (i >> 2) + 4 * n + (i & 3); }

template <int CTRL> __device__ __forceinline__ float xl_dpp(float v) { return __builtin_bit_cast(float, __builtin_amdgcn_mov_dpp(__builtin_bit_cast(int, v), CTRL, 0xF, 0xF, true)); }
__device__ __forceinline__ float xl_sum16(float v) {
    v += xl_dpp<0xB1>(v); v += xl_dpp<0x4E>(v); v += xl_dpp<0x141>(v); v += xl_dpp<0x140>(v); return v; }
__device__ __forceinline__ void xl_swap16(float v, float& a, float& b) { a = v; b = v; asm volatile("s_nop 1\n\tv_permlane16_swap_b32 %0, %1" : "+v"(a), "+v"(b)); }
__device__ __forceinline__ void xl_swap32(float v, float& a, float& b) { a = v; b = v; asm volatile("s_nop 1\n\tv_permlane32_swap_b32 %0, %1" : "+v"(a), "+v"(b)); }
__device__ __forceinline__ float xl_sum_x16(float v) { float a, b; xl_swap16(v, a, b); return a + b; }
__device__ __forceinline__ float xl_sum_x32(float v) { float a, b; xl_swap32(v, a, b); return a + b; }
__device__ __forceinline__ float xl_max_x32(float v) { float a, b; xl_swap32(v, a, b); return fmaxf(a, b); }
__device__ __forceinline__ float xl_other_x32(float v, int hi) { float a, b; xl_swap32(v, a, b); return hi ? a : b; }
__device__ __forceinline__ int pg8_lane_id() { int l_; asm volatile("v_mbcnt_lo_u32_b32 %0, -1, 0\n\tv_mbcnt_hi_u32_b32 %0, -1, %0" : "=v"(l_)); return l_; }
struct Unit { int pm, pn; };
struct Gemm { const bf16_t* A; const bf16_t* Bt; int M, N, K; };

struct StaticOrder {
    int nM, nN, nwg, G, c;
    __host__ __device__ void init(int M, int N, int G_, int c_) { nM = M / BM; nN = N / BM; nwg = nM * nN; G = G_; c = c_; }
    __host__ __device__ bool next(int i, Unit& u) const {
        const long L = (long)i * G + c; if (L >= nwg) return false;
        int wgid = (int)L; { const int q = nwg / NXCD, r = nwg % NXCD, xcd = wgid % NXCD, off = wgid / NXCD; wgid = (xcd < r ? xcd * (q + 1) : r * (q + 1) + (xcd - r) * q) + off; }
        const int nig = WGM * nN, gid = wgid / nig, fm = gid * WGM, gsz = (nM - fm) < WGM ? (nM - fm) : WGM;
        u.pm = fm + ((wgid % nig) % gsz); u.pn = nN - 1 - (wgid % nig) / gsz; return true;
    }
    __device__ __forceinline__ void a_ready(const Unit&) const {}
    __device__ __forceinline__ void done(const Unit&) const {}
};

__device__ __forceinline__ unsigned cvt_pk_bf16(float lo, float hi) { unsigned r; asm volatile("v_cvt_pk_bf16_f32 %0, %1, %2" : "=v"(r) : "v"(lo), "v"(hi)); return r; }
typedef float f32x2 __attribute__((ext_vector_type(2)));
constexpr int E_MP = 16384, E_MS = 512;
constexpr size_t EMiB = 1u << 20, EW_SSQ = 148 * EMiB, EW_SBSS = 150 * EMiB, EW_SASS = 527 * EMiB, EW_XF = 152 * EMiB, EW_XB = 218 * EMiB, EW_U = 251 * EMiB, EW_VA = 268 * EMiB, EW_Q = 285 * EMiB, EW_K = 302 * EMiB, EW_V = 319 * EMiB;
constexpr size_t EO_SBK_P = (size_t)16896 * 1024, EO_SBV_P = EO_SBK_P + (size_t)4 * 16384 * 512, EO_MK_P = EO_SBV_P + (size_t)4 * 16384 * 512, EO_MV_P = EO_MK_P + (size_t)4 * 4 * 256 * 1024, EO_SBK_S = EO_MV_P + (size_t)4 * 4 * 256 * 1024, EO_SBV_S = EO_SBK_S + (size_t)4 * 512 * 512;
constexpr float E_EPS = 1e-6f, E_LOG2E = 1.4426950408889634f;
typedef unsigned u32x2 __attribute__((ext_vector_type(2)));
__device__ __forceinline__ void load_rstd(const float* SSQ, int row0, int fq, float (&rs)[2][4]) {
#pragma unroll
    for (int ai = 0; ai < 2; ++ai)
#pragma unroll
        for (int m = 0; m < 4; ++m) { const f32x4 a = *(const f32x4*)(SSQ + (size_t)(row0 + ai * HALF + m * 16) * 16 + fq * 4);
            float s = (a[0] + a[1]) + (a[2] + a[3]); s = xl_sum_x16(s); s = xl_sum_x32(s);
            rs[ai][m] = __builtin_amdgcn_rsqf(s * (1.0f / 1024.0f) + E_EPS); }
}
__device__ __forceinline__ void prep_rstd(const float* SSQ, PG8_LAS float* aux, const Unit& u, int ui, int tid) {
    if (tid < 256) { const f32x4* p = (const f32x4*)(SSQ + (size_t)(u.pm * BM + tid) * 16); const f32x4 a = p[0], b = p[1], c = p[2], d = p[3];
        const float s = (((a[0] + a[1]) + (a[2] + a[3])) + ((b[0] + b[1]) + (b[2] + b[3]))) + (((c[0] + c[1]) + (c[2] + c[3])) + ((d[0] + d[1]) + (d[2] + d[3])));
        aux[(ui & 1) * 256 + tid] = __builtin_amdgcn_rsqf(s * (1.0f / 1024.0f) + E_EPS); }
}
__device__ __forceinline__ f32x4 ld_untracked(const float* p) { f32x4 v; asm volatile("global_load_dwordx4 %0, %1, off" : "=v"(v) : "v"(p) : "memory"); return v; }
__device__ __forceinline__ void prep_rstd_load(const float* SSQ, const Unit& u, int tid, f32x4 (&pr)[6]) {
    if (tid < 256) { const float* p = SSQ + (size_t)(u.pm * BM + tid) * 16; pr[0] = ld_untracked(p); pr[1] = ld_untracked(p + 4); pr[2] = ld_untracked(p + 8); pr[3] = ld_untracked(p + 12); }
}
__device__ __forceinline__ void prep_rstd_commit(PG8_LAS float* aux, const f32x4 (&pr)[6], int ui, int tid) {
    if (tid < 256) { const f32x4 a = pr[0], b = pr[1], c = pr[2], d = pr[3];
        const float s = (((a[0] + a[1]) + (a[2] + a[3])) + ((b[0] + b[1]) + (b[2] + b[3]))) + (((c[0] + c[1]) + (c[2] + c[3])) + ((d[0] + d[1]) + (d[2] + d[3])));
        aux[(ui & 1) * 256 + tid] = __builtin_amdgcn_rsqf(s * (1.0f / 1024.0f) + E_EPS); }
}
__device__ __forceinline__ void aux_rstd(const PG8_LAS float* aux, int ui, int wr, int fr, float (&rs)[2][4]) {
#pragma unroll
    for (int ai = 0; ai < 2; ++ai)
#pragma unroll
        for (int m = 0; m < 4; ++m) rs[ai][m] = aux[(ui & 1) * 256 + ai * HALF + wr * 64 + m * 16 + fr];
}
__device__ __forceinline__ float gelu_tanh_f(float x) {
    const float y = x * (1.0f + 0.044715f * x * x);
    const float e = __builtin_amdgcn_exp2f(y * (-2.0f * 0.7978845608028654f * E_LOG2E));
    return x * __builtin_amdgcn_rcpf(1.0f + e);
}
__device__ __forceinline__ u32x4 pack8(const f32x4 a, const f32x4 b) { u32x4 w; w.x = cvt_pk_bf16(a[0], a[1]); w.y = cvt_pk_bf16(a[2], a[3]); w.z = cvt_pk_bf16(b[0], b[1]); w.w = cvt_pk_bf16(b[2], b[3]); return w; }

struct EpiIn {
    static constexpr bool PERM = true, AFTER_DRAIN = false, MIDSCALE = false, PREP = true; static constexpr int MID_T = 0;
    unsigned char* ws; float* out; int l; float qscale; PG8_LAS float* aux;
    __device__ __forceinline__ void midscale(f32x4 (&)[2][2][4][2], const Unit&, int, int, int) const {}
    __device__ __forceinline__ void prepare(const Unit& u, int ui, int tid) const { size_t z_ = 0; asm volatile("" : "+s"(z_)); prep_rstd((const float*)(ws + z_ + EW_SSQ), aux, u, ui, tid); }
    __device__ __forceinline__ void prepare_load(const Unit& u, int tid, f32x4 (&pr)[6]) const { size_t z_ = 0; asm volatile("" : "+s"(z_)); prep_rstd_load((const float*)(ws + z_ + EW_SSQ), u, tid, pr); }
    __device__ __forceinline__ void prepare_commit(const f32x4 (&pr)[6], int ui, int tid) const { prep_rstd_commit(aux, pr, ui, tid); }
    __device__ __forceinline__ void operator()(const f32x4 (&acc)[2][2][4][2], const Unit& u, int wr, int wc, int fr, int fq, int ui) const {
        size_t z_ = 0; asm volatile("" : "+s"(z_)); unsigned char* w = ws + z_; float* o = out + z_;
        const int row0 = u.pm * BM + wr * 64 + fr, typ = u.pn >> 1, col0 = (u.pn & 1) * 256 + wc * 32 + 8 * fq;
        float rs[2][4]; aux_rstd(aux, ui, wr, fr, rs);
        bf16_t* ob = (bf16_t*)(w + (typ == 0 ? EW_U : typ == 1 ? EW_VA : typ == 2 ? EW_Q : typ == 3 ? EW_K : EW_V));
        float* of = nullptr;
        if (typ >= 3) { const bool smp = u.pm * BM >= E_MP;
            of = o + (smp ? (typ == 3 ? EO_SBK_S : EO_SBV_S) + (size_t)l * E_MS * 512 - (size_t)E_MP * 512 : (typ == 3 ? EO_SBK_P : EO_SBV_P) + (size_t)l * E_MP * 512); }
#pragma unroll
        for (int ai = 0; ai < 2; ++ai)
#pragma unroll
            for (int m = 0; m < 4; ++m) { const int row = row0 + ai * HALF + m * 16; const float r = rs[ai][m];
#pragma unroll
                for (int bj = 0; bj < 2; ++bj) { f32x4 v0 = acc[ai][bj][m][0] * r, v1 = acc[ai][bj][m][1] * r; const size_t off = (size_t)row * 512 + col0 + bj * HALF;
                    if (typ <= 1) {
#pragma unroll
                        for (int i = 0; i < 4; ++i) { v0[i] = gelu_tanh_f(v0[i]); v1[i] = gelu_tanh_f(v1[i]); } }
                    else if (typ == 2) { v0 = v0 * qscale; v1 = v1 * qscale; }
                    else { *(f32x4*)(of + off) = v0; *(f32x4*)(of + off + 4) = v1; }
                    *(u32x4*)(ob + off) = pack8(v0, v1); }
                asm volatile("" ::: "memory"); }
#ifdef TPROBE
        if (wr == 0 && wc == 0 && fr == 0 && fq == 0) {
            volatile PG8_LAS unsigned* tc = (volatile PG8_LAS unsigned*)((PG8_LAS unsigned char*)aux - 2048 - 640);
            const unsigned now_ = (unsigned)__builtin_amdgcn_s_memrealtime(); tc[typ <= 1 ? 1 : typ == 2 ? 15 : 26] += now_ - tc[32]; tc[32] = now_; }
#endif
    }
};
template <bool MID> struct EpiRes {
    static constexpr bool PERM = true, AFTER_DRAIN = false, MIDSCALE = MID, PREP = MID; static constexpr int MID_T = 8;
    unsigned char* ws; PG8_LAS float* aux;
    __device__ __forceinline__ void prepare_load(const Unit& u, int tid, f32x4 (&pr)[6]) const {
        if (MID && tid < 256) { size_t z_ = 0; asm volatile("" : "+s"(z_)); unsigned char* w = ws + z_; const float* SBSS = (const float*)(w + EW_SBSS); const float* SASS = (const float*)(w + EW_SASS);
            const size_t row = (size_t)(u.pm * BM + tid);
            pr[0] = ld_untracked(SBSS + row * 8); pr[1] = ld_untracked(SBSS + row * 8 + 4);
            pr[2] = ld_untracked(SASS + row * 16); pr[3] = ld_untracked(SASS + row * 16 + 4); pr[4] = ld_untracked(SASS + row * 16 + 8); pr[5] = ld_untracked(SASS + row * 16 + 12); }
    }
    __device__ __forceinline__ void prepare_commit(const f32x4 (&pr)[6], int ui, int tid) const {
        if (MID && tid < 256) { const f32x4 b0 = pr[0], b1 = pr[1], a0 = pr[2], a1 = pr[3], a2 = pr[4], a3 = pr[5];
            const float sb = ((b0[0] + b0[1]) + (b0[2] + b0[3])) + ((b1[0] + b1[1]) + (b1[2] + b1[3]));
            const float sa = (((a0[0] + a0[1]) + (a0[2] + a0[3])) + ((a1[0] + a1[1]) + (a1[2] + a1[3]))) + (((a2[0] + a2[1]) + (a2[2] + a2[3])) + ((a3[0] + a3[1]) + (a3[2] + a3[3])));
            const float rb = __builtin_amdgcn_rsqf(sb * (1.0f / 512.0f) + E_EPS), qa = sa * (1.0f / 512.0f) + E_EPS;
            aux[(ui & 1) * 512 + tid] = rb * __builtin_amdgcn_sqrtf(qa); aux[(ui & 1) * 512 + 256 + tid] = __builtin_amdgcn_rsqf(qa); }
    }
    __device__ __forceinline__ void prepare(const Unit& u, int ui, int tid) const { f32x4 pr[6]; prepare_load(u, tid, pr); asm volatile("s_waitcnt vmcnt(0)" : "+v"(pr[0]), "+v"(pr[1]), "+v"(pr[2]), "+v"(pr[3]), "+v"(pr[4]), "+v"(pr[5]) :: "memory"); prepare_commit(pr, ui, tid); }
    __device__ __forceinline__ void midscale(f32x4 (&acc)[2][2][4][2], const Unit& u, int wr, int fr, int ui) const {
#pragma unroll
        for (int ai = 0; ai < 2; ++ai)
#pragma unroll
            for (int m = 0; m < 4; ++m) { const float r = aux[(ui & 1) * 512 + ai * HALF + wr * 64 + m * 16 + fr];
#pragma unroll
                for (int bj = 0; bj < 2; ++bj)
#pragma unroll
                    for (int n = 0; n < 2; ++n) acc[ai][bj][m][n] = acc[ai][bj][m][n] * r; }
    }
    __device__ __forceinline__ void operator()(const f32x4 (&acc)[2][2][4][2], const Unit& u, int wr, int wc, int fr, int fq, int ui) const {
        size_t z_ = 0; asm volatile("" : "+s"(z_)); unsigned char* w = ws + z_; bf16_t* XB = (bf16_t*)(w + EW_XB); float* SSQ = (float*)(w + EW_SSQ);
        const int row0 = u.pm * BM + wr * 64 + fr, col0 = u.pn * BM + wc * 32 + 8 * fq;
#pragma unroll
        for (int ai = 0; ai < 2; ++ai) {
            u32x4 xo[4][2];
#pragma unroll
            for (int m = 0; m < 4; ++m)
#pragma unroll
                for (int bj = 0; bj < 2; ++bj) xo[m][bj] = *(const u32x4*)(XB + (size_t)(row0 + ai * HALF + m * 16) * 1024 + col0 + bj * HALF);
            asm volatile("" : "+v"(xo[0][0]), "+v"(xo[0][1]), "+v"(xo[1][0]), "+v"(xo[1][1]), "+v"(xo[2][0]), "+v"(xo[2][1]), "+v"(xo[3][0]), "+v"(xo[3][1]));
#pragma unroll
            for (int m = 0; m < 4; ++m) { const int row = row0 + ai * HALF + m * 16; float ss = 0.f, ra = 1.0f;
                if (MID) ra = aux[(ui & 1) * 512 + 256 + ai * HALF + wr * 64 + m * 16 + fr];
#pragma unroll
                for (int bj = 0; bj < 2; ++bj) { const size_t off = (size_t)row * 1024 + col0 + bj * HALF;
                    const u32x4 xv = xo[m][bj];
                    f32x4 x0, x1;
                    x0[0] = __uint_as_float(xv.x << 16); x0[1] = __uint_as_float(xv.x & 0xffff0000u); x0[2] = __uint_as_float(xv.y << 16); x0[3] = __uint_as_float(xv.y & 0xffff0000u);
                    x1[0] = __uint_as_float(xv.z << 16); x1[1] = __uint_as_float(xv.z & 0xffff0000u); x1[2] = __uint_as_float(xv.w << 16); x1[3] = __uint_as_float(xv.w & 0xffff0000u);
                    x0 = x0 + (MID ? acc[ai][bj][m][0] * ra : acc[ai][bj][m][0]); x1 = x1 + (MID ? acc[ai][bj][m][1] * ra : acc[ai][bj][m][1]);
                    *(u32x4*)(XB + off) = pack8(x0, x1);
                    ss += ((x0[0] * x0[0] + x0[1] * x0[1]) + (x0[2] * x0[2] + x0[3] * x0[3])) + ((x1[0] * x1[0] + x1[1] * x1[1]) + (x1[2] * x1[2] + x1[3] * x1[3])); }
                ss = xl_sum_x16(ss); ss = xl_sum_x32(ss);
                if (fq == 0) SSQ[(size_t)row * 16 + u.pn * 4 + wc] = ss; }
        }
    }
};
struct EpiQ {
    static constexpr bool PERM = true, AFTER_DRAIN = false, MIDSCALE = false, PREP = true; static constexpr int MID_T = 0;
    const float* SSQ; bf16_t* QM; float qscale; PG8_LAS float* aux;
    __device__ __forceinline__ void midscale(f32x4 (&)[2][2][4][2], const Unit&, int, int, int) const {}
    __device__ __forceinline__ void prepare(const Unit& u, int ui, int tid) const { prep_rstd(SSQ, aux, u, ui, tid); }
    __device__ __forceinline__ void prepare_load(const Unit& u, int tid, f32x4 (&pr)[6]) const { prep_rstd_load(SSQ, u, tid, pr); }
    __device__ __forceinline__ void prepare_commit(const f32x4 (&pr)[6], int ui, int tid) const { prep_rstd_commit(aux, pr, ui, tid); }
    __device__ __forceinline__ void operator()(const f32x4 (&acc)[2][2][4][2], const Unit& u, int wr, int wc, int fr, int fq, int ui) const {
        const int row0 = u.pm * BM + wr * 64 + fr, col0 = u.pn * BM + wc * 32 + 8 * fq;
        float rs[2][4]; aux_rstd(aux, ui, wr, fr, rs);
#pragma unroll
        for (int ai = 0; ai < 2; ++ai)
#pragma unroll
            for (int m = 0; m < 4; ++m) { const float r = rs[ai][m] * qscale;
                const int rbk = u.pm * 8 + wr * 2 + ai * 4 + (m >> 1), rr = fr + 16 * (m & 1);
                bf16_t* tp = QM + (size_t)(rbk * 4 + u.pn) * 8192 + (size_t)(((2 * wc + (fq >> 1)) * 32 + rr) * 2 + (fq & 1)) * 8;
#pragma unroll
                for (int bj = 0; bj < 2; ++bj) *(u32x4*)(tp + bj * 8 * 512) = pack8(acc[ai][bj][m][0] * r, acc[ai][bj][m][1] * r); }
    }
};
struct EpiGU {
    static constexpr bool PERM = true, AFTER_DRAIN = false, MIDSCALE = false, PREP = true; static constexpr int MID_T = 0;
    const float* SSQ; bf16_t* H; PG8_LAS float* aux;
    __device__ __forceinline__ void midscale(f32x4 (&)[2][2][4][2], const Unit&, int, int, int) const {}
    __device__ __forceinline__ void prepare(const Unit& u, int ui, int tid) const { prep_rstd(SSQ, aux, u, ui, tid); }
    __device__ __forceinline__ void prepare_load(const Unit& u, int tid, f32x4 (&pr)[6]) const { prep_rstd_load(SSQ, u, tid, pr); }
    __device__ __forceinline__ void prepare_commit(const f32x4 (&pr)[6], int ui, int tid) const { prep_rstd_commit(aux, pr, ui, tid); }
    __device__ __forceinline__ void operator()(const f32x4 (&acc)[2][2][4][2], const Unit& u, int wr, int wc, int fr, int fq, int ui) const {
        const int row0 = u.pm * BM + wr * 64 + fr, col0 = u.pn * HALF + wc * 32 + 8 * fq;
        float rs[2][4]; aux_rstd(aux, ui, wr, fr, rs);
#pragma unroll
        for (int ai = 0; ai < 2; ++ai)
#pragma unroll
            for (int m = 0; m < 4; ++m) { const float r = rs[ai][m]; f32x4 h[2];
#pragma unroll
                for (int n = 0; n < 2; ++n) { const f32x4 g = acc[ai][0][m][n] * r, uu = acc[ai][1][m][n] * r;
#pragma unroll
                    for (int i = 0; i < 4; ++i) h[n][i] = g[i] * uu[i] * __builtin_amdgcn_rcpf(1.0f + __builtin_amdgcn_exp2f(-E_LOG2E * g[i])); }
                *(u32x4*)(H + (size_t)(row0 + ai * HALF + m * 16) * 2816 + col0) = pack8(h[0], h[1]); }
    }
};
struct EpiKV {
    static constexpr bool PERM = true, AFTER_DRAIN = false, MIDSCALE = false, PREP = false; static constexpr int MID_T = 0;
    float *mk_out, *mv_out; bf16_t *MK, *MVt; int pn0;
    __device__ __forceinline__ void midscale(f32x4 (&)[2][2][4][2], const Unit&, int, int, int) const {}
    __device__ __forceinline__ void prepare(const Unit&, int, int) const {}
    __device__ __forceinline__ void prepare_load(const Unit&, int, f32x4 (&)[6]) const {}
    __device__ __forceinline__ void prepare_commit(const f32x4 (&)[6], int, int) const {}
    __device__ __forceinline__ void operator()(const f32x4 (&acc)[2][2][4][2], const Unit& u, int wr, int wc, int fr, int fq, int ui) const {
        const int pn = u.pn + pn0, l = pn >> 3, isv = (pn >> 2) & 1, hh = pn & 3, b = u.pm;
        const int key0 = wr * 64 + fr, col0 = hh * 256 + wc * 32 + 8 * fq;
        float* of = (isv ? mv_out : mk_out) + (size_t)(l * 4 + b) * 256 * 1024 + (size_t)key0 * 1024 + col0;
#pragma unroll
        for (int ai = 0; ai < 2; ++ai)
#pragma unroll
            for (int m = 0; m < 4; ++m) { float* p = of + (size_t)(ai * HALF + m * 16) * 1024;
#pragma unroll
                for (int bj = 0; bj < 2; ++bj) { *(f32x4*)(p + bj * HALF) = acc[ai][bj][m][0]; *(f32x4*)(p + bj * HALF + 4) = acc[ai][bj][m][1]; }
                asm volatile("" ::: "memory"); }
        bf16_t* ob = (isv ? MVt : MK) + ((size_t)(l * 4 + b) * 256 + key0) * 1024 + col0;
#pragma unroll
        for (int ai = 0; ai < 2; ++ai)
#pragma unroll
            for (int m = 0; m < 4; ++m) {
#pragma unroll
                for (int bj = 0; bj < 2; ++bj) *(u32x4*)(ob + (size_t)(ai * HALF + m * 16) * 1024 + bj * HALF) = pack8(acc[ai][bj][m][0], acc[ai][bj][m][1]);
                asm volatile("" ::: "memory"); }
    }
};
template <class Epi, class Sched, bool ALIGN_EPI = false, bool SP2 = false, bool KREV = false>
__device__ __forceinline__ void gemm_phase(PG8_LAS unsigned char* lds, const Gemm g, const Sched& S, const Epi& E, int wave_id) {
    int tid_ = wave_id * 64 + pg8_lane_id(); asm volatile("" : "+v"(tid_));
    const int tid = tid_, wid = __builtin_amdgcn_readfirstlane(tid >> 6), lane = tid & 63, wr = wid >> 2, wc = wid & 3, fr = lane & 15, fq = lane >> 4;
    const int K = g.K, nt = K / BK;
    unsigned voffA[2], voffB[2];
#pragma unroll
    for (int i = 0; i < 2; ++i) { int R, C; stage_rc(tid * 16 + i * 8192, R, C); const int Rb = Epi::PERM ? ((R & ~31) + perm32(R & 31)) : R;
        voffA[i] = (unsigned)(R * K + C) * 2u; voffB[i] = (unsigned)(Rb * K + C) * 2u; }
    const ptrdiff_t kstep = KREV ? -(ptrdiff_t)(BK * 2) : (ptrdiff_t)(BK * 2);
    const size_t k0off = KREV ? (size_t)(nt - 1) * (BK * 2) : 0;
    const size_t hstep = (size_t)HALF * K * 2;
    const size_t tstep = 2 * hstep;
    const unsigned ldsw = (unsigned)wid * 1024u;
    const int aoff = lds_byte(wr * 64 + fr, fq * 8), boff = lds_byte(wc * 32 + fr, fq * 8);
#define PG8_SA(b, h) (((b) * 2 + (h)) * HTB)
#define PG8_SB(b, h) ((4 + (b) * 2 + (h)) * HTB)
#define PG8_STAGE(bufoff, gbase, voff) do { _Pragma("unroll") for (int _i = 0; _i < 2; ++_i) \
        __builtin_amdgcn_global_load_lds((const unsigned*)((const char*)(gbase) + (voff)[_i]), (PG8_LAS unsigned*)(lds + (bufoff) + ldsw + _i * 8192), 16, 0, 0); } while (0)
#define PG8_LDA(dst, b, h) do { _Pragma("unroll") for (int m = 0; m < 4; ++m) _Pragma("unroll") for (int k = 0; k < 2; ++k) dst[m][k] = *(const PG8_LAS bf16x8*)(lds + PG8_SA(b, h) + aoff + m * 2048 + k * 1024); } while (0)
#define PG8_LDB(dst, b, h) do { _Pragma("unroll") for (int n = 0; n < 2; ++n) _Pragma("unroll") for (int k = 0; k < 2; ++k) dst[n][k] = *(const PG8_LAS bf16x8*)(lds + PG8_SB(b, h) + boff + n * 2048 + k * 1024); } while (0)
#define PG8_MMA(ai, bj, At, Bt) do { __builtin_amdgcn_s_setprio(1); _Pragma("unroll") for (int m = 0; m < 4; ++m) _Pragma("unroll") for (int n = 0; n < 2; ++n) _Pragma("unroll") for (int k = 0; k < 2; ++k) \
        acc[ai][bj][m][n] = __builtin_amdgcn_mfma_f32_16x16x32_bf16(Bt[n][k], At[m][k], acc[ai][bj][m][n], 0, 0, 0); __builtin_amdgcn_s_setprio(0); } while (0)
#define PG8_WAIT_V(n) asm volatile("s_waitcnt vmcnt(" #n ")" ::: "memory")
#define PG8_WAIT_L(n) asm volatile("s_waitcnt lgkmcnt(" #n ")" ::: "memory")
#define PG8_BAR __builtin_amdgcn_s_barrier()
#define PG8_SCHED __builtin_amdgcn_sched_barrier(0)
    Unit cur, nxt; int ui = 0;
    if (!S.next(0, cur)) return;
    f32x4 acc[2][2][4][2];
#pragma unroll
    for (int a = 0; a < 2; ++a)
#pragma unroll
        for (int b = 0; b < 2; ++b)
#pragma unroll
            for (int m = 0; m < 4; ++m)
#pragma unroll
                for (int n = 0; n < 2; ++n) acc[a][b][m][n] = (f32x4){0.f, 0.f, 0.f, 0.f};
    bf16x8 At[4][2], B0[2][2], B1[2][2];
    const char* cA = (const char*)g.A + (size_t)cur.pm * tstep + k0off; const char* cB = (const char*)g.Bt + (size_t)cur.pn * tstep + k0off;
    S.a_ready(cur);
    if constexpr (Epi::PREP) E.prepare(cur, 0, tid);
    if constexpr (SP2) {
        PG8_STAGE(PG8_SB(0, 0), cB, voffB); PG8_STAGE(PG8_SB(0, 1), cB + hstep, voffB); PG8_STAGE(PG8_SA(0, 0), cA, voffA); PG8_STAGE(PG8_SA(0, 1), cA + hstep, voffA);
        if (wr == 1) PG8_BAR;
        PG8_WAIT_V(2); PG8_BAR;
        PG8_STAGE(PG8_SB(1, 0), cB + kstep, voffB); PG8_STAGE(PG8_SA(1, 0), cA + kstep, voffA); PG8_STAGE(PG8_SB(1, 1), cB + hstep + kstep, voffB);
        PG8_WAIT_V(6); PG8_BAR;
    } else {
        PG8_STAGE(PG8_SB(0, 0), cB, voffB); PG8_STAGE(PG8_SA(0, 0), cA, voffA); PG8_STAGE(PG8_SB(0, 1), cB + hstep, voffB); PG8_STAGE(PG8_SA(0, 1), cA + hstep, voffA);
        if (wr == 1) PG8_BAR;
        PG8_WAIT_V(4); PG8_BAR;
        PG8_STAGE(PG8_SB(1, 0), cB + kstep, voffB); PG8_STAGE(PG8_SA(1, 0), cA + kstep, voffA); PG8_STAGE(PG8_SB(1, 1), cB + hstep + kstep, voffB);
        PG8_WAIT_V(6); PG8_BAR;
    }
    for (;;) {
        const bool has_next = S.next(ui + 1, nxt);
        const char* nA = has_next ? (const char*)g.A + (size_t)nxt.pm * tstep + k0off : cA; const char* nB = has_next ? (const char*)g.Bt + (size_t)nxt.pn * tstep + k0off : cB;
        for (int t = 0; t < nt; t += 2) {
            if constexpr (Epi::MIDSCALE) { if (t == Epi::MID_T) E.midscale(acc, cur, wr, fr, ui); }
            const bool last = (t == nt - 2);
            const char* a1 = cA + (ptrdiff_t)(t + 1) * kstep;
            const char* a2 = last ? nA : cA + (ptrdiff_t)(t + 2) * kstep; const char* b2 = last ? nB : cB + (ptrdiff_t)(t + 2) * kstep;
            const char* a3 = a2 + kstep; const char* b3 = b2 + kstep;
            if (last && has_next) S.a_ready(nxt);
            if constexpr (SP2) {
            PG8_LDB(B0, 0, 0); PG8_LDB(B1, 0, 1); PG8_SCHED; PG8_LDA(At, 0, 0); PG8_STAGE(PG8_SA(1, 1), a1 + hstep, voffA);
            PG8_WAIT_V(8); PG8_WAIT_L(0); PG8_BAR; PG8_MMA(0, 0, At, B0); PG8_MMA(0, 1, At, B1); PG8_BAR; PG8_SCHED;
            PG8_LDA(At, 0, 1); PG8_STAGE(PG8_SB(0, 0), b2, voffB); PG8_STAGE(PG8_SB(0, 1), b2 + hstep, voffB); PG8_STAGE(PG8_SA(0, 0), a2, voffA);
            PG8_WAIT_V(8); PG8_WAIT_L(0); PG8_BAR; PG8_MMA(1, 0, At, B0); PG8_MMA(1, 1, At, B1); PG8_BAR; PG8_SCHED;
            PG8_LDB(B0, 1, 0); PG8_LDB(B1, 1, 1); PG8_SCHED; PG8_LDA(At, 1, 0); PG8_STAGE(PG8_SA(0, 1), a2 + hstep, voffA);
            PG8_WAIT_V(8); PG8_WAIT_L(0); PG8_BAR; PG8_MMA(0, 0, At, B0); PG8_MMA(0, 1, At, B1); PG8_BAR; PG8_SCHED;
            PG8_LDA(At, 1, 1); PG8_STAGE(PG8_SB(1, 0), b3, voffB); PG8_STAGE(PG8_SB(1, 1), b3 + hstep, voffB); PG8_STAGE(PG8_SA(1, 0), a3, voffA);
            PG8_WAIT_V(8); PG8_WAIT_L(0); PG8_BAR; PG8_MMA(1, 0, At, B0); PG8_MMA(1, 1, At, B1); PG8_BAR; PG8_SCHED;
            } else {
            PG8_LDB(B0, 0, 0); PG8_SCHED; PG8_LDA(At, 0, 0); PG8_STAGE(PG8_SA(1, 1), a1 + hstep, voffA);
            PG8_WAIT_L(8); PG8_BAR; PG8_WAIT_L(0); PG8_MMA(0, 0, At, B0); PG8_BAR; PG8_SCHED;
            PG8_LDB(B1, 0, 1); PG8_STAGE(PG8_SB(0, 0), b2, voffB);
            PG8_BAR; PG8_WAIT_L(0); PG8_MMA(0, 1, At, B1); PG8_BAR;
            PG8_LDA(At, 0, 1); PG8_STAGE(PG8_SA(0, 0), a2, voffA);
            PG8_BAR; PG8_WAIT_L(0); PG8_MMA(1, 0, At, B0); PG8_BAR; PG8_SCHED;
            PG8_STAGE(PG8_SB(0, 1), b2 + hstep, voffB);
            PG8_WAIT_V(6); PG8_BAR; PG8_MMA(1, 1, At, B1); PG8_BAR;
            PG8_LDB(B0, 1, 0); PG8_SCHED; PG8_LDA(At, 1, 0); PG8_STAGE(PG8_SA(0, 1), a2 + hstep, voffA);
            PG8_WAIT_L(8); PG8_BAR; PG8_WAIT_L(0); PG8_MMA(0, 0, At, B0); PG8_BAR; PG8_SCHED;
            PG8_LDB(B1, 1, 1); PG8_STAGE(PG8_SB(1, 0), b3, voffB);
            PG8_BAR; PG8_WAIT_L(0); PG8_MMA(0, 1, At, B1); PG8_BAR;
            PG8_LDA(At, 1, 1); PG8_STAGE(PG8_SA(1, 0), a3, voffA);
            PG8_BAR; PG8_WAIT_L(0); PG8_MMA(1, 0, At, B0); PG8_BAR; PG8_SCHED;
            PG8_STAGE(PG8_SB(1, 1), b3 + hstep, voffB);
            PG8_WAIT_V(6); PG8_BAR; PG8_MMA(1, 1, At, B1); PG8_BAR;
            }
        }
        if constexpr (ALIGN_EPI) { if (wr == 0) PG8_BAR; }
        if constexpr (!Epi::AFTER_DRAIN) { E(acc, cur, wr, wc, fr, fq, ui); S.done(cur); }
        if (!has_next) break;
#pragma unroll
        for (int a = 0; a < 2; ++a)
#pragma unroll
            for (int b = 0; b < 2; ++b)
#pragma unroll
                for (int m = 0; m < 4; ++m)
#pragma unroll
                    for (int n = 0; n < 2; ++n) acc[a][b][m][n] = (f32x4){0.f, 0.f, 0.f, 0.f};
        cur = nxt; cA = nA; cB = nB; ++ui;
        if constexpr (Epi::PREP) E.prepare(cur, ui, tid);
        if constexpr (ALIGN_EPI) { if (wr == 1) PG8_BAR; }
    }
    PG8_WAIT_V(0);
    if constexpr (!ALIGN_EPI) { if (wr == 0) PG8_BAR; }
    PG8_BAR;
    if constexpr (Epi::AFTER_DRAIN) { E.fused(acc, cur, wr, wc, fr, fq, lds, wid, lane); S.done(cur); }
#undef PG8_SA
#undef PG8_SB
#undef PG8_STAGE
#undef PG8_LDA
#undef PG8_LDB
#undef PG8_MMA
#undef PG8_WAIT_V
#undef PG8_WAIT_L
#undef PG8_BAR
#undef PG8_SCHED
}
}
constexpr int NWAVES = 8;
constexpr int D = 1024, NB = 4, T = 4096, NL = 4, BS = 32, NS = 16, PAST = 1024, INW = 2560, NMEM = 256, DFF = 2816;
constexpr int MP = NB * T, MS = BS * NS, M = MP + MS;
constexpr float EPS = 1e-6f, LOG2E = 1.4426950408889634f;
constexpr float C_SB = 0.125f * LOG2E, C_MEM = 0.0625f * LOG2E;
constexpr float SB_EXIT = 0x1p-135f;
constexpr size_t MiB = 1u << 20;
constexpr size_t WS_CTL = 0, CTL_ZERO_BYTES = 1 * MiB;
constexpr size_t WS_WL = 2 * MiB, WL_STRIDE = 28 * MiB;
constexpr size_t WL_IN = 0, WL_OUT = 5 * MiB, WL_MQ = 7 * MiB, WL_MO = 9 * MiB, WL_GU = 11 * MiB, WL_DN = 22 * MiB;
constexpr size_t WS_WMKV = 114 * MiB, WS_MEMB = 130 * MiB, WS_MK = 132 * MiB, WS_MV = 140 * MiB, WS_SSQ = 148 * MiB, WS_SBSS = 150 * MiB;
constexpr size_t WS_XF = 152 * MiB, WS_XB = 218 * MiB, WS_U = 251 * MiB, WS_VA = 268 * MiB, WS_Q = 285 * MiB, WS_K = 302 * MiB, WS_V = 319 * MiB;
constexpr size_t WS_CAT = 336 * MiB, WS_QM = 369 * MiB, WS_OM = 402 * MiB, WS_H = 435 * MiB, WS_WT = 526 * MiB, WS_SASS = 527 * MiB, WS_END = 529 * MiB;
constexpr int CW_BAR = 4096, CW_SBQ = 8192, CW_GRP = 12288, CW_GMASK = 13312;
constexpr int RING_OFF = 0, RING_BYTES = 131072, LDSCTL_OFF = RING_BYTES, MISC_OFF = LDSCTL_OFF + 320, AUX_OFF = LDSCTL_OFF + 1024, OST_OFF = AUX_OFF + 8192, LDS_BYTES = 163840;

#define GAS __attribute__((address_space(1)))
#define LAS __attribute__((address_space(3)))
typedef unsigned short bf16;
typedef unsigned v4u __attribute__((ext_vector_type(4)));
typedef unsigned v2u __attribute__((ext_vector_type(2)));
typedef float f32x4 __attribute__((ext_vector_type(4)));
typedef float f32x16 __attribute__((ext_vector_type(16)));
typedef short bf16x8 __attribute__((ext_vector_type(8)));
typedef short s16x4 __attribute__((ext_vector_type(4)));
typedef GAS unsigned gu32;
#define RLX_AGENT __ATOMIC_RELAXED, __HIP_MEMORY_SCOPE_AGENT
#define LDS_WAIT() asm volatile("s_waitcnt lgkmcnt(0)" ::: "memory")
#define VM_WAIT() asm volatile("s_waitcnt vmcnt(0)" ::: "memory")
__device__ __forceinline__ unsigned cvtpk(float lo, float hi) { unsigned r; asm volatile("v_cvt_pk_bf16_f32 %0, %1, %2" : "=v"(r) : "v"(lo), "v"(hi)); return r; }
__device__ __forceinline__ float bf_lo(unsigned w) { return __uint_as_float(w << 16); }
__device__ __forceinline__ float bf_hi(unsigned w) { return __uint_as_float(w & 0xffff0000u); }
__device__ __forceinline__ int lane_id() { int l_; asm volatile("v_mbcnt_lo_u32_b32 %0, -1, 0\n\tv_mbcnt_hi_u32_b32 %0, -1, %0" : "=v"(l_)); return l_; }
__device__ __forceinline__ int crow(int r, int hi) { return (r & 3) + 8 * (r >> 2) + 4 * hi; }
__device__ __forceinline__ s16x4 tr_read(unsigned addr) { return __builtin_bit_cast(s16x4, __builtin_amdgcn_ds_read_tr16_b64_v4i16((LAS s16x4*)(uintptr_t)addr)); }
using pg8::xl_sum16; using pg8::xl_sum_x16; using pg8::xl_sum_x32; using pg8::xl_max_x32; using pg8::xl_other_x32;
#define MFMA32(a, b, c) __builtin_amdgcn_mfma_f32_32x32x16_bf16((a), (b), (c), 0, 0, 0)

#ifndef REP_A
#define REP_A 1
#endif
#ifndef REP_B
#define REP_B 1
#endif
#ifndef REP_E
#define REP_E 1
#endif
#ifndef REP_F
#define REP_F 1
#endif
#ifndef REP_H
#define REP_H 1
#endif
#ifndef REP_P
#define REP_P 1
#endif
#ifndef REP_SGU
#define REP_SGU 1
#endif
#ifndef REP_SB
#define REP_SB 1
#endif
#define XB_TMO      128
#define XB_XCNT(j)  (256  + 64 * (j))
#define XB_XSUB(j)  (1280 + 64 * (j))
#define XB_XGEN(j)  (2304 + 64 * (j))
#define XB_TOP      3328
#define XB_TOPGEN   3392
#define XCD_BAR_WORDS 3456
#define XB_SPIN_CAP (1u << 18)

__device__ __forceinline__ unsigned xb_ld(unsigned* p)              { return __hip_atomic_load(p, __ATOMIC_RELAXED, __HIP_MEMORY_SCOPE_AGENT); }
__device__ __forceinline__ unsigned xb_add(unsigned* p, unsigned v) { return __hip_atomic_fetch_add(p, v, __ATOMIC_RELAXED, __HIP_MEMORY_SCOPE_AGENT); }
__device__ __forceinline__ unsigned xb_xcc_id() { return (unsigned)__builtin_amdgcn_s_getreg((3 << 11) | 20) & 0xFu; }
#define XB_SPIN(cond, bar) do { unsigned _sp = 0; while (cond) { __builtin_amdgcn_s_sleep(1); \
    if ((++_sp & 255u) == 0u) { if (xb_ld(&(bar)[XB_TMO])) break; if (_sp > XB_SPIN_CAP) { atomicAdd(&(bar)[XB_TMO], 1u); break; } } } } while (0)

struct XcdBarrier {
    unsigned* bar; unsigned x;
    volatile LAS unsigned* st;
};

__device__ __forceinline__ XcdBarrier xcd_barrier_post(unsigned* bar, volatile LAS unsigned* st, int tid) {
    XcdBarrier b; b.bar = bar; b.x = xb_xcc_id(); b.st = st;
    if (tid == 0) (void)xb_add(&bar[XB_XCNT(b.x)], 1u);
    return b;
}
__device__ __forceinline__ void xcd_barrier_complete(unsigned* bar, unsigned x, unsigned& nloc, unsigned& nx) {
    const unsigned G = gridDim.x * gridDim.y * gridDim.z;
    unsigned sum, cnt, mine, sp = 0u;
    for (;;) {
        sum = 0u; cnt = 0u; mine = 0u;
#pragma unroll
        for (unsigned j = 0; j < 16; ++j) { const unsigned c = xb_ld(&bar[XB_XCNT(j)]); sum += c; cnt += (c > 0u) ? 1u : 0u; mine = (j == x) ? c : mine; }
        if (sum == G) break;
        __builtin_amdgcn_s_sleep(1);
        if ((++sp & 255u) == 0u) { if (xb_ld(&bar[XB_TMO])) break; if (sp > XB_SPIN_CAP) { atomicAdd(&bar[XB_TMO], 1u); break; } }
    }
    nloc = mine > 0u ? mine : 1u; nx = cnt > 0u ? cnt : 1u;
}

__device__ __forceinline__ void xcd_barrier(const XcdBarrier& b, int tid) {
    asm volatile("s_waitcnt vmcnt(0)" ::: "memory");
    __syncthreads();
    if (tid == 0) {
        size_t bz_ = 0; unsigned bx = b.x; asm volatile("" : "+s"(bz_), "+s"(bx)); unsigned* bar = b.bar + bz_;
        __builtin_amdgcn_s_waitcnt(0);
        unsigned nloc = b.st[0], nx = b.st[1];
        if (nloc == 0u) { xcd_barrier_complete(bar, bx, nloc, nx); b.st[0] = nloc; b.st[1] = nx; }
        const unsigned old = xb_add(&bar[XB_XSUB(bx)], 1u);
        const unsigned gen = old / nloc;
        if (old + 1u == (gen + 1u) * nloc) {
            __builtin_amdgcn_fence(__ATOMIC_RELEASE, "agent");
            asm volatile("s_waitcnt vmcnt(0)" ::: "memory");
            const unsigned og = xb_add(&bar[XB_TOP], 1u);
            const unsigned tg = og / nx;
            if (og + 1u == (tg + 1u) * nx) xb_add(&bar[XB_TOPGEN], 1u);
            else XB_SPIN(xb_ld(&bar[XB_TOPGEN]) == tg, bar);
            __builtin_amdgcn_fence(__ATOMIC_ACQUIRE, "agent");
            xb_add(&bar[XB_XGEN(bx)], 1u);
            asm volatile("s_waitcnt vmcnt(0)" ::: "memory");
        } else {
            XB_SPIN(xb_ld(&bar[XB_XGEN(bx)]) == gen, bar);
            __builtin_amdgcn_fence(__ATOMIC_ACQUIRE, "agent");
            asm volatile("s_waitcnt vmcnt(0)" ::: "memory");
        }
    }
    __syncthreads();
}


struct Frame {
    LAS unsigned char* lds; unsigned lds0;
    int wave, G, bid;
};
struct Args {
    const float* in[25]; float* out; unsigned char* ws; int ph_lo, ph_hi;
};
__device__ __forceinline__ float* out_y_p(float* o) { return o; }
__device__ __forceinline__ float* out_y_s(float* o) { return o + (size_t)MP * D; }
__device__ __forceinline__ float* out_sbk_p(float* o) { return o + (size_t)M * D; }
__device__ __forceinline__ float* out_sbv_p(float* o) { return out_sbk_p(o) + (size_t)NL * MP * 512; }
__device__ __forceinline__ float* out_mk_p(float* o) { return out_sbv_p(o) + (size_t)NL * MP * 512; }
__device__ __forceinline__ float* out_mv_p(float* o) { return out_mk_p(o) + (size_t)NL * NB * NMEM * D; }
__device__ __forceinline__ float* out_sbk_s(float* o) { return out_mv_p(o) + (size_t)NL * NB * NMEM * D; }
__device__ __forceinline__ float* out_sbv_s(float* o) { return out_sbk_s(o) + (size_t)NL * MS * 512; }
__device__ __forceinline__ float* out_sguv_s(float* o) { return out_sbv_s(o) + (size_t)NL * MS * 512; }

struct TrItem { const float* src; const float* gain; bf16* dst; int ldw, ldd; };
__device__ __forceinline__ TrItem tr_decode(const Args& a, unsigned char* ws, int it) {
    constexpr int I_IN = 640, I_SQ = 256, I_G = 704, I_L = I_IN + 3 * I_SQ + 3 * I_G + 2 * I_SQ;
    const int l = it / I_L; int r = it % I_L; unsigned char* wl = ws + WS_WL + (size_t)l * WL_STRIDE; TrItem t;
    if (r < I_IN) { const int kb = r / 40, nb = r % 40; t.src = a.in[8] + (size_t)l * D * INW + (size_t)(kb * 64) * INW + nb * 64; t.ldw = INW; t.gain = a.in[7] + l * D + kb * 64; t.dst = (bf16*)(wl + WL_IN) + (size_t)(nb * 64) * D + kb * 64; t.ldd = D; return t; } r -= I_IN;
    if (r < I_SQ) { const int kb = r / 16, nb = r % 16; const int ks = (kb * 64 + 512) & 1023;
        t.src = a.in[14] + (size_t)l * D * D + (size_t)ks * D + nb * 64; t.ldw = D; t.gain = ks < 512 ? a.in[12] + l * 512 + ks : a.in[13] + l * 512 + (ks - 512); t.dst = (bf16*)(wl + WL_OUT) + (size_t)(nb * 64) * D + kb * 64; t.ldd = D; return t; } r -= I_SQ;
    if (r < I_SQ) { const int kb = r / 16, nb = r % 16; t.src = a.in[16] + (size_t)l * D * D + (size_t)(kb * 64) * D + nb * 64; t.ldw = D; t.gain = a.in[15] + l * D + kb * 64; t.dst = (bf16*)(wl + WL_MQ) + (size_t)(nb * 64) * D + kb * 64; t.ldd = D; return t; } r -= I_SQ;
    if (r < I_SQ) { const int kb = r / 16, nb = r % 16; t.src = a.in[19] + (size_t)l * D * D + (size_t)(kb * 64) * D + nb * 64; t.ldw = D; t.gain = nullptr; t.dst = (bf16*)(wl + WL_MO) + (size_t)(nb * 64) * D + kb * 64; t.ldd = D; return t; } r -= I_SQ;
    if (r < 2 * I_G) { const int up = r >= I_G; if (up) r -= I_G; const int kb = r / 44, nb = r % 44; const int j0 = nb * 64;
        t.src = a.in[up ? 22 : 21] + (size_t)l * D * DFF + (size_t)(kb * 64) * DFF + j0; t.ldw = DFF; t.gain = a.in[20] + l * D + kb * 64; t.dst = (bf16*)(wl + WL_GU) + (size_t)(256 * (j0 >> 7) + (up ? 128 : 0) + (j0 & 127)) * D + kb * 64; t.ldd = D; return t; } r -= 2 * I_G;
    if (r < I_G) { const int kb = r / 16, nb = r % 16; t.src = a.in[23] + (size_t)l * DFF * D + (size_t)(kb * 64) * D + nb * 64; t.ldw = D; t.gain = nullptr; t.dst = (bf16*)(wl + WL_DN) + (size_t)(nb * 64) * DFF + kb * 64; t.ldd = DFF; return t; } r -= I_G;
    { const int isv = r >= I_SQ; if (isv) r -= I_SQ; const int kb = r / 16, nb = r % 16;
      t.src = a.in[isv ? 18 : 17] + (size_t)l * D * D + (size_t)(kb * 64) * D + nb * 64; t.ldw = D; t.gain = nullptr; t.dst = (bf16*)(ws + WS_WMKV) + (size_t)((l * 2 + isv) * 1024 + nb * 64) * D + kb * 64; t.ldd = D; return t; }
}
__device__ __forceinline__ void tr_load(const TrItem& t, f32x4 (&v)[16], f32x4 (&g)[2], int lane) {
    const int kr0 = lane >> 4, nc = (lane & 15) * 4;
#pragma unroll
    for (int i = 0; i < 16; ++i) v[i] = *(const GAS f32x4*)((const GAS float*)t.src + (unsigned)((kr0 + 4 * i) * t.ldw + nc));
    const f32x4 one = (f32x4){1.f, 1.f, 1.f, 1.f};
    g[0] = t.gain ? *(const f32x4*)(t.gain + 8 * (lane & 7)) : one; g[1] = t.gain ? *(const f32x4*)(t.gain + 8 * (lane & 7) + 4) : one;
}
__device__ __forceinline__ void tr_store(const TrItem& t, const f32x4 (&v)[16], const f32x4 (&g)[2], LAS float* scr, int lane) {
    const int kr0 = lane >> 4, nc = (lane & 15) * 4;
#pragma unroll
    for (int i = 0; i < 16; ++i) { const int kr = kr0 + 4 * i; LAS float* p = scr + kr * 64; const f32x4 x = v[i];
        p[(nc + 0) ^ (kr & 31)] = x[0]; p[(nc + 1) ^ (kr & 31)] = x[1]; p[(nc + 2) ^ (kr & 31)] = x[2]; p[(nc + 3) ^ (kr & 31)] = x[3]; }
    LDS_WAIT(); asm volatile("" ::: "memory");
    const int c = lane & 7;
#pragma unroll
    for (int j = 0; j < 8; ++j) { const int n = (lane >> 3) + 8 * j; float s[8];
#pragma unroll
        for (int i = 0; i < 8; ++i) s[i] = scr[(8 * c + i) * 64 + (n ^ ((8 * c + i) & 31))] * g[i >> 2][i & 3];
        v4u o; o.x = cvtpk(s[0], s[1]); o.y = cvtpk(s[2], s[3]); o.z = cvtpk(s[4], s[5]); o.w = cvtpk(s[6], s[7]);
        *(GAS v4u*)((GAS bf16*)t.dst + (unsigned)(n * t.ldd + 8 * c)) = o; }
    LDS_WAIT(); asm volatile("" ::: "memory");
}
template <bool PRO> __device__ __forceinline__ int cv_item(int l, int j) { return PRO ? (j < 4032 ? j : 4032 * (1 + (j - 4032) / 512) + 3520 + (j - 4032) % 512) : l * 4032 + j; }
template <bool PRO> __device__ __forceinline__ void convert_items(const Args& a, const Frame& F, int l, int gw, int ngw, int lo, int hi) {
    LAS float* scr = (LAS float*)(F.lds + RING_OFF + F.wave * 16384); unsigned char* ws = a.ws; const int lane = lane_id();
#pragma unroll 1
    for (int j = lo + gw; j < hi; j += ngw) { const TrItem cur = tr_decode(a, ws, cv_item<PRO>(l, j)); f32x4 v[16], g[2]; tr_load(cur, v, g, lane); tr_store(cur, v, g, scr, lane); }
}
__device__ __forceinline__ void prologue(const Args& a, const Frame& F) {
    LAS float* scr = (LAS float*)(F.lds + RING_OFF + F.wave * 16384);
    const int gw = F.bid * NWAVES + F.wave, NGW = F.G * NWAVES;
    unsigned char* ws = a.ws;
    convert_items<true>(a, F, 0, gw, NGW, 0, 4032 + (NL - 1) * 512);
    bf16* XB = (bf16*)(ws + WS_XB); float* SSQ = (float*)(ws + WS_SSQ);
    for (int m0 = gw; m0 < M; m0 += 3 * NGW) {
        f32x4 v[3][4];
#pragma unroll
        for (int k = 0; k < 3; ++k) { int m = m0 + k * NGW; m = m < M ? m : M - 1;
            const float* src = m < MP ? a.in[0] + (size_t)m * D : a.in[1] + (size_t)(m - MP) * D;
#pragma unroll
            for (int j = 0; j < 4; ++j) v[k][j] = ((const f32x4*)src)[lane_id() + 64 * j]; }
#pragma unroll
        for (int k = 0; k < 3; ++k) asm volatile("" : "+v"(v[k][0]), "+v"(v[k][1]), "+v"(v[k][2]), "+v"(v[k][3]));
#pragma unroll
        for (int k = 0; k < 3; ++k) { const int m = m0 + k * NGW;
            if (m < M) { float s = 0.f;
#pragma unroll
                for (int j = 0; j < 4; ++j) s += (v[k][j][0] * v[k][j][0] + v[k][j][1] * v[k][j][1]) + (v[k][j][2] * v[k][j][2] + v[k][j][3] * v[k][j][3]);
                s = xl_sum_x32(xl_sum_x16(xl_sum16(s)));
#pragma unroll
                for (int j = 0; j < 4; ++j) { v2u w; w.x = cvtpk(v[k][j][0], v[k][j][1]); w.y = cvtpk(v[k][j][2], v[k][j][3]); ((v2u*)(XB + (size_t)m * D))[lane_id() + 64 * j] = w; }
                if (lane_id() < 16) SSQ[(size_t)m * 16 + lane_id()] = lane_id() == 0 ? s : 0.f; } }
    }
    { bf16* WT = (bf16*)(ws + WS_WT); const int gt = F.bid * 512 + (F.wave * 64 + lane_id()), NT = F.G * 512;
      for (int i = gt; i < NL * 2 * 4 * 128 * 128; i += NT) { const int s = i & 127, t = (i >> 7) & 127, g = (i >> 14) & 3, var = (i >> 16) & 1, l = i >> 17;
          const float* W = a.in[10] + (size_t)(l * 4 + g) * 128 * 128; float v;
          if (var == 0) v = s <= t ? W[t * 128 + s] : 0.f; else v = ((t >> 4) == (s >> 4) && (s & 15) <= (t & 15)) ? W[(t & 15) * 128 + (s & 15)] : 0.f;
          WT[(size_t)(i >> 14) * 16384 + ((((t >> 5) * 8 + (s >> 4)) * 32 + (t & 31)) * 16 + (s & 15))] = (bf16)(cvtpk(v, 0.f) & 0xffffu); } }
    { const f32x4* src = (const f32x4*)a.in[6]; v2u* dst = (v2u*)(ws + WS_MEMB); const int gt = F.bid * 512 + (F.wave * 64 + lane_id()), NT = F.G * 512;
      for (int i = gt; i < NB * NMEM * D / 4; i += NT) { const f32x4 v = src[i]; v2u w; w.x = cvtpk(v[0], v[1]); w.y = cvtpk(v[2], v[3]); dst[i] = w; } }
}

__device__ __forceinline__ void sgu_unit(const Args& a, const Frame& F, int l, int unit) {
    unsigned char* ws = a.ws;
    const bf16* VA = (const bf16*)(ws + WS_VA); const bf16* U = (const bf16*)(ws + WS_U); bf16* CAT = (bf16*)(ws + WS_CAT); float* SASS = (float*)(ws + WS_SASS);
    const int c = unit >> 1, gp = unit & 1; const bool smp = c >= 128; const int R0 = smp ? MP + 128 * (c - 128) : 128 * c;
    const float* gv = a.in[9] + l * 512; const float* bl = a.in[11] + l * 512;
    float* sguv = out_sguv_s(a.out) + (size_t)l * MS * 512;
    int tid_ = F.wave * 64 + lane_id(); asm volatile("" : "+v"(tid_));
    const int tid = tid_, lane = tid & 63, w = F.wave;
    const int gl = w >> 2, nb = w & 3, g = 2 * gp + gl, r32 = lane & 31, hi = lane >> 5;
    const int g4 = lane >> 4, cb = g4 & 1, q4 = (lane & 15) >> 2, p4 = lane & 3;
    const bf16* WT = (const bf16*)(ws + WS_WT) + (size_t)((l * 2 + (smp ? 1 : 0)) * 4 + g) * 16384 + r32 * 16 + hi * 8;
    bf16x8 wfr[20]; float bias[4];
    { int n = 0;
#pragma unroll
      for (int ks = 0; ks < 8; ++ks)
#pragma unroll
          for (int i = 0; i < 4; ++i) { if (ks > 2 * i + 1) continue; wfr[n++] = __builtin_bit_cast(bf16x8, *(const GAS v4u*)(WT + (i * 8 + ks) * 512)); } }
#pragma unroll
    for (int i = 0; i < 4; ++i) { const int t = 32 * i + r32; bias[i] = bl[g * 128 + (smp ? (t & 15) : t)]; }
    f32x4 g0, g1; { const int ch = tid & 31, col = (2 * gp + (ch >> 4)) * 128 + (ch & 15) * 8; g0 = *(const f32x4*)(gv + col); g1 = *(const f32x4*)(gv + col + 4); }
    v4u uraw[8];
#pragma unroll
    for (int i = 0; i < 8; ++i) { const int cc = tid + 512 * i, row = cc >> 5, ch = cc & 31; uraw[i] = *(const GAS v4u*)(U + (size_t)(R0 + row) * 512 + 2 * gp * 128 + ch * 8); }
    v4u raws[8];
#pragma unroll
    for (int i = 0; i < 8; ++i) { const int cc = tid + 512 * i, row = cc >> 5, ch = cc & 31; raws[i] = *(const GAS v4u*)(VA + (size_t)(R0 + row) * 512 + (2 * gp + (ch >> 4)) * 128 + (ch & 15) * 8); }
    asm volatile("" : "+v"(raws[0]), "+v"(raws[1]), "+v"(raws[2]), "+v"(raws[3]), "+v"(raws[4]), "+v"(raws[5]), "+v"(raws[6]), "+v"(raws[7]));
    asm volatile("" : "+v"(wfr[0]), "+v"(wfr[1]), "+v"(wfr[2]), "+v"(wfr[3]), "+v"(wfr[4]));
    asm volatile("" : "+v"(wfr[5]), "+v"(wfr[6]), "+v"(wfr[7]), "+v"(wfr[8]), "+v"(wfr[9]));
    asm volatile("" : "+v"(wfr[10]), "+v"(wfr[11]), "+v"(wfr[12]), "+v"(wfr[13]), "+v"(wfr[14]));
    asm volatile("" : "+v"(wfr[15]), "+v"(wfr[16]), "+v"(wfr[17]), "+v"(wfr[18]), "+v"(wfr[19]));
    asm volatile("" : "+v"(uraw[0]), "+v"(uraw[1]), "+v"(uraw[2]), "+v"(uraw[3]), "+v"(uraw[4]), "+v"(uraw[5]), "+v"(uraw[6]), "+v"(uraw[7]));
    asm volatile("" : "+v"(bias[0]), "+v"(bias[1]), "+v"(bias[2]), "+v"(bias[3]), "+v"(g0), "+v"(g1));
#pragma unroll
    for (int i = 0; i < 8; ++i) { const int cc = tid + 512 * i, row = cc >> 5, ch = cc & 31; *(LAS v4u*)(F.lds + 65536 + row * 512 + ((ch ^ (row & 31)) << 4)) = uraw[i]; }
#pragma unroll
    for (int i = 0; i < 8; ++i) { const int cc = tid + 512 * i, row = cc >> 5, ch = cc & 31, gl = ch >> 4, c16 = ch & 15, col = (2 * gp + gl) * 128 + c16 * 8;
        const v4u raw = raws[i];
        float x[8] = {bf_lo(raw.x), bf_hi(raw.x), bf_lo(raw.y), bf_hi(raw.y), bf_lo(raw.z), bf_hi(raw.z), bf_lo(raw.w), bf_hi(raw.w)};
        float ss = 0.f;
#pragma unroll
        for (int j = 0; j < 8; ++j) ss += x[j] * x[j];
        ss = xl_sum16(ss);
        const float rstd = __builtin_amdgcn_rsqf(ss * (1.0f / 128.0f) + EPS);
        f32x4 y0, y1;
#pragma unroll
        for (int j = 0; j < 4; ++j) { y0[j] = x[j] * rstd * g0[j]; y1[j] = x[4 + j] * rstd * g1[j]; }
        if (smp) { float* o = sguv + (size_t)(R0 - MP + row) * 512 + col; *(f32x4*)o = y0; *(f32x4*)(o + 4) = y1; }
        v4u pk; pk.x = cvtpk(y0[0], y0[1]); pk.y = cvtpk(y0[2], y0[3]); pk.z = cvtpk(y1[0], y1[1]); pk.w = cvtpk(y1[2], y1[3]);
        *(LAS v4u*)(F.lds + gl * 32768 + row * 256 + ((((c16 >> 2) ^ (row & 3)) << 2) | (c16 & 3)) * 16) = pk; }
    __syncthreads();
#ifdef TPROBE
    if (F.wave == 0 && lane == 0) { volatile LAS unsigned* tc = (volatile LAS unsigned*)(F.lds + MISC_OFF + 64); const unsigned now_ = (unsigned)__builtin_amdgcn_s_memrealtime(); tc[27] += now_ - tc[32]; tc[32] = now_; }
#endif
    const int colb = (nb * 32 + 16 * cb + 4 * p4) * 2;
    const unsigned tb = F.lds0 + gl * 32768 + (8 * hi + q4) * 256 + ((((colb >> 6) ^ q4) << 6) | (colb & 63));
    f32x16 acc[4];
#pragma unroll
    for (int i = 0; i < 4; ++i)
#pragma unroll
        for (int r = 0; r < 16; ++r) acc[i][r] = 0.f;
    { int n = 0;
#pragma unroll
      for (int ks = 0; ks < 8; ++ks) {
        const s16x4 a0 = tr_read(tb + ks * 16 * 256), a1 = tr_read(tb + ks * 16 * 256 + 4 * 256);
        const bf16x8 af = (bf16x8){a0[0], a0[1], a0[2], a0[3], a1[0], a1[1], a1[2], a1[3]};
#pragma unroll
        for (int i = 0; i < 4; ++i) { if (ks > 2 * i + 1) continue; acc[i] = MFMA32(af, wfr[n++], acc[i]); }
      } }
#ifdef TPROBE
    if (F.wave == 0 && lane == 0) { volatile LAS unsigned* tc = (volatile LAS unsigned*)(F.lds + MISC_OFF + 64); const unsigned now_ = (unsigned)__builtin_amdgcn_s_memrealtime(); tc[28] += now_ - tc[32]; tc[32] = now_; }
#endif
#pragma unroll
    for (int i = 0; i < 4; ++i) { const int t = 32 * i + r32; const float bs_ = bias[i];
        const size_t rowoff = (size_t)(R0 + t); float ss = 0.f;
#pragma unroll
        for (int k = 0; k < 4; ++k) { const int e = g * 128 + nb * 32 + 8 * k + 4 * hi; const v2u u2 = *(const LAS v2u*)(F.lds + 65536 + t * 512 + (((gl * 16 + nb * 4 + k) ^ r32) << 4) + 8 * hi);
            const float v0 = bf_lo(u2.x) * (acc[i][4 * k] + bs_), v1 = bf_hi(u2.x) * (acc[i][4 * k + 1] + bs_), v2 = bf_lo(u2.y) * (acc[i][4 * k + 2] + bs_), v3 = bf_hi(u2.y) * (acc[i][4 * k + 3] + bs_);
            ss += (v0 * v0 + v1 * v1) + (v2 * v2 + v3 * v3);
            v2u o; o.x = cvtpk(v0, v1); o.y = cvtpk(v2, v3); *(GAS v2u*)(CAT + rowoff * 1024 + 512 + e) = o; }
        ss = xl_sum_x32(ss);
        SASS[rowoff * 16 + g * 4 + nb] = ss; }
    __syncthreads();
}

__device__ __forceinline__ float vmin126(float x) { float r; asm("v_min_f32 %0, 0x42fc0000, %1" : "=v"(r) : "v"(x)); return r; }
template <bool SMP> __device__ __forceinline__ void sb_unit(const Args& a, const Frame& F, int l, int uidx) {
    unsigned char* ws = a.ws;
    const bf16* Qb = (const bf16*)(ws + WS_Q); const bf16* Kb = (const bf16*)(ws + WS_K); const bf16* Vb = (const bf16*)(ws + WS_V);
    bf16* CAT = (bf16*)(ws + WS_CAT); float* SBSS = (float*)(ws + WS_SBSS);
    int lane_ = lane_id(); asm volatile("" : "+v"(lane_));
    const int lane = lane_, r32 = lane & 31, hi = lane >> 5;
    int h, rowq0, nq, krow0 = 0, bs = 0, t0 = 0, jt;
    if (!SMP) { const int tb = uidx & 127, bh = uidx >> 7; h = bh & 7; const int b = bh >> 3; t0 = 32 * tb; rowq0 = b * T + t0; krow0 = b * T; nq = 32; jt = t0 >> 6; }
    else { h = uidx & 7; bs = uidx >> 3; rowq0 = MP + bs * NS; nq = NS; jt = PAST / 64; }
    const int tq = SMP ? PAST + (r32 < NS ? r32 : NS - 1) : t0 + r32;
    const float* ck = a.in[2] + ((size_t)(l * BS + bs) * PAST) * 512 + h * 64; const float* cv = a.in[3] + ((size_t)(l * BS + bs) * PAST) * 512 + h * 64;
    bf16x8 qf[4];
#pragma unroll
    for (int d0 = 0; d0 < 4; ++d0) qf[d0] = __builtin_bit_cast(bf16x8, *(const GAS v4u*)(Qb + (size_t)(rowq0 + (r32 < nq ? r32 : nq - 1)) * 512 + h * 64 + d0 * 16 + hi * 8));
    f32x16 o[2];
#pragma unroll
    for (int r = 0; r < 16; ++r) { o[0][r] = 0.f; o[1][r] = 0.f; }
    float R = 1.0f;
    LAS unsigned char* vt = F.lds + F.wave * 16384;
    LAS unsigned char* kt = vt + 8192;
    const unsigned vt0 = F.lds0 + F.wave * 16384;
    const int g4 = lane >> 4, cb = g4 & 1, q4 = (lane & 15) >> 2, p4 = lane & 3;
    v4u kn[8], vn[8];
    if (!SMP) {
#pragma unroll
        for (int i = 0; i < 8; ++i) { const GAS unsigned char* kb_ = (const GAS unsigned char*)(Kb + (size_t)(krow0 + 64 * jt) * 512 + h * 64); const GAS unsigned char* vb_ = (const GAS unsigned char*)(Vb + (size_t)(krow0 + 64 * jt) * 512 + h * 64);
            const unsigned lo_ = (unsigned)((lane >> 3) * 1024 + (lane & 7) * 16 + i * 8192);
            kn[i] = *(const GAS v4u*)(kb_ + lo_); vn[i] = *(const GAS v4u*)(vb_ + lo_); }
    }
    for (; jt >= 0; --jt) {
        bf16x8 kf[2][4];
        if (!SMP) {
            {
                const int r0_ = lane >> 3, ch_ = lane & 7;
                LAS unsigned char* kw_ = kt + r0_ * 128 + ((ch_ ^ (r0_ & 7)) << 4); LAS unsigned char* vw_ = vt + r0_ * 128 + (((((ch_ >> 2) ^ ((r0_ >> 1) & 1)) << 2) | (ch_ & 3)) << 4);
#pragma unroll
                for (int i = 0; i < 8; ++i) { *(LAS v4u*)(kw_ + i * 1024) = kn[i]; *(LAS v4u*)(vw_ + i * 1024) = vn[i]; } }
#pragma unroll
            for (int mb = 0; mb < 2; ++mb)
#pragma unroll
                for (int d0 = 0; d0 < 4; ++d0) kf[mb][d0] = *(const LAS bf16x8*)(kt + (32 * mb + r32) * 128 + (((2 * d0 + hi) ^ (r32 & 7)) << 4));
        } else if (jt == PAST / 64) {
#pragma unroll
            for (int mb = 0; mb < 2; ++mb) { const int kv = 32 * mb + r32;
                const bf16* kp = Kb + (size_t)(MP + bs * NS + (kv < NS ? kv : NS - 1)) * 512 + h * 64 + hi * 8;
#pragma unroll
                for (int d0 = 0; d0 < 4; ++d0) kf[mb][d0] = __builtin_bit_cast(bf16x8, *(const GAS v4u*)(kp + d0 * 16)); }
#pragma unroll
            for (int i = 0; i < 8; ++i) { const int c = lane + 64 * i, row = c >> 3, ch = c & 7;
                const v4u v = *(const GAS v4u*)(Vb + (size_t)(MP + bs * NS + (row < NS ? row : NS - 1)) * 512 + h * 64 + ch * 8);
                *(LAS v4u*)(vt + row * 128 + (((((ch >> 2) ^ ((row >> 1) & 1)) << 2) | (ch & 3)) << 4)) = v; }
        } else {
#pragma unroll
            for (int mb = 0; mb < 2; ++mb) { const float* kp = ck + (size_t)(64 * jt + 32 * mb + r32) * 512 + hi * 8;
#pragma unroll
                for (int d0 = 0; d0 < 4; ++d0) { const f32x4 x0 = *(const f32x4*)(kp + d0 * 16), x1 = *(const f32x4*)(kp + d0 * 16 + 4);
                    v4u v; v.x = cvtpk(x0[0], x0[1]); v.y = cvtpk(x0[2], x0[3]); v.z = cvtpk(x1[0], x1[1]); v.w = cvtpk(x1[2], x1[3]); kf[mb][d0] = __builtin_bit_cast(bf16x8, v); } }
#pragma unroll
            for (int i = 0; i < 8; ++i) { const int c = lane + 64 * i, row = c >> 3, ch = c & 7; const float* vp = cv + (size_t)(64 * jt + row) * 512 + ch * 8;
                const f32x4 x0 = *(const f32x4*)vp, x1 = *(const f32x4*)(vp + 4);
                v4u v; v.x = cvtpk(x0[0], x0[1]); v.y = cvtpk(x0[2], x0[3]); v.z = cvtpk(x1[0], x1[1]); v.w = cvtpk(x1[2], x1[3]);
                *(LAS v4u*)(vt + row * 128 + (((((ch >> 2) ^ ((row >> 1) & 1)) << 2) | (ch & 3)) << 4)) = v; }
        }
        f32x16 p0, p1;
#pragma unroll
        for (int r = 0; r < 16; ++r) { p0[r] = 0.f; p1[r] = 0.f; }
#pragma unroll
        for (int d0 = 0; d0 < 4; ++d0) { p0 = MFMA32(kf[0][d0], qf[d0], p0); p1 = MFMA32(kf[1][d0], qf[d0], p1); }
        const bool diag = SMP ? (jt == PAST / 64) : (64 * jt + 63 >= t0);
        if (diag) {
#pragma unroll
            for (int r = 0; r < 16; ++r) { const int kp = 64 * jt + crow(r, hi); if (kp >= tq) p0[r] = -1e30f; if (kp + 32 >= tq) p1[r] = -1e30f; } }
        float cw[32];
#pragma unroll
        for (int r = 0; r < 16; ++r) { p0[r] = __builtin_amdgcn_exp2f(vmin126(p0[r])); p1[r] = __builtin_amdgcn_exp2f(vmin126(p1[r]));
            cw[r] = __builtin_amdgcn_rcpf(1.0f + p0[r]); cw[16 + r] = __builtin_amdgcn_rcpf(1.0f + p1[r]); }
        float gs[8], oth[8];
#pragma unroll
        for (int gq = 0; gq < 8; ++gq) { cw[4 * gq + 2] *= cw[4 * gq + 3]; cw[4 * gq + 1] *= cw[4 * gq + 2]; cw[4 * gq] *= cw[4 * gq + 1]; gs[gq] = cw[4 * gq]; }
#pragma unroll
        for (int gq = 0; gq < 8; ++gq) oth[gq] = xl_other_x32(gs[gq], hi);
        float off[8]; float tail = R;
#pragma unroll
        for (int gq = 7; gq >= 0; --gq) { off[gq] = hi == 0 ? tail * oth[gq] : tail; tail *= gs[gq] * oth[gq]; }
        R = tail;
#pragma unroll
        for (int r = 0; r < 16; ++r) { p0[r] = p0[r] * cw[r] * off[r >> 2]; p1[r] = p1[r] * cw[16 + r] * off[4 + (r >> 2)]; }
        const bool last = __all(((r32 < nq) ? R : 0.f) < SB_EXIT) || jt == 0;
        if (!SMP && !last) { const int jn = jt - 1;
#pragma unroll
            for (int i = 0; i < 8; ++i) { const GAS unsigned char* kb_ = (const GAS unsigned char*)(Kb + (size_t)(krow0 + 64 * jn) * 512 + h * 64); const GAS unsigned char* vb_ = (const GAS unsigned char*)(Vb + (size_t)(krow0 + 64 * jn) * 512 + h * 64);
                const unsigned lo_ = (unsigned)((lane >> 3) * 1024 + (lane & 7) * 16 + i * 8192);
                kn[i] = *(const GAS v4u*)(kb_ + lo_); vn[i] = *(const GAS v4u*)(vb_ + lo_); } }
        unsigned pk[16];
#pragma unroll
        for (int i = 0; i < 8; ++i) { pk[i] = cvtpk(p0[2 * i], p0[2 * i + 1]); pk[8 + i] = cvtpk(p1[2 * i], p1[2 * i + 1]); }
#pragma unroll
        for (int ks = 0; ks < 4; ++ks) { const bf16x8 pf = __builtin_bit_cast(bf16x8, (v4u){pk[4 * ks], pk[4 * ks + 1], pk[4 * ks + 2], pk[4 * ks + 3]});
#pragma unroll
            for (int nb = 0; nb < 2; ++nb) { const unsigned ad0 = vt0 + (16 * ks + 4 * hi + q4) * 128 + ((nb ^ ((q4 >> 1) & 1)) << 6) + (16 * cb + 4 * p4) * 2, ad1 = ad0 + 8 * 128;
                const s16x4 b0 = tr_read(ad0), b1 = tr_read(ad1);
                const bf16x8 vf = (bf16x8){b0[0], b0[1], b0[2], b0[3], b1[0], b1[1], b1[2], b1[3]};
                o[nb] = MFMA32(pf, vf, o[nb]); } }
#ifdef TPROBE
        if (F.wave == 0 && lane == 0) { volatile LAS unsigned* tc = (volatile LAS unsigned*)(F.lds + MISC_OFF + 64); tc[SMP ? 14 : 12] += 100u; }
#endif
        if (last) break;
    }
    float ssq[16];
#pragma unroll
    for (int r = 0; r < 16; ++r) { ssq[r] = o[0][r] * o[0][r] + o[1][r] * o[1][r];
        ssq[r] = xl_sum_x16(xl_sum16(ssq[r])); }
#pragma unroll
    for (int r = 0; r < 16; ++r) { if (SMP && r >= 8) continue;
        const int q = crow(r, hi);
        *(LAS bf16*)(vt + q * 128 + r32 * 2) = (bf16)(cvtpk(o[0][r], 0.f) & 0xffffu); *(LAS bf16*)(vt + q * 128 + 64 + r32 * 2) = (bf16)(cvtpk(o[1][r], 0.f) & 0xffffu);
        SBSS[(size_t)(rowq0 + q) * 8 + h] = ssq[r]; }
#pragma unroll
    for (int i = 0; i < 4; ++i) { if (SMP && i >= 2) continue; const int ch = lane + 64 * i, row = ch >> 3, cp = ch & 7;
        const v4u v = *(const LAS v4u*)(vt + row * 128 + cp * 16); *(GAS v4u*)(CAT + (size_t)(rowq0 + row) * 1024 + h * 64 + cp * 8) = v; }
}

template <bool SMP> __device__ __forceinline__ void mem_unit(const Args& a, const Frame& F, int l, int uidx) {
    unsigned char* ws = a.ws;
    const bf16* QM = (const bf16*)(ws + WS_QM); bf16* OM = (bf16*)(ws + WS_OM);
    int tid_ = F.wave * 64 + lane_id(); asm volatile("" : "+v"(tid_));
    const int tid = tid_, lane = tid & 63, r32 = lane & 31, hi = lane >> 5;
    int h, rowq0, nq, b;
    if (!SMP) { const int qb = uidx & 15, bh = uidx >> 4; h = bh & 3; b = bh >> 2; rowq0 = b * T + 256 * qb + 32 * F.wave; nq = 32; }
    else { h = uidx & 3; b = uidx >> 2; rowq0 = MP + b * NS; nq = NS; }
    const bool active = !SMP || F.wave == 0;
    bf16x8 qf[16];
    { const bf16* qp = QM + (size_t)((rowq0 >> 5) * 4 + h) * 8192 + (r32 * 2 + hi) * 8;
#pragma unroll
      for (int d0 = 0; d0 < 16; ++d0) qf[d0] = __builtin_bit_cast(bf16x8, *(const GAS v4u*)(qp + d0 * 512)); }
    if (!SMP) { const bf16* src = (const bf16*)(ws + WS_MK) + (size_t)(l * 4 + b) * 256 * 1024 + h * 256;
#pragma unroll
        for (int i = 0; i < 16; ++i) { const int j = F.wave * 16 + i, key = 2 * j + (lane >> 5), ch = (lane & 31) ^ (key & 31);
            __builtin_amdgcn_global_load_lds((const GAS unsigned*)(src + (size_t)key * 1024 + ch * 8), (LAS unsigned*)(F.lds + j * 1024), 16, 0, 0); }
        VM_WAIT(); }
    else { const float* src = a.in[4] + (size_t)(l * BS + b) * NMEM * D + h * 256;
#pragma unroll 8
        for (int i = 0; i < 16; ++i) { const int c = tid + 512 * i, key = c >> 5, ch = c & 31;
            const f32x4 x0 = *(const f32x4*)(src + (size_t)key * 1024 + ch * 8), x1 = *(const f32x4*)(src + (size_t)key * 1024 + ch * 8 + 4);
            v4u v; v.x = cvtpk(x0[0], x0[1]); v.y = cvtpk(x0[2], x0[3]); v.z = cvtpk(x1[0], x1[1]); v.w = cvtpk(x1[2], x1[3]);
            *(LAS v4u*)(F.lds + key * 512 + ((ch ^ (key & 31)) << 4)) = v; } }
    __syncthreads();
#ifdef TPROBE
#define MSTAMP(k) do { if (!SMP && F.wave == 0 && lane == 0) { volatile LAS unsigned* tc = (volatile LAS unsigned*)(F.lds + MISC_OFF + 64); const unsigned now_ = (unsigned)__builtin_amdgcn_s_memrealtime(); tc[(k)] += now_ - tc[32]; tc[32] = now_; } } while (0)
#else
#define MSTAMP(k) do { } while (0)
#endif
    MSTAMP(29);
    f32x16 s[8]; unsigned pk[8][8]; float inv[16];
#pragma unroll
    for (int kb = 0; kb < 8; ++kb)
#pragma unroll
        for (int r = 0; r < 16; ++r) s[kb][r] = 0.f;
    { const int xb = r32 ^ hi;
#pragma unroll
      for (int d0 = 0; d0 < 16; ++d0) {
          LAS unsigned char* kp = F.lds + r32 * 512 + ((xb ^ (2 * d0)) << 4);
#pragma unroll
          for (int kb = 0; kb < 8; ++kb) { const bf16x8 kf = *(const LAS bf16x8*)(kp + kb * 16384); s[kb] = MFMA32(kf, qf[d0], s[kb]); }
      } }
    MSTAMP(30);
    __syncthreads();
    { const bf16* src = (const bf16*)(ws + WS_MV) + (size_t)(l * 4 + b) * 256 * 1024 + h * 256;
#pragma unroll
      for (int i = 0; i < 16; ++i) { const int j = F.wave * 16 + i, key = 2 * j + (lane >> 5), cp = lane & 31, ch = ((((cp >> 2) ^ (key & 3)) << 2) | (cp & 3));
          __builtin_amdgcn_global_load_lds((const GAS unsigned*)(src + (size_t)key * 1024 + ch * 8), (LAS unsigned*)(F.lds + j * 1024), 16, 0, 0); } }
    float lsum = 0.f;
    {
        float mx = s[0][0];
#pragma unroll
        for (int kb = 0; kb < 8; ++kb)
#pragma unroll
            for (int r = 0; r < 16; ++r) mx = fmaxf(mx, s[kb][r]);
        mx = xl_max_x32(mx);
#pragma unroll
        for (int kb = 0; kb < 8; ++kb) {
#pragma unroll
            for (int r = 0; r < 16; ++r) { s[kb][r] = __builtin_amdgcn_exp2f(s[kb][r] - mx); lsum += s[kb][r]; }
#pragma unroll
            for (int i = 0; i < 8; ++i) pk[kb][i] = cvtpk(s[kb][2 * i], s[kb][2 * i + 1]); }
        lsum = xl_sum_x32(lsum); }
    VM_WAIT();
    __syncthreads();
    { LAS float* wsf = (LAS float*)(F.lds + AUX_OFF) + F.wave * 64;
      if (hi == 0) wsf[r32] = lsum;
      LDS_WAIT();
#pragma unroll
      for (int r = 0; r < 16; ++r) inv[r] = __builtin_amdgcn_rcpf(wsf[crow(r, hi)]); }
    MSTAMP(23);
    if (active) {
        const int g4 = lane >> 4, cb = g4 & 1, q4 = (lane & 15) >> 2, p4 = lane & 3;
        const unsigned vb = F.lds0 + (4 * hi + q4) * 512 + (16 * cb + 4 * p4) * 2;
        LAS unsigned char* ost = F.lds + OST_OFF + F.wave * 2048;
#pragma unroll 1
        for (int nb = 0; nb < 8; ++nb) { f32x16 o;
#pragma unroll
            for (int r = 0; r < 16; ++r) o[r] = 0.f;
            const unsigned vn = vb + ((nb ^ q4) << 6);
#pragma unroll
            for (int ks = 0; ks < 16; ++ks) { const bf16x8 pf = __builtin_bit_cast(bf16x8, (v4u){pk[ks >> 1][4 * (ks & 1)], pk[ks >> 1][4 * (ks & 1) + 1], pk[ks >> 1][4 * (ks & 1) + 2], pk[ks >> 1][4 * (ks & 1) + 3]});
                const s16x4 b0 = tr_read(vn + ks * 16 * 512), b1 = tr_read(vn + ks * 16 * 512 + 8 * 512);
                const bf16x8 vf = (bf16x8){b0[0], b0[1], b0[2], b0[3], b1[0], b1[1], b1[2], b1[3]};
                o = MFMA32(pf, vf, o); }
#pragma unroll
            for (int r = 0; r < 16; ++r) *(LAS bf16*)(ost + crow(r, hi) * 64 + r32 * 2) = (bf16)(cvtpk(o[r] * inv[r], 0.f) & 0xffffu);
#pragma unroll
            for (int i = 0; i < 2; ++i) { if (SMP && i == 1) continue; const int ch = lane + 64 * i, row = ch >> 2, cp = ch & 3;
                const v4u v = *(const LAS v4u*)(ost + row * 64 + cp * 16); *(GAS v4u*)(OM + (size_t)(rowq0 + row) * 1024 + h * 256 + 32 * nb + cp * 8) = v; }
        }
    }
    __syncthreads();
}

__device__ __forceinline__ void mem_unit_smp(const Args& a, const Frame& F, int l, int uidx) {
    unsigned char* ws = a.ws;
    const bf16* QM = (const bf16*)(ws + WS_QM); bf16* OM = (bf16*)(ws + WS_OM);
    int tid_ = F.wave * 64 + lane_id(); asm volatile("" : "+v"(tid_));
    const int tid = tid_, lane = tid & 63, r32 = lane & 31, hi = lane >> 5, w = F.wave;
    const int h = uidx & 3, b = uidx >> 2, rowq0 = MP + b * NS;
    LAS unsigned char* tile = F.lds + w * 16384;
    LAS float* st = (LAS float*)(F.lds + AUX_OFF);
    bf16x8 qf[16];
    { const bf16* qp = QM + (size_t)(rowq0 + (r32 & 15)) * 1024 + h * 256 + hi * 8;
#pragma unroll
      for (int d0 = 0; d0 < 16; ++d0) qf[d0] = __builtin_bit_cast(bf16x8, *(const GAS v4u*)(qp + d0 * 16)); }
    const size_t coff = ((size_t)(l * BS + b) * NMEM + w) * D + h * 256;
    { const float* src = a.in[4] + coff + (size_t)hi * 8 * D + r32 * 8; f32x4 x[32];
#pragma unroll
      for (int i = 0; i < 16; ++i) { x[2 * i] = *(const f32x4*)(src + (size_t)(16 * i) * D); x[2 * i + 1] = *(const f32x4*)(src + (size_t)(16 * i) * D + 4); }
#pragma unroll
      for (int i = 0; i < 32; ++i) asm volatile("" : "+v"(x[i]));
#pragma unroll
      for (int i = 0; i < 16; ++i) { const int key = 2 * i + hi; v4u v; v.x = cvtpk(x[2 * i][0], x[2 * i][1]); v.y = cvtpk(x[2 * i][2], x[2 * i][3]); v.z = cvtpk(x[2 * i + 1][0], x[2 * i + 1][1]); v.w = cvtpk(x[2 * i + 1][2], x[2 * i + 1][3]);
          *(LAS v4u*)(tile + key * 512 + ((r32 ^ key) << 4)) = v; } }
    f32x4 y[32];
    { int voff = hi * 8 * D + r32 * 8; asm volatile("" : "+v"(voff));
      const float* src = a.in[5] + coff + voff;
#pragma unroll
      for (int i = 0; i < 16; ++i) { y[2 * i] = *(const f32x4*)(src + (size_t)(16 * i) * D); y[2 * i + 1] = *(const f32x4*)(src + (size_t)(16 * i) * D + 4); } }
    LDS_WAIT();
    f32x16 s;
#pragma unroll
    for (int r = 0; r < 16; ++r) s[r] = 0.f;
    { const int xb = r32 ^ hi;
#pragma unroll
      for (int d0 = 0; d0 < 16; ++d0) { const bf16x8 kf = *(const LAS bf16x8*)(tile + r32 * 512 + ((xb ^ (2 * d0)) << 4)); s = MFMA32(kf, qf[d0], s); } }
    float mx = s[0];
#pragma unroll
    for (int r = 1; r < 16; ++r) mx = fmaxf(mx, s[r]);
    mx = xl_max_x32(mx);
    float ls = 0.f;
#pragma unroll
    for (int r = 0; r < 16; ++r) { s[r] = __builtin_amdgcn_exp2f(s[r] - mx); ls += s[r]; }
    ls = xl_sum_x32(ls);
    if (hi == 0) { st[w * 64 + r32] = mx; st[w * 64 + 32 + r32] = ls; }
#pragma unroll
    for (int i = 0; i < 32; ++i) asm volatile("" : "+v"(y[i]));
#pragma unroll
    for (int i = 0; i < 16; ++i) { const int key = 2 * i + hi; v4u v; v.x = cvtpk(y[2 * i][0], y[2 * i][1]); v.y = cvtpk(y[2 * i][2], y[2 * i][3]); v.z = cvtpk(y[2 * i + 1][0], y[2 * i + 1][1]); v.w = cvtpk(y[2 * i + 1][2], y[2 * i + 1][3]);
        *(LAS v4u*)(tile + key * 512 + ((((r32 >> 2) ^ (key & 3)) << 2 | (r32 & 3)) << 4)) = v; }
    __syncthreads();
    unsigned pk[8];
    { float mm[8], m = -3.0e38f, L = 0.f;
#pragma unroll
      for (int j = 0; j < 8; ++j) { mm[j] = st[j * 64 + r32]; m = fmaxf(m, mm[j]); }
#pragma unroll
      for (int j = 0; j < 8; ++j) L += st[j * 64 + 32 + r32] * __builtin_amdgcn_exp2f(mm[j] - m);
      const float f = __builtin_amdgcn_exp2f(mx - m) * __builtin_amdgcn_rcpf(L);
#pragma unroll
      for (int i = 0; i < 8; ++i) pk[i] = cvtpk(s[2 * i] * f, s[2 * i + 1] * f); }
    { const int g4 = lane >> 4, cb = g4 & 1, q4 = (lane & 15) >> 2, p4 = lane & 3;
      const unsigned vb = F.lds0 + (4 * hi + q4) * 512 + (16 * cb + 4 * p4) * 2;
      f32x16 o[8];
#pragma unroll
      for (int nb = 0; nb < 8; ++nb) {
#pragma unroll
          for (int r = 0; r < 16; ++r) o[nb][r] = 0.f;
          const unsigned vn = vb + ((nb ^ q4) << 6);
#pragma unroll
          for (int kl = 0; kl < 2; ++kl) { const int ks = 2 * w + kl; const bf16x8 pf = __builtin_bit_cast(bf16x8, (v4u){pk[4 * kl], pk[4 * kl + 1], pk[4 * kl + 2], pk[4 * kl + 3]});
              const s16x4 b0 = tr_read(vn + ks * 16 * 512), b1 = tr_read(vn + ks * 16 * 512 + 8 * 512);
              const bf16x8 vf = (bf16x8){b0[0], b0[1], b0[2], b0[3], b1[0], b1[1], b1[2], b1[3]};
              o[nb] = MFMA32(pf, vf, o[nb]); } }
      LAS float* part = (LAS float*)tile;
#pragma unroll
      for (int nb = 0; nb < 8; ++nb)
#pragma unroll
          for (int r = 0; r < 8; ++r) part[crow(r, hi) * 256 + 32 * nb + r32] = o[nb][r];
    }
    __syncthreads();
    { const int q = tid >> 5, c8 = (tid & 31) * 8; f32x4 o0 = (f32x4){0.f, 0.f, 0.f, 0.f}, o1 = o0;
#pragma unroll
      for (int j = 0; j < 8; ++j) { const LAS float* pp = (const LAS float*)(F.lds + j * 16384) + q * 256 + c8; o0 = o0 + *(const LAS f32x4*)pp; o1 = o1 + *(const LAS f32x4*)(pp + 4); }
      v4u v; v.x = cvtpk(o0[0], o0[1]); v.y = cvtpk(o0[2], o0[3]); v.z = cvtpk(o1[0], o1[1]); v.w = cvtpk(o1[2], o1[3]);
      *(GAS v4u*)(OM + (size_t)(rowq0 + q) * 1024 + h * 256 + c8) = v; }
    __syncthreads();
}

template <int MODE, int K> __device__ __forceinline__ void mini_gemm(const Frame& F, unsigned char* ws, const bf16* A, const bf16* Bt) {
    int tid_ = F.wave * 64 + lane_id(); asm volatile("" : "+v"(tid_));
    const int tid = tid_, lane = tid & 63, r32 = lane & 31, hi = lane >> 5, w = F.wave;
    constexpr int KS = K >> 3, NIT = KS / 16, BT = (NIT % 8 == 0) ? 8 : 11;
    static_assert(NIT % BT == 0, "batching");
    const int rb = 2 * (F.bid & 7) + (F.bid >> 7), cb = (F.bid >> 3) & 15, row0 = MP + 32 * rb, col0 = 64 * cb;
    const bf16* ap = A + (size_t)(row0 + r32) * K + w * KS + hi * 8;
    const bf16* bp0 = Bt + (size_t)(col0 + r32) * K + w * KS + hi * 8; const bf16* bp1 = bp0 + (size_t)32 * K;
    const int row = tid >> 4, c4 = (tid & 15) * 4, grow = row0 + row, gcol = col0 + c4;
    f32x4 e0, e1, e2, e3, e4, e5; v2u xo;
    if (MODE == 2) { const float* SSQ = (const float*)(ws + WS_SSQ) + (size_t)grow * 16; e0 = *(const f32x4*)SSQ; e1 = *(const f32x4*)(SSQ + 4); e2 = *(const f32x4*)(SSQ + 8); e3 = *(const f32x4*)(SSQ + 12); e4 = e0; e5 = e0; xo.x = 0u; xo.y = 0u; }
    else { if (MODE == 1) { const float* SBSS = (const float*)(ws + WS_SBSS) + (size_t)grow * 8; const float* SASS = (const float*)(ws + WS_SASS) + (size_t)grow * 16;
               e0 = *(const f32x4*)SBSS; e1 = *(const f32x4*)(SBSS + 4); e2 = *(const f32x4*)SASS; e3 = *(const f32x4*)(SASS + 4); e4 = *(const f32x4*)(SASS + 8); e5 = *(const f32x4*)(SASS + 12); }
           else { e0 = (f32x4){0.f, 0.f, 0.f, 0.f}; e1 = e0; e2 = e0; e3 = e0; e4 = e0; e5 = e0; }
           xo = *(const GAS v2u*)((const bf16*)(ws + WS_XB) + (size_t)grow * 1024 + gcol); }
    f32x16 acc0, acc1;
#pragma unroll
    for (int r = 0; r < 16; ++r) { acc0[r] = 0.f; acc1[r] = 0.f; }
#pragma unroll
    for (int k0 = 0; k0 < NIT; k0 += BT) { v4u fa[BT], fb0[BT], fb1[BT];
#pragma unroll
        for (int i = 0; i < BT; ++i) { fa[i] = *(const GAS v4u*)(ap + (k0 + i) * 16); fb0[i] = *(const GAS v4u*)(bp0 + (k0 + i) * 16); fb1[i] = *(const GAS v4u*)(bp1 + (k0 + i) * 16); }
#pragma unroll
        for (int i = 0; i < BT; ++i) asm volatile("" : "+v"(fa[i]), "+v"(fb0[i]), "+v"(fb1[i]));
#pragma unroll
        for (int i = 0; i < BT; ++i) { const bf16x8 af = __builtin_bit_cast(bf16x8, fa[i]); acc0 = MFMA32(af, __builtin_bit_cast(bf16x8, fb0[i]), acc0); acc1 = MFMA32(af, __builtin_bit_cast(bf16x8, fb1[i]), acc1); } }
    LAS float* P = (LAS float*)F.lds + w * 2048;
#pragma unroll
    for (int r = 0; r < 16; ++r) { P[crow(r, hi) * 64 + r32] = acc0[r]; P[crow(r, hi) * 64 + 32 + r32] = acc1[r]; }
    __syncthreads();
    f32x4 sb = (f32x4){0.f, 0.f, 0.f, 0.f}, sa = (f32x4){0.f, 0.f, 0.f, 0.f};
#pragma unroll
    for (int ww = 0; ww < 4; ++ww) { sb = sb + *(const LAS f32x4*)((LAS float*)F.lds + ww * 2048 + row * 64 + c4); sa = sa + *(const LAS f32x4*)((LAS float*)F.lds + (ww + 4) * 2048 + row * 64 + c4); }
    if (MODE == 2) {
        const float s = (((e0[0] + e0[1]) + (e0[2] + e0[3])) + ((e1[0] + e1[1]) + (e1[2] + e1[3]))) + (((e2[0] + e2[1]) + (e2[2] + e2[3])) + ((e3[0] + e3[1]) + (e3[2] + e3[3])));
        const float r = __builtin_amdgcn_rsqf(s * (1.0f / 1024.0f) + EPS) * C_MEM; const f32x4 v = (sb + sa) * r;
        v2u o; o.x = cvtpk(v[0], v[1]); o.y = cvtpk(v[2], v[3]); *(GAS v2u*)((bf16*)(ws + WS_QM) + (size_t)grow * 1024 + gcol) = o;
    } else {
        f32x4 val = sb + sa;
        if (MODE == 1) {
            const float tb = ((e0[0] + e0[1]) + (e0[2] + e0[3])) + ((e1[0] + e1[1]) + (e1[2] + e1[3]));
            const float ta = (((e2[0] + e2[1]) + (e2[2] + e2[3])) + ((e3[0] + e3[1]) + (e3[2] + e3[3]))) + (((e4[0] + e4[1]) + (e4[2] + e4[3])) + ((e5[0] + e5[1]) + (e5[2] + e5[3])));
            val = sb * __builtin_amdgcn_rsqf(tb * (1.0f / 512.0f) + EPS) + sa * __builtin_amdgcn_rsqf(ta * (1.0f / 512.0f) + EPS); }
        bf16* xb = (bf16*)(ws + WS_XB) + (size_t)grow * 1024 + gcol;
        f32x4 x; x[0] = bf_lo(xo.x); x[1] = bf_hi(xo.x); x[2] = bf_lo(xo.y); x[3] = bf_hi(xo.y);
        x = x + val;
        v2u o; o.x = cvtpk(x[0], x[1]); o.y = cvtpk(x[2], x[3]); *(GAS v2u*)xb = o;
        float ss = (x[0] * x[0] + x[1] * x[1]) + (x[2] * x[2] + x[3] * x[3]);
        ss = xl_sum16(ss);
        if ((tid & 15) == 0) ((float*)(ws + WS_SSQ))[(size_t)grow * 16 + cb] = ss;
    }
    __syncthreads();
}

__device__ __forceinline__ void grp_barrier(gu32* cnt, int tid) {
    asm volatile("s_waitcnt vmcnt(0)" ::: "memory");
    __syncthreads();
    if (tid == 0) {
        const unsigned old = __hip_atomic_fetch_add(cnt, 1u, __ATOMIC_RELAXED, __HIP_MEMORY_SCOPE_AGENT);
        const unsigned target = (old / 32u + 1u) * 32u; unsigned sp = 0u;
        while (__hip_atomic_load(cnt, __ATOMIC_RELAXED, __HIP_MEMORY_SCOPE_AGENT) < target) { __builtin_amdgcn_s_sleep(1); if (++sp > (1u << 22)) break; }
        __builtin_amdgcn_fence(__ATOMIC_ACQUIRE, "agent");
        asm volatile("s_waitcnt vmcnt(0)" ::: "memory");
    }
    __syncthreads();
}

__global__ void __launch_bounds__(NWAVES * 64, 2) mk_fwd(Args args) {
    extern __shared__ __attribute__((aligned(16))) unsigned char lds[];
    const int wave0 = __builtin_amdgcn_readfirstlane((int)threadIdx.x >> 6);
#define PH_FRAME() Frame F; { int w_ = wave0, g_ = (int)gridDim.x, b_ = (int)blockIdx.x; unsigned l0_ = (unsigned)(uintptr_t)lds; asm volatile("" : "+s"(w_), "+s"(g_), "+s"(b_), "+s"(l0_)); \
        F.lds = (LAS unsigned char*)lds; F.lds0 = l0_; F.wave = w_; F.G = g_; F.bid = b_; } \
        size_t wz_ = 0; asm volatile("" : "+s"(wz_)); unsigned char* ws = args.ws + wz_;
    gu32* ctl; { unsigned char* ws0 = args.ws; ctl = (gu32*)(ws0 + WS_CTL); }
    for (int u = wave0 * 64 + lane_id(); u < (LDS_BYTES - LDSCTL_OFF) / 4; u += NWAVES * 64) ((LAS unsigned*)((LAS unsigned char*)lds + LDSCTL_OFF))[u] = 0u;
    __syncthreads();
    XcdBarrier bar = xcd_barrier_post((unsigned*)(ctl + CW_BAR), (volatile LAS unsigned*)((LAS unsigned char*)lds + MISC_OFF) + 8, wave0 * 64 + lane_id());
    if (wave0 * 64 + lane_id() == 0) (void)__hip_atomic_fetch_or((gu32*)ctl + CW_GMASK + ((int)blockIdx.x & 7) * 64, 1u << xb_xcc_id(), __ATOMIC_RELAXED, __HIP_MEMORY_SCOPE_AGENT);
    const int lo = args.ph_lo, hi_ph = args.ph_hi; int ph = 0;
#ifdef TPROBE
    volatile LAS unsigned* tacc = (volatile LAS unsigned*)((LAS unsigned char*)lds + MISC_OFF + 64);
    if (wave0 * 64 + lane_id() == 0) tacc[32] = (unsigned)__builtin_amdgcn_s_memrealtime();
#define TSTAMP(k) do { if (wave0 * 64 + lane_id() == 0) { const unsigned now_ = (unsigned)__builtin_amdgcn_s_memrealtime(); tacc[(k)] += now_ - tacc[32]; if ((k) >= 16) tacc[31] += now_ - tacc[32]; tacc[32] = now_; } } while (0)
#else
#define TSTAMP(k) do { } while (0)
#endif
#define PH_ON() (lo <= ph && ph < hi_ph)
#ifndef EXTRA_BAR
#define EXTRA_BAR 0
#endif
#define PH_END(kk) do { if (lo <= ph && ph + 1 < hi_ph) { xcd_barrier(bar, wave0 * 64 + lane_id()); for (int xb_ = 0; xb_ < EXTRA_BAR; ++xb_) xcd_barrier(bar, wave0 * 64 + lane_id()); } ++ph; TSTAMP(16 + (kk)); } while (0)

#ifndef NO_PRO
    if (PH_ON()) {
#pragma unroll 1
        for (int rp = 0; rp < REP_P; ++rp) { PH_FRAME(); prologue(args, F); } }
#endif
    TSTAMP(0); PH_END(0);
    bool grp_ok;
    { const unsigned m_ = __hip_atomic_load((gu32*)ctl + CW_GMASK + (lane_id() & 7) * 64, __ATOMIC_RELAXED, __HIP_MEMORY_SCOPE_AGENT);
      grp_ok = __all(__builtin_popcount(m_) == 1) && lo == 0 && hi_ph >= 34 && gridDim.x == 256; }
#define PH_END_G(kk) do { if (lo <= ph && ph + 1 < hi_ph) { if (grp_ok) grp_barrier((gu32*)ctl + CW_GRP + ((int)blockIdx.x & 7) * 64, wave0 * 64 + lane_id()); else xcd_barrier(bar, wave0 * 64 + lane_id()); } ++ph; TSTAMP(16 + (kk)); } while (0)
    for (int l = 0; l < NL; ++l) {
        if (PH_ON())
#pragma unroll 1
        for (int rp = 0; rp < REP_A; ++rp) { PH_FRAME(); const unsigned char* wl = ws + WS_WL + (size_t)l * WL_STRIDE;
            { pg8::Gemm g{(const bf16*)(ws + WS_XB), (const bf16*)(wl + WL_IN), M, INW, D}; pg8::StaticOrder S; S.init(M, INW, F.G, F.bid);
              pg8::EpiIn E{ws, args.out, l, C_SB, (LAS float*)(F.lds + AUX_OFF + 2048)};
#ifndef NO_GA
              pg8::gemm_phase<pg8::EpiIn, pg8::StaticOrder, true, true>(F.lds + RING_OFF, g, S, E, F.wave);
#endif
              }
#ifndef NO_CVA
            if (l + 1 < NL && F.bid >= 148) { __syncthreads(); convert_items<false>(args, F, l + 1, (F.bid - 148) * NWAVES + F.wave, 108 * NWAVES, 0, 2592); }
#endif
        }
        TSTAMP(2); PH_END(2);
        if (PH_ON())
#pragma unroll 1
        for (int rp = 0; rp < REP_B; ++rp) { PH_FRAME();
            if (l == 0) { pg8::Gemm g{(const bf16*)(ws + WS_MEMB), (const bf16*)(ws + WS_WMKV), NB * NMEM, 8 * D, D}; pg8::StaticOrder S; S.init(NB * NMEM, 8 * D, F.G, F.bid >= 128 ? F.bid - 128 : 256);
              pg8::EpiKV E{out_mk_p(args.out), out_mv_p(args.out), (bf16*)(ws + WS_MK), (bf16*)(ws + WS_MV), 0};
#ifndef NO_GKV
              pg8::gemm_phase<pg8::EpiKV, pg8::StaticOrder, true, true>(F.lds + RING_OFF, g, S, E, F.wave);
#endif
              __syncthreads();
            }
#ifndef NO_SGU
#pragma unroll 1
            for (int r2 = 0; r2 < REP_SGU; ++r2) {
            sgu_unit(args, F, l, 2 * (16 * (F.bid & 7) + (F.bid >> 4)) + ((F.bid >> 3) & 1));
            if (F.bid < 8) sgu_unit(args, F, l, 256 + F.bid);
            }
#endif
            TSTAMP(11);
#ifndef NO_SB
            { const int x = F.bid & 7; gu32* qh = (gu32*)(ws + WS_CTL) + CW_SBQ + (l * 8 + x) * 64;
#pragma unroll 1
              for (;;) { unsigned q = 0u; if (lane_id() == 0) q = __hip_atomic_fetch_add(qh, 1u, __ATOMIC_RELAXED, __HIP_MEMORY_SCOPE_AGENT);
                  const int qi = (int)__builtin_amdgcn_readfirstlane(q);
                  if (qi >= 32 + 4 * (T / 32)) break;
                  if (qi < 32) sb_unit<true>(args, F, l, 32 * x + qi); else sb_unit<false>(args, F, l, (4 * x + ((qi - 32) & 3)) * 128 + 127 - ((qi - 32) >> 2)); } }
#endif
            __syncthreads();
        }
        TSTAMP(3); PH_END(3);
        if (PH_ON()) { PH_FRAME(); const unsigned char* wl = ws + WS_WL + (size_t)l * WL_STRIDE; pg8::Gemm g{(const bf16*)(ws + WS_CAT), (const bf16*)(wl + WL_OUT), MP, D, D}; pg8::StaticOrder S; S.init(MP, D, F.G, F.bid);
            pg8::EpiRes<true> E{ws, (LAS float*)(F.lds + AUX_OFF + 2048)};
#ifndef NO_GD
            pg8::gemm_phase<pg8::EpiRes<true>, pg8::StaticOrder, true, true>(F.lds + RING_OFF, g, S, E, F.wave);
#endif
            mini_gemm<1, D>(F, ws, (const bf16*)(ws + WS_CAT), (const bf16*)(wl + WL_OUT));
            }
        TSTAMP(4); PH_END_G(4);
        if (PH_ON())
#pragma unroll 1
        for (int rp = 0; rp < REP_E; ++rp) { PH_FRAME(); const unsigned char* wl = ws + WS_WL + (size_t)l * WL_STRIDE; pg8::Gemm g{(const bf16*)(ws + WS_XB), (const bf16*)(wl + WL_MQ), MP, D, D}; pg8::StaticOrder S; S.init(MP, D, F.G, F.bid);
            pg8::EpiQ E{(const float*)(ws + WS_SSQ), (bf16*)(ws + WS_QM), C_MEM, (LAS float*)(F.lds + AUX_OFF + 2048)};
#ifndef NO_GE
            pg8::gemm_phase<pg8::EpiQ, pg8::StaticOrder, true, true>(F.lds + RING_OFF, g, S, E, F.wave);
#endif
            mini_gemm<2, D>(F, ws, (const bf16*)(ws + WS_XB), (const bf16*)(wl + WL_MQ));
            }
        TSTAMP(5); PH_END_G(5);
        if (PH_ON())
#pragma unroll 1
        for (int rp = 0; rp < REP_F; ++rp) { PH_FRAME();
#ifndef NO_MEM
            if (F.bid >= 192) mem_unit_smp(args, F, l, (4 * (F.bid & 7) + ((F.bid >> 3) - 24) / 4) * 4 + ((F.bid >> 3) & 3));
            if (F.bid < NB * 4 * (T / 256)) { const int pm_ = 8 * (F.bid & 7) + (F.bid >> 5), h_ = (F.bid >> 3) & 3;
                mem_unit<false>(args, F, l, ((pm_ >> 4) * 4 + h_) * 16 + (pm_ & 15)); }
            TSTAMP(13);
#ifndef NO_MEMS
            if (F.bid < 64) mem_unit_smp(args, F, l, (4 * (F.bid & 7) + 2 + (F.bid >> 5)) * 4 + ((F.bid >> 3) & 3));
#endif
#endif
            __syncthreads();
        }
        TSTAMP(6); PH_END_G(6);
        if (PH_ON()) { PH_FRAME(); const unsigned char* wl = ws + WS_WL + (size_t)l * WL_STRIDE; pg8::Gemm g{(const bf16*)(ws + WS_OM), (const bf16*)(wl + WL_MO), MP, D, D}; pg8::StaticOrder S; S.init(MP, D, F.G, F.bid);
            pg8::EpiRes<false> E{ws, nullptr};
#ifndef NO_GG
            pg8::gemm_phase<pg8::EpiRes<false>, pg8::StaticOrder, true, true>(F.lds + RING_OFF, g, S, E, F.wave);
#endif
            mini_gemm<0, D>(F, ws, (const bf16*)(ws + WS_OM), (const bf16*)(wl + WL_MO));
            }
        TSTAMP(7); PH_END(7);
        if (PH_ON())
#pragma unroll 1
        for (int rp = 0; rp < REP_H; ++rp) { PH_FRAME(); const unsigned char* wl = ws + WS_WL + (size_t)l * WL_STRIDE; pg8::Gemm g{(const bf16*)(ws + WS_XB), (const bf16*)(wl + WL_GU), M, 2 * DFF, D}; pg8::StaticOrder S; S.init(M, 2 * DFF, F.G, F.bid);
            pg8::EpiGU E{(const float*)(ws + WS_SSQ), (bf16*)(ws + WS_H), (LAS float*)(F.lds + AUX_OFF + 2048)};
#ifndef NO_GH
            pg8::gemm_phase<pg8::EpiGU, pg8::StaticOrder, true, true>(F.lds + RING_OFF, g, S, E, F.wave);
#endif
#ifndef NO_CVH
            if (l + 1 < NL && F.bid >= 172) { __syncthreads(); convert_items<false>(args, F, l + 1, (F.bid - 172) * NWAVES + F.wave, 84 * NWAVES, 2592, 3520); }
#endif
            }
        TSTAMP(8); PH_END(8);
        if (PH_ON()) { PH_FRAME(); const unsigned char* wl = ws + WS_WL + (size_t)l * WL_STRIDE; pg8::Gemm g{(const bf16*)(ws + WS_H), (const bf16*)(wl + WL_DN), MP, D, DFF}; pg8::StaticOrder S; S.init(MP, D, F.G, F.bid);
            pg8::EpiRes<false> E{ws, nullptr};
#ifndef NO_GI
            pg8::gemm_phase<pg8::EpiRes<false>, pg8::StaticOrder, true, true, true>(F.lds + RING_OFF, g, S, E, F.wave);
#endif
            mini_gemm<0, DFF>(F, ws, (const bf16*)(ws + WS_H), (const bf16*)(wl + WL_DN));
            }
        TSTAMP(9); PH_END(9);
    }
    if (PH_ON()) { PH_FRAME();
        const float* gf = args.in[24]; const int gw = F.bid * NWAVES + F.wave, NGW = F.G * NWAVES;
        f32x4 gg[4];
#pragma unroll
        for (int j = 0; j < 4; ++j) gg[j] = ((const f32x4*)gf)[lane_id() + 64 * j];
        for (int m0 = gw; m0 < M; m0 += 3 * NGW) {
            float sq[3]; v2u xo[3][4];
#pragma unroll
            for (int k = 0; k < 3; ++k) { int m = m0 + k * NGW; m = m < M ? m : M - 1;
                sq[k] = lane_id() < 16 ? ((const float*)(ws + WS_SSQ))[(size_t)m * 16 + lane_id()] : 0.f;
#pragma unroll
                for (int j = 0; j < 4; ++j) xo[k][j] = ((const v2u*)((const bf16*)(ws + WS_XB) + (size_t)m * D))[lane_id() + 64 * j]; }
#pragma unroll
            for (int k = 0; k < 3; ++k) asm volatile("" : "+v"(sq[k]), "+v"(xo[k][0]), "+v"(xo[k][1]), "+v"(xo[k][2]), "+v"(xo[k][3]));
#pragma unroll
            for (int k = 0; k < 3; ++k) { const int m = m0 + k * NGW;
                if (m < M) { float s = xl_sum16(sq[k]); s = __builtin_bit_cast(float, __builtin_amdgcn_readfirstlane(__builtin_bit_cast(int, s)));
                    const float rstd = __builtin_amdgcn_rsqf(s * (1.0f / 1024.0f) + EPS);
                    float* dst = m < MP ? out_y_p(args.out) + (size_t)m * D : out_y_s(args.out) + (size_t)(m - MP) * D;
#pragma unroll
                    for (int j = 0; j < 4; ++j) { f32x4 v; v[0] = bf_lo(xo[k][j].x); v[1] = bf_hi(xo[k][j].x); v[2] = bf_lo(xo[k][j].y); v[3] = bf_hi(xo[k][j].y);
                        ((f32x4*)dst)[lane_id() + 64 * j] = v * rstd * gg[j]; } } }
        }
    }
    TSTAMP(10);
#ifdef TPROBE
    { unsigned long long* tsum = (unsigned long long*)(args.ws + WS_CTL + 65536);
      if (wave0 * 64 + lane_id() == 0) atomicAdd(tsum, (unsigned long long)tacc[TPROBE]);
      xcd_barrier(bar, wave0 * 64 + lane_id());
      if (blockIdx.x == 0 && wave0 * 64 + lane_id() == 0) { const unsigned long long tot = __hip_atomic_load(tsum, __ATOMIC_RELAXED, __HIP_MEMORY_SCOPE_AGENT);
          const unsigned long long wait = tot * 10ull / gridDim.x, t0 = __builtin_amdgcn_s_memrealtime();
          while (__builtin_amdgcn_s_memrealtime() - t0 < wait) __builtin_amdgcn_s_sleep(8); } }
#endif
#undef PH_ON
#undef PH_END
#undef PH_END_G
}

static int mk_grid = 0;
static void mk_launch(void* const* d_in, float* out, unsigned char* ws, hipStream_t stream, int ph_lo, int ph_hi) {
    if (mk_grid == 0) {
        int dev = 0, cus = 0;
        if (hipGetDevice(&dev) != hipSuccess || hipDeviceGetAttribute(&cus, hipDeviceAttributeMultiprocessorCount, dev) != hipSuccess) { mk_grid = -1; return; }
        if (hipFuncSetAttribute((const void*)mk_fwd, hipFuncAttributeMaxDynamicSharedMemorySize, LDS_BYTES) != hipSuccess) { mk_grid = -1; return; }
        (void)hipGetLastError();
        if (cus < 256) { fprintf(stderr, "kernel_launch: this kernel needs 256 CUs (got %d); nothing launched\n", cus); mk_grid = -1; return; }
        mk_grid = 256;
    }
    if (mk_grid < 0) return;
    (void)hipMemsetAsync(ws + WS_CTL, 0, CTL_ZERO_BYTES, stream);
    Args a{};
    for (int i = 0; i < 25; ++i) a.in[i] = (const float*)d_in[i];
    a.out = out; a.ws = ws; a.ph_lo = ph_lo; a.ph_hi = ph_hi;
    hipLaunchKernelGGL(mk_fwd, dim3(mk_grid), dim3(NWAVES * 64), LDS_BYTES, stream, a);
}
extern "C" void kernel_launch(void* const* d_in, const int* in_sizes, int n_in, void* d_out, int out_size, void* d_ws, size_t ws_size, hipStream_t stream) {
    mk_launch(d_in, (float*)d_out, (unsigned char*)d_ws, stream, 0, 34);
}
```
